# Optimizing an MI355X kernel written in HIP

```python
import jax, jax.numpy as jnp
from jax import lax
import numpy as np

D_MODEL = 1024
BATCH = 8
SEQ = 2048
DEPTH = 4
DEC_BATCH = 128
DEC_SEQ = 8
PAST_LEN = 2048
PAGE_SIZE = 128

N_MIXERS = 2
N_A_LAYERS = (DEPTH + 1) // 2
N_B_LAYERS = DEPTH // 2
P_DIM = 256
EPS = 1e-6
ROPE_THETA = 10000.0

CHUNK = 128
A_WIDTH = 2 * D_MODEL
A_GROUPS = 8
A_GROUP_DIM = A_WIDTH // A_GROUPS

N_HEADS = 8
HEAD_DIM = D_MODEL // N_HEADS
N_KV_HEADS = 2
B_WIDTH = N_HEADS * HEAD_DIM
KV_WIDTH = N_KV_HEADS * HEAD_DIM
IDX_HEADS = 8
IDX_DIM = 64
TOPK_MAX = 256
Q_BLOCK = 128
B_SPLITS = (B_WIDTH, KV_WIDTH, KV_WIDTH, IDX_HEADS * IDX_DIM, IDX_DIM, IDX_HEADS, B_WIDTH)
B_IN = sum(B_SPLITS)

kernel_name = 'hybrid_gmlp_dsa_decode_step'


def rmsnorm(x, g):
    xf = x.astype(jnp.float32)
    r = lax.rsqrt(jnp.mean(xf * xf, axis=-1, keepdims=True) + EPS)
    return (xf * r).astype(x.dtype) * g


def rope(x, pos):
    half = x.shape[-1] // 2
    inv = ROPE_THETA ** (-jnp.arange(half, dtype=jnp.float32) / half)
    ang = pos.astype(jnp.float32)[:, None] * inv[None, :]
    cos = jnp.cos(ang)[:, None, :]
    sin = jnp.sin(ang)[:, None, :]
    x1, x2 = x[..., :half], x[..., half:]
    return jnp.concatenate([x1 * cos - x2 * sin, x2 * cos + x1 * sin], axis=-1).astype(x.dtype)


def mixer_a(h, w_in, w_s, b_s, g_v, w_out):
    bsz, t, _ = h.shape
    u, v, z = jnp.split(h @ w_in, 3, axis=-1)
    v = rmsnorm(v, g_v)
    c = min(t, CHUNK)
    n_chunks = t // c
    causal = jnp.tril(jnp.ones((c, c), dtype=bool))
    ws = jnp.where(causal[None], w_s[:, :c, :c], jnp.zeros((), w_s.dtype))
    vc = v.reshape(bsz, n_chunks, c, A_GROUPS, A_GROUP_DIM)
    mixed = jnp.einsum('gts,bnsgd->bntgd', ws, vc) + b_s[:, :c].T[None, None, :, :, None]
    y = u * mixed.reshape(bsz, t, A_WIDTH) * jax.nn.silu(z)
    return y @ w_out, v


def project_b(h, pos, w_in, g_q, g_k, g_ik):
    bsz, t, _ = h.shape
    pts = np.cumsum(B_SPLITS)[:-1].tolist()
    q, k, v, iq, ik, iw, z = jnp.split(h @ w_in, pts, axis=-1)
    q = rope(rmsnorm(q.reshape(bsz, t, N_HEADS, HEAD_DIM), g_q), pos)
    k = rope(rmsnorm(k.reshape(bsz, t, N_KV_HEADS, HEAD_DIM), g_k), pos)
    v = v.reshape(bsz, t, N_KV_HEADS, HEAD_DIM)
    iq = rope(iq.reshape(bsz, t, IDX_HEADS, IDX_DIM), pos)
    ik = rope(rmsnorm(ik, g_ik)[:, :, None, :], pos)[:, :, 0, :]
    return q, k, v, iq, ik, iw, z


def indexer_scores(iq, iw, ik):
    s = jax.nn.relu(jnp.einsum('bthd,bsd->bths', iq, ik).astype(jnp.float32))
    return jnp.einsum('bths,bth->bts', s, iw.astype(jnp.float32)) * (IDX_DIM ** -0.5 * IDX_HEADS ** -0.5)


def attend_selected(q, k_sel, v_sel, valid):
    bsz, t, h, d = q.shape
    qg = q.reshape(bsz, t, N_KV_HEADS, h // N_KV_HEADS, d)
    s = jnp.einsum('btgrd,btkgd->btgrk', qg, k_sel).astype(jnp.float32) * (d ** -0.5)
    s = jnp.where(valid[:, :, None, None, :], s, -jnp.inf)
    p = jax.nn.softmax(s, axis=-1).astype(v_sel.dtype)
    o = jnp.einsum('btgrk,btkgd->btgrd', p, v_sel)
    return o.reshape(bsz, t, h * d)


def dsa_prompt(q, k, v, iq, ik, iw):
    bsz, s = q.shape[:2]
    topk = min(TOPK_MAX, s // 4)
    n_blocks = s // Q_BLOCK
    key_pos = jnp.arange(s)
    bi = jnp.arange(bsz)[:, None, None]

    def block(i):
        start = i * Q_BLOCK
        qb = lax.dynamic_slice_in_dim(q, start, Q_BLOCK, axis=1)
        iqb = lax.dynamic_slice_in_dim(iq, start, Q_BLOCK, axis=1)
        iwb = lax.dynamic_slice_in_dim(iw, start, Q_BLOCK, axis=1)
        qpos = start + jnp.arange(Q_BLOCK)
        sc = indexer_scores(iqb, iwb, ik)
        adm = key_pos[None, :] <= qpos[:, None]
        sc = jnp.where(adm[None], sc, -jnp.inf)
        _, idx = lax.top_k(sc, topk)
        valid = idx <= qpos[None, :, None]
        return attend_selected(qb, k[bi, idx], v[bi, idx], valid)

    out = lax.map(block, jnp.arange(n_blocks))
    return out.transpose(1, 0, 2, 3).reshape(bsz, s, B_WIDTH)


def dsa_sample(q, k_new, v_new, iq, ik_new, iw, cache_k, cache_v, cache_ik, page_table, layer):
    db, t = q.shape[:2]
    n_pages = page_table.shape[1]
    past = n_pages * PAGE_SIZE
    L = past + t
    topk = min(TOPK_MAX, L // 4)
    ik_past = cache_ik[page_table, layer].reshape(db, past, IDX_DIM)
    ik_all = jnp.concatenate([ik_past, ik_new], axis=1)
    sc = indexer_scores(iq, iw, ik_all)
    qpos = past + jnp.arange(t)
    adm = jnp.arange(L)[None, :] <= qpos[:, None]
    sc = jnp.where(adm[None], sc, -jnp.inf)
    _, idx = lax.top_k(sc, topk)
    valid = idx <= qpos[None, :, None]
    from_past = idx < past
    pidx = jnp.minimum(idx, past - 1)
    phys = jnp.take_along_axis(page_table, (pidx // PAGE_SIZE).reshape(db, t * topk), axis=1).reshape(db, t, topk)
    slot = pidx % PAGE_SIZE
    nidx = jnp.clip(idx - past, 0, t - 1)
    bi = jnp.arange(db)[:, None, None]
    sel = from_past[..., None, None]
    k_sel = jnp.where(sel, cache_k[phys, layer, slot], k_new[bi, nidx])
    v_sel = jnp.where(sel, cache_v[phys, layer, slot], v_new[bi, nidx])
    return attend_selected(q, k_sel, v_sel, valid)


def per_layer_embed(x, p, g, w_gate, w_pe):
    return x + jax.nn.sigmoid(rmsnorm(x, g) @ w_gate) * (p @ w_pe)


def setup_inputs(seed: int = 0) -> dict:
    key = jax.random.key(seed)
    ks = jax.random.split(key, 24)
    n_pages = PAST_LEN // PAGE_SIZE
    n_pool = (DEC_BATCH * n_pages * 5) // 4
    nrm = lambda k, shape, scale=1.0: jax.random.normal(k, shape, jnp.float32) * scale
    page_table = jax.random.permutation(ks[5], n_pool)[:DEC_BATCH * n_pages].reshape(DEC_BATCH, n_pages).astype(jnp.int32)
    return {
        'x_prompt': nrm(ks[0], (BATCH, SEQ, D_MODEL)),
        'x_sample': nrm(ks[1], (DEC_BATCH, DEC_SEQ, D_MODEL)),
        'cache_k': nrm(ks[2], (n_pool, N_B_LAYERS, PAGE_SIZE, N_KV_HEADS, HEAD_DIM)),
        'cache_v': nrm(ks[3], (n_pool, N_B_LAYERS, PAGE_SIZE, N_KV_HEADS, HEAD_DIM)),
        'cache_ik': nrm(ks[4], (n_pool, N_B_LAYERS, PAGE_SIZE, IDX_DIM)),
        'page_table': page_table,
        'p_prompt': nrm(ks[6], (DEPTH, BATCH, SEQ, P_DIM)),
        'p_sample': nrm(ks[7], (DEPTH, DEC_BATCH, DEC_SEQ, P_DIM)),
        'g_norm': 1.0 + nrm(ks[8], (DEPTH, D_MODEL), 0.05),
        'w_in_a': nrm(ks[9], (N_A_LAYERS, D_MODEL, 3 * A_WIDTH), D_MODEL ** -0.5),
        'w_s_a': nrm(ks[10], (N_A_LAYERS, A_GROUPS, CHUNK, CHUNK), CHUNK ** -0.5),
        'b_s_a': 1.0 + nrm(ks[11], (N_A_LAYERS, A_GROUPS, CHUNK), 0.1),
        'g_v_a': 1.0 + nrm(ks[12], (N_A_LAYERS, A_WIDTH), 0.05),
        'w_out_a': nrm(ks[13], (N_A_LAYERS, A_WIDTH, D_MODEL), A_WIDTH ** -0.5),
        'w_in_b': nrm(ks[14], (N_B_LAYERS, D_MODEL, B_IN), D_MODEL ** -0.5),
        'g_q_b': 1.0 + nrm(ks[15], (N_B_LAYERS, HEAD_DIM), 0.05),
        'g_k_b': 1.0 + nrm(ks[16], (N_B_LAYERS, HEAD_DIM), 0.05),
        'g_ik_b': 1.0 + nrm(ks[17], (N_B_LAYERS, IDX_DIM), 0.05),
        'w_out_b': nrm(ks[18], (N_B_LAYERS, B_WIDTH, D_MODEL), B_WIDTH ** -0.5),
        'g_pe': 1.0 + nrm(ks[19], (DEPTH, D_MODEL), 0.05),
        'w_pe_gate': nrm(ks[20], (DEPTH, D_MODEL, D_MODEL), D_MODEL ** -0.5),
        'w_pe_proj': nrm(ks[21], (DEPTH, P_DIM, D_MODEL), P_DIM ** -0.5),
    }


def reference(x_prompt, x_sample, cache_k, cache_v, cache_ik, page_table, p_prompt, p_sample,
              g_norm, w_in_a, w_s_a, b_s_a, g_v_a, w_out_a, w_in_b, g_q_b, g_k_b, g_ik_b, w_out_b,
              g_pe, w_pe_gate, w_pe_proj):
    yp, ys = x_prompt, x_sample
    past = page_table.shape[1] * PAGE_SIZE
    pos_p = jnp.arange(x_prompt.shape[1])
    pos_s = past + jnp.arange(x_sample.shape[1])
    kp_l, vp_l, ikp_l, ks_l, vs_l, iks_l, cv_l = [], [], [], [], [], [], []
    for i in range(DEPTH):
        j = i // N_MIXERS
        hp = rmsnorm(yp, g_norm[i])
        hs = rmsnorm(ys, g_norm[i])
        if i % N_MIXERS == 0:
            op, _ = mixer_a(hp, w_in_a[j], w_s_a[j], b_s_a[j], g_v_a[j], w_out_a[j])
            os_, v_rows = mixer_a(hs, w_in_a[j], w_s_a[j], b_s_a[j], g_v_a[j], w_out_a[j])
            cv_l.append(v_rows)
        else:
            q, k, v, iq, ik, iw, z = project_b(hp, pos_p, w_in_b[j], g_q_b[j], g_k_b[j], g_ik_b[j])
            op = (dsa_prompt(q, k, v, iq, ik, iw) * jax.nn.silu(z)) @ w_out_b[j]
            kp_l.append(k)
            vp_l.append(v)
            ikp_l.append(ik)
            q, k, v, iq, ik, iw, z = project_b(hs, pos_s, w_in_b[j], g_q_b[j], g_k_b[j], g_ik_b[j])
            att = dsa_sample(q, k, v, iq, ik, iw, cache_k, cache_v, cache_ik, page_table, j)
            os_ = (att * jax.nn.silu(z)) @ w_out_b[j]
            ks_l.append(k)
            vs_l.append(v)
            iks_l.append(ik)
        yp = per_layer_embed(yp + op, p_prompt[i], g_pe[i], w_pe_gate[i], w_pe_proj[i])
        ys = per_layer_embed(ys + os_, p_sample[i], g_pe[i], w_pe_gate[i], w_pe_proj[i])
    k_prompt = jnp.stack(kp_l, axis=1)
    v_prompt = jnp.stack(vp_l, axis=1)
    ik_prompt = jnp.stack(ikp_l, axis=1)
    k_sample = jnp.stack(ks_l, axis=1)
    v_sample = jnp.stack(vs_l, axis=1)
    ik_sample = jnp.stack(iks_l, axis=1)
    chunk_v_sample = jnp.stack(cv_l, axis=1)
    return (yp, ys, k_prompt, v_prompt, ik_prompt, k_sample, v_sample, ik_sample, chunk_v_sample)
```

```cpp
#include <hip/hip_runtime.h>
#include <cstdio>
#include <cstdint>
namespace pg8 {
#define PG8_LAS __attribute__((address_space(3)))
typedef unsigned short bf16_t;
typedef short bf16x8 __attribute__((ext_vector_type(8)));
typedef float f32x4 __attribute__((ext_vector_type(4)));
typedef unsigned u32x4 __attribute__((ext_vector_type(4)));
constexpr int BM = 256, BK = 64, HALF = 128, HTB = HALF * BK * 2  , STAGE_BYTES = 8 * HTB, NXCD = 8, WGM = 8;

__host__ __device__ __forceinline__ int lds_byte(int r, int c) { const int st = (r >> 4) * 2 + (c >> 5), rr = r & 15, cc = c & 31, ob = rr * 64 + cc * 2; return st * 1024 + (ob ^ (((ob >> 9) & 1) << 5)); }
__host__ __device__ __forceinline__ void stage_rc(int b, int& R, int& C) { const int st = b / 1024, sb = b % 1024, swz = sb ^ (((sb >> 9) & 1) << 5); R = (st >> 1) * 16 + swz / 64; C = (st & 1) * 32 + (swz % 64) / 2; }
__host__ __device__ __forceinline__ int perm32(int rho) { const int n = rho >> 4, i = rho & 15; return 8 * (i >> 2) + 4 * n + (i & 3); }

struct Unit { int pm, pn; };
struct Gemm { const bf16_t* A; const bf16_t* Bt; int M, N, K; };

struct StaticOrder {
    int nM, nN, nwg, G, c;
    __host__ __device__ void init(int M, int N, int G_, int c_) { nM = M / BM; nN = N / BM; nwg = nM * nN; G = G_; c = c_; }
    __host__ __device__ bool next(int i, Unit& u) const {
        const long L = (long)i * G + c; if (L >= nwg) return false;
        int wgid = (int)L; { const int q = nwg / NXCD, r = nwg % NXCD, xcd = wgid % NXCD, off = wgid / NXCD; wgid = (xcd < r ? xcd * (q + 1) : r * (q + 1) + (xcd - r) * q) + off; }
        const int nig = WGM * nN, gid = wgid / nig, fm = gid * WGM, gsz = (nM - fm) < WGM ? (nM - fm) : WGM;
        u.pm = fm + ((wgid % nig) % gsz); u.pn = (wgid % nig) / gsz; return true;
    }
    __device__ __forceinline__ void a_ready(const Unit&) const {}
    __device__ __forceinline__ void done(const Unit&) const {}
};
__device__ __forceinline__ unsigned cvt_pk_bf16(float lo, float hi) { unsigned r; asm volatile("v_cvt_pk_bf16_f32 %0, %1, %2" : "=v"(r) : "v"(lo), "v"(hi)); return r; }
typedef float f32x2 __attribute__((ext_vector_type(2)));
template <class Epi, class Sched, bool ALIGN_EPI = false, bool SP2 = false>
__device__ __forceinline__ void gemm_phase(PG8_LAS unsigned char* lds, const Gemm g, const Sched& S, const Epi& E) {
    const int tid = threadIdx.x, wid = __builtin_amdgcn_readfirstlane(tid >> 6), lane = tid & 63, wr = wid >> 2, wc = wid & 3, fr = lane & 15, fq = lane >> 4;
    const int K = g.K, nt = K / BK;
    unsigned voffA[2], voffB[2];
#pragma unroll
    for (int i = 0; i < 2; ++i) { int R, C; stage_rc(tid * 16 + i * 8192, R, C); const int Rb = Epi::PERM ? ((R & ~31) + perm32(R & 31)) : R;
        voffA[i] = (unsigned)(R * K + C) * 2u; voffB[i] = (unsigned)(Rb * K + C) * 2u; }
    const size_t kstep = (size_t)(BK * 2);
    const size_t hstep = (size_t)HALF * K * 2;
    const size_t tstep = 2 * hstep;
    const unsigned ldsw = (unsigned)wid * 1024u;
    const int aoff = lds_byte(wr * 64 + fr, fq * 8), boff = lds_byte(wc * 32 + fr, fq * 8);
#define PG8_SA(b, h) (((b) * 2 + (h)) * HTB)
#define PG8_SB(b, h) ((4 + (b) * 2 + (h)) * HTB)
#define PG8_STAGE(bufoff, gbase, voff) do { _Pragma("unroll") for (int _i = 0; _i < 2; ++_i) \
        __builtin_amdgcn_global_load_lds((const unsigned*)((const char*)(gbase) + (voff)[_i]), (PG8_LAS unsigned*)(lds + (bufoff) + ldsw + _i * 8192), 16, 0, 0); } while (0)
#define PG8_LDA(dst, b, h) do { _Pragma("unroll") for (int m = 0; m < 4; ++m) _Pragma("unroll") for (int k = 0; k < 2; ++k) dst[m][k] = *(const PG8_LAS bf16x8*)(lds + PG8_SA(b, h) + aoff + m * 2048 + k * 1024); } while (0)
#define PG8_LDB(dst, b, h) do { _Pragma("unroll") for (int n = 0; n < 2; ++n) _Pragma("unroll") for (int k = 0; k < 2; ++k) dst[n][k] = *(const PG8_LAS bf16x8*)(lds + PG8_SB(b, h) + boff + n * 2048 + k * 1024); } while (0)
#define PG8_MMA(ai, bj, At, Bt) do { __builtin_amdgcn_s_setprio(1); _Pragma("unroll") for (int m = 0; m < 4; ++m) _Pragma("unroll") for (int n = 0; n < 2; ++n) _Pragma("unroll") for (int k = 0; k < 2; ++k) \
        acc[ai][bj][m][n] = __builtin_amdgcn_mfma_f32_16x16x32_bf16(Bt[n][k], At[m][k], acc[ai][bj][m][n], 0, 0, 0); __builtin_amdgcn_s_setprio(0); } while (0)
#define PG8_WAIT_V(n) asm volatile("s_waitcnt vmcnt(" #n ")" ::: "memory")
#define PG8_WAIT_L(n) asm volatile("s_waitcnt lgkmcnt(" #n ")" ::: "memory")
#define PG8_BAR __builtin_amdgcn_s_barrier()
#define PG8_SCHED __builtin_amdgcn_sched_barrier(0)
    Unit cur, nxt; int ui = 0;
    if (!S.next(0, cur)) return;
    f32x4 acc[2][2][4][2];
#pragma unroll
    for (int a = 0; a < 2; ++a)
#pragma unroll
        for (int b = 0; b < 2; ++b)
#pragma unroll
            for (int m = 0; m < 4; ++m)
#pragma unroll
                for (int n = 0; n < 2; ++n) acc[a][b][m][n] = (f32x4){0.f, 0.f, 0.f, 0.f};
    bf16x8 At[4][2], B0[2][2], B1[2][2];
    const char* cA = (const char*)g.A + (size_t)cur.pm * tstep; const char* cB = (const char*)g.Bt + (size_t)cur.pn * tstep;
    S.a_ready(cur);
    if constexpr (SP2) {
        PG8_STAGE(PG8_SB(0, 0), cB, voffB); PG8_STAGE(PG8_SB(0, 1), cB + hstep, voffB); PG8_STAGE(PG8_SA(0, 0), cA, voffA); PG8_STAGE(PG8_SA(0, 1), cA + hstep, voffA);
        if (wr == 1) PG8_BAR;
        PG8_WAIT_V(2); PG8_BAR;
        PG8_STAGE(PG8_SB(1, 0), cB + kstep, voffB); PG8_STAGE(PG8_SA(1, 0), cA + kstep, voffA); PG8_STAGE(PG8_SB(1, 1), cB + hstep + kstep, voffB);
        PG8_WAIT_V(6); PG8_BAR;
    } else {
        PG8_STAGE(PG8_SB(0, 0), cB, voffB); PG8_STAGE(PG8_SA(0, 0), cA, voffA); PG8_STAGE(PG8_SB(0, 1), cB + hstep, voffB); PG8_STAGE(PG8_SA(0, 1), cA + hstep, voffA);
        if (wr == 1) PG8_BAR;
        PG8_WAIT_V(4); PG8_BAR;
        PG8_STAGE(PG8_SB(1, 0), cB + kstep, voffB); PG8_STAGE(PG8_SA(1, 0), cA + kstep, voffA); PG8_STAGE(PG8_SB(1, 1), cB + hstep + kstep, voffB);
        PG8_WAIT_V(6); PG8_BAR;
    }
    for (;;) {
        const bool has_next = S.next(ui + 1, nxt);
        const char* nA = has_next ? (const char*)g.A + (size_t)nxt.pm * tstep : cA; const char* nB = has_next ? (const char*)g.Bt + (size_t)nxt.pn * tstep : cB;
        for (int t = 0; t < nt; t += 2) {
            const bool last = (t == nt - 2);
            const char* a1 = cA + (size_t)(t + 1) * kstep;
            const char* a2 = last ? nA : cA + (size_t)(t + 2) * kstep; const char* b2 = last ? nB : cB + (size_t)(t + 2) * kstep;
            const char* a3 = a2 + kstep; const char* b3 = b2 + kstep;
            if (last && has_next) S.a_ready(nxt);
            if constexpr (SP2) {
            PG8_LDB(B0, 0, 0); PG8_LDB(B1, 0, 1); PG8_SCHED; PG8_LDA(At, 0, 0); PG8_STAGE(PG8_SA(1, 1), a1 + hstep, voffA);
            PG8_WAIT_V(8); PG8_WAIT_L(0); PG8_BAR; PG8_MMA(0, 0, At, B0); PG8_MMA(0, 1, At, B1); PG8_BAR; PG8_SCHED;
            PG8_LDA(At, 0, 1); PG8_STAGE(PG8_SB(0, 0), b2, voffB); PG8_STAGE(PG8_SB(0, 1), b2 + hstep, voffB); PG8_STAGE(PG8_SA(0, 0), a2, voffA);
            PG8_WAIT_V(8); PG8_WAIT_L(0); PG8_BAR; PG8_MMA(1, 0, At, B0); PG8_MMA(1, 1, At, B1); PG8_BAR; PG8_SCHED;
            PG8_LDB(B0, 1, 0); PG8_LDB(B1, 1, 1); PG8_SCHED; PG8_LDA(At, 1, 0); PG8_STAGE(PG8_SA(0, 1), a2 + hstep, voffA);
            PG8_WAIT_V(8); PG8_WAIT_L(0); PG8_BAR; PG8_MMA(0, 0, At, B0); PG8_MMA(0, 1, At, B1); PG8_BAR; PG8_SCHED;
            PG8_LDA(At, 1, 1); PG8_STAGE(PG8_SB(1, 0), b3, voffB); PG8_STAGE(PG8_SB(1, 1), b3 + hstep, voffB); PG8_STAGE(PG8_SA(1, 0), a3, voffA);
            PG8_WAIT_V(8); PG8_WAIT_L(0); PG8_BAR; PG8_MMA(1, 0, At, B0); PG8_MMA(1, 1, At, B1); PG8_BAR; PG8_SCHED;
            } else {
            PG8_LDB(B0, 0, 0); PG8_SCHED; PG8_LDA(At, 0, 0); PG8_STAGE(PG8_SA(1, 1), a1 + hstep, voffA);
            PG8_WAIT_L(8); PG8_BAR; PG8_WAIT_L(0); PG8_MMA(0, 0, At, B0); PG8_BAR; PG8_SCHED;
            PG8_LDB(B1, 0, 1); PG8_STAGE(PG8_SB(0, 0), b2, voffB);
            PG8_BAR; PG8_WAIT_L(0); PG8_MMA(0, 1, At, B1); PG8_BAR;
            PG8_LDA(At, 0, 1); PG8_STAGE(PG8_SA(0, 0), a2, voffA);
            PG8_BAR; PG8_WAIT_L(0); PG8_MMA(1, 0, At, B0); PG8_BAR; PG8_SCHED;
            PG8_STAGE(PG8_SB(0, 1), b2 + hstep, voffB);
            PG8_WAIT_V(6); PG8_BAR; PG8_MMA(1, 1, At, B1); PG8_BAR;
            PG8_LDB(B0, 1, 0); PG8_SCHED; PG8_LDA(At, 1, 0); PG8_STAGE(PG8_SA(0, 1), a2 + hstep, voffA);
            PG8_WAIT_L(8); PG8_BAR; PG8_WAIT_L(0); PG8_MMA(0, 0, At, B0); PG8_BAR; PG8_SCHED;
            PG8_LDB(B1, 1, 1); PG8_STAGE(PG8_SB(1, 0), b3, voffB);
            PG8_BAR; PG8_WAIT_L(0); PG8_MMA(0, 1, At, B1); PG8_BAR;
            PG8_LDA(At, 1, 1); PG8_STAGE(PG8_SA(1, 0), a3, voffA);
            PG8_BAR; PG8_WAIT_L(0); PG8_MMA(1, 0, At, B0); PG8_BAR; PG8_SCHED;
            PG8_STAGE(PG8_SB(1, 1), b3 + hstep, voffB);
            PG8_WAIT_V(6); PG8_BAR; PG8_MMA(1, 1, At, B1); PG8_BAR;
            }
        }
        if constexpr (ALIGN_EPI) { if (wr == 0) PG8_BAR; }
        if constexpr (!Epi::AFTER_DRAIN) { E(acc, cur, wr, wc, fr, fq); S.done(cur); }
        if (!has_next) break;
#pragma unroll
        for (int a = 0; a < 2; ++a)
#pragma unroll
            for (int b = 0; b < 2; ++b)
#pragma unroll
                for (int m = 0; m < 4; ++m)
#pragma unroll
                    for (int n = 0; n < 2; ++n) acc[a][b][m][n] = (f32x4){0.f, 0.f, 0.f, 0.f};
        cur = nxt; cA = nA; cB = nB; ++ui;
        if constexpr (ALIGN_EPI) { if (wr == 1) PG8_BAR; }
    }
    PG8_WAIT_V(0);
    if constexpr (!ALIGN_EPI) { if (wr == 0) PG8_BAR; }
    PG8_BAR;
    if constexpr (Epi::AFTER_DRAIN) { E.fused(acc, cur, wr, wc, fr, fq, lds, wid, lane); S.done(cur); }
#undef PG8_SA
#undef PG8_SB
#undef PG8_STAGE
#undef PG8_LDA
#undef PG8_LDB
#undef PG8_MMA
#undef PG8_WAIT_V
#undef PG8_WAIT_L
#undef PG8_BAR
#undef PG8_SCHED
}
}
#define GAS __attribute__((address_space(1)))
#define LAS __attribute__((address_space(3)))
typedef unsigned short bf16;
typedef unsigned v4u __attribute__((ext_vector_type(4)));
typedef float f32x4 __attribute__((ext_vector_type(4)));
typedef short bf16x8 __attribute__((ext_vector_type(8)));
typedef GAS unsigned gu32;
typedef GAS unsigned long long gu64;
#define RLX_AGENT __ATOMIC_RELAXED, __HIP_MEMORY_SCOPE_AGENT
#define LDS_WAIT() asm volatile("s_waitcnt lgkmcnt(0)" ::: "memory")
#define VM_WAIT() asm volatile("s_waitcnt vmcnt(0)" ::: "memory")
__device__ __forceinline__ unsigned long long rt() { return __builtin_amdgcn_s_memrealtime(); }
__device__ __forceinline__ unsigned f2bf(float f) { unsigned u = __builtin_bit_cast(unsigned, f); return (u + 0x7fffu + ((u >> 16) & 1u)) >> 16; }
__device__ __forceinline__ unsigned pk2(float lo, float hi) { return f2bf(lo) | (f2bf(hi) << 16); }

#define XB_TMO      128
#define XB_XCNT(j)  (256  + 64 * (j))
#define XB_XSUB(j)  (1280 + 64 * (j))
#define XB_XGEN(j)  (2304 + 64 * (j))
#define XB_TOP      3328
#define XB_TOPGEN   3392
#define XCD_BAR_WORDS 3456
#define XB_SPIN_CAP (1u << 18)

__device__ __forceinline__ unsigned xb_ld(unsigned* p)              { return __hip_atomic_load(p, __ATOMIC_RELAXED, __HIP_MEMORY_SCOPE_AGENT); }
__device__ __forceinline__ unsigned xb_add(unsigned* p, unsigned v) { return __hip_atomic_fetch_add(p, v, __ATOMIC_RELAXED, __HIP_MEMORY_SCOPE_AGENT); }
__device__ __forceinline__ unsigned xb_xcc_id() { return (unsigned)__builtin_amdgcn_s_getreg((3 << 11) | 20) & 0xFu; }
#define XB_SPIN(cond, bar) do { unsigned _sp = 0; while (cond) { __builtin_amdgcn_s_sleep(1); \
    if ((++_sp & 255u) == 0u) { if (xb_ld(&(bar)[XB_TMO])) break; if (_sp > XB_SPIN_CAP) { atomicAdd(&(bar)[XB_TMO], 1u); break; } } } } while (0)

struct XcdBarrier {
    unsigned* bar; unsigned x;
    volatile LAS unsigned* st;
};

__device__ __forceinline__ XcdBarrier xcd_barrier_post(unsigned* bar, volatile LAS unsigned* st) {
    XcdBarrier b; b.bar = bar; b.x = xb_xcc_id(); b.st = st;
    if (threadIdx.x == 0) (void)xb_add(&bar[XB_XCNT(b.x)], 1u);
    return b;
}
__device__ __forceinline__ void xcd_barrier_complete(unsigned* bar, unsigned x, unsigned& nloc, unsigned& nx) {
    const unsigned G = gridDim.x * gridDim.y * gridDim.z;
    unsigned sum, cnt, mine, sp = 0u;
    for (;;) {
        sum = 0u; cnt = 0u; mine = 0u;
#pragma unroll
        for (unsigned j = 0; j < 16; ++j) { const unsigned c = xb_ld(&bar[XB_XCNT(j)]); sum += c; cnt += (c > 0u) ? 1u : 0u; mine = (j == x) ? c : mine; }
        if (sum == G) break;
        __builtin_amdgcn_s_sleep(1);
        if ((++sp & 255u) == 0u) { if (xb_ld(&bar[XB_TMO])) break; if (sp > XB_SPIN_CAP) { atomicAdd(&bar[XB_TMO], 1u); break; } }
    }
    nloc = mine > 0u ? mine : 1u; nx = cnt > 0u ? cnt : 1u;
}

__device__ __forceinline__ void xcd_barrier(const XcdBarrier& b) {
    asm volatile("s_waitcnt vmcnt(0)" ::: "memory");
    __syncthreads();
    if (threadIdx.x == 0) {
        unsigned* bar = b.bar;
        __builtin_amdgcn_s_waitcnt(0);
        unsigned nloc = b.st[0], nx = b.st[1];
        if (nloc == 0u) { xcd_barrier_complete(bar, b.x, nloc, nx); b.st[0] = nloc; b.st[1] = nx; }
        const unsigned old = xb_add(&bar[XB_XSUB(b.x)], 1u);
        const unsigned gen = old / nloc;
        if (old + 1u == (gen + 1u) * nloc) {
            __builtin_amdgcn_fence(__ATOMIC_RELEASE, "agent");
            asm volatile("s_waitcnt vmcnt(0)" ::: "memory");
            const unsigned og = xb_add(&bar[XB_TOP], 1u);
            const unsigned tg = og / nx;
            if (og + 1u == (tg + 1u) * nx) xb_add(&bar[XB_TOPGEN], 1u);
            else XB_SPIN(xb_ld(&bar[XB_TOPGEN]) == tg, bar);
            __builtin_amdgcn_fence(__ATOMIC_ACQUIRE, "agent");
            xb_add(&bar[XB_XGEN(b.x)], 1u);
            asm volatile("s_waitcnt vmcnt(0)" ::: "memory");
        } else {
            XB_SPIN(xb_ld(&bar[XB_XGEN(b.x)]) == gen, bar);
            __builtin_amdgcn_fence(__ATOMIC_ACQUIRE, "agent");
            asm volatile("s_waitcnt vmcnt(0)" ::: "memory");
        }
    }
    __syncthreads();
}

constexpr int D = 1024, TP = 16384, TS = 1024, T = TP + TS, SEQ = 2048, NBATCH = 8, DBATCH = 128, DSEQ = 8;
constexpr int AW = 2048, NA_IN = 6144, NB_IN = 3328, NB_SRC = 3144, PD = 256, NPAGES = 16, PAGE = 128;
constexpr int HD = 128, NH = 8, NKV = 2, KVW = 256, IDXH = 8, IDXD = 64, TOPK = 256;
constexpr int NPOS = SEQ + DSEQ;
constexpr int MASKW = 34;
constexpr float EPS = 1e-6f;
constexpr size_t O_Y = 0, O_KP = (size_t)T * D, O_VP = O_KP + (size_t)NBATCH * 2 * SEQ * KVW, O_IKP = O_VP + (size_t)NBATCH * 2 * SEQ * KVW,
                 O_KS = O_IKP + (size_t)NBATCH * 2 * SEQ * IDXD, O_VS = O_KS + (size_t)DBATCH * 2 * DSEQ * KVW, O_IKS = O_VS + (size_t)DBATCH * 2 * DSEQ * KVW,
                 O_CV = O_IKS + (size_t)DBATCH * 2 * DSEQ * IDXD, O_END = O_CV + (size_t)DBATCH * 2 * DSEQ * AW;
static_assert(O_END == 42074112, "output size");
constexpr size_t al256(size_t x) { return (x + 255) & ~(size_t)255; }
constexpr size_t WS_CTL = 0, CTL_BYTES = 1u << 20;
constexpr size_t SZ_WINA = (size_t)NA_IN * D * 2, SZ_WOUTA = (size_t)D * AW * 2, SZ_WINB = (size_t)NB_IN * D * 2, SZ_WSQ = (size_t)D * D * 2, SZ_WPE = (size_t)D * PD * 2;
constexpr size_t WS_WINA = CTL_BYTES, WS_WOUTA = WS_WINA + 2 * SZ_WINA, WS_WINB = WS_WOUTA + 2 * SZ_WOUTA, WS_WOUTB = WS_WINB + 2 * SZ_WINB,
                 WS_WGATE = WS_WOUTB + 2 * SZ_WSQ, WS_WPE = WS_WGATE + 4 * SZ_WSQ, WS_ROPE = WS_WPE + 4 * SZ_WPE;
constexpr size_t SZ_ROPE = al256((size_t)NPOS * 64 * 8), SZ_PB = (size_t)T * PD * 2, SZ_XB = (size_t)T * D * 2, SZ_XF = (size_t)T * D * 4, SZ_SS = (size_t)T * 16 * 4;
constexpr size_t WS_PB = WS_ROPE + SZ_ROPE, WS_XB0 = WS_PB + 4 * SZ_PB, WS_XB1 = WS_XB0 + SZ_XB, WS_XF0 = WS_XB1 + SZ_XB, WS_XF1 = WS_XF0 + SZ_XF,
                 WS_SSX = WS_XF1 + SZ_XF, WS_SS1 = WS_SSX + SZ_SS, WS_UZ = WS_SS1 + SZ_SS;
constexpr size_t SZ_AW = (size_t)T * AW * 2;
constexpr size_t WS_VR = WS_UZ + SZ_AW, WS_Y = WS_VR + SZ_AW, WS_VSS = WS_Y + SZ_AW, WS_PE = WS_VSS + (size_t)T * 32 * 4, WS_RAW = WS_PE + SZ_XB;
constexpr size_t WS_Q = WS_RAW + (size_t)T * NB_IN * 2, WS_KB = WS_Q + SZ_XB, WS_VB = WS_KB + (size_t)T * KVW * 2, WS_IQ = WS_VB + (size_t)T * KVW * 2,
                 WS_IK = WS_IQ + (size_t)T * 512 * 2, WS_IW = WS_IK + (size_t)T * 64 * 2, WS_SZ = WS_IW + (size_t)T * 8 * 4, WS_AO = WS_SZ + SZ_XB,
                 WS_MASK = WS_AO + SZ_XB, WS_END = WS_MASK + (size_t)T * MASKW * 8;
constexpr int SCR_BYTES = 139264, MISC_OFF = SCR_BYTES, LDS_BYTES = SCR_BYTES + 256;

typedef short s16x4 __attribute__((ext_vector_type(4)));
typedef float f32x16 __attribute__((ext_vector_type(16)));
typedef float f32x2v __attribute__((ext_vector_type(2)));
typedef unsigned u32x2v __attribute__((ext_vector_type(2)));
typedef unsigned long long u64;

__device__ __forceinline__ float bf2f(unsigned short b) { return __builtin_bit_cast(float, (unsigned)b << 16); }
__device__ __forceinline__ float bflo(unsigned w) { return __builtin_bit_cast(float, w << 16); }
__device__ __forceinline__ float bfhi(unsigned w) { return __builtin_bit_cast(float, w & 0xffff0000u); }
__device__ __forceinline__ unsigned cvtpk(float lo, float hi) { return pg8::cvt_pk_bf16(lo, hi); }
__device__ __forceinline__ float wave_sum(float v) {
#pragma unroll
    for (int o = 1; o < 64; o <<= 1) v += __shfl_xor(v, o);
    return v;
}
__device__ __forceinline__ float wave_max(float v) {
#pragma unroll
    for (int o = 1; o < 64; o <<= 1) v = fmaxf(v, __shfl_xor(v, o));
    return v;
}
__device__ __forceinline__ float rsq(float x) { return 1.0f / sqrtf(x); }
__device__ __forceinline__ float sigm(float x) { return 1.0f / (1.0f + __expf(-x)); }
__device__ __forceinline__ float row_r16(const float* ss, int row, float inv_n) {
    const f32x4* p = (const f32x4*)(ss + (size_t)row * 16); const f32x4 a = p[0], b = p[1], c = p[2], d = p[3];
    const float s = (((a.x + a.y) + (a.z + a.w)) + ((b.x + b.y) + (b.z + b.w))) + (((c.x + c.y) + (c.z + c.w)) + ((d.x + d.y) + (d.z + d.w)));
    return rsq(s * inv_n + EPS);
}

struct EpiA1 {
    static constexpr bool PERM = true, AFTER_DRAIN = false;
    const float* ssx; bf16* UZ; bf16* V; float* vss;
    __device__ __forceinline__ void operator()(const f32x4 (&acc)[2][2][4][2], const pg8::Unit& u, int wr, int wc, int fr, int fq) const {
        const int row0 = u.pm * 256 + wr * 64 + fr;
#pragma unroll
        for (int ai = 0; ai < 2; ++ai)
#pragma unroll
            for (int m = 0; m < 4; ++m) {
                const int row = row0 + ai * 128 + m * 16; const float r = row_r16(ssx, row, 1.0f / D);
                if (u.pn < 16) {
                    float o[8];
#pragma unroll
                    for (int n = 0; n < 2; ++n)
#pragma unroll
                        for (int j = 0; j < 4; ++j) { const float uu = acc[ai][0][m][n][j] * r, zz = acc[ai][1][m][n][j] * r; o[n * 4 + j] = uu * zz * sigm(zz); }
                    v4u w; w.x = cvtpk(o[0], o[1]); w.y = cvtpk(o[2], o[3]); w.z = cvtpk(o[4], o[5]); w.w = cvtpk(o[6], o[7]);
                    *(v4u*)(UZ + (size_t)row * AW + u.pn * 128 + wc * 32 + 8 * fq) = w;
                } else {
                    float q = 0.f;
#pragma unroll
                    for (int bj = 0; bj < 2; ++bj) { const f32x4 a = acc[ai][bj][m][0] * r, b = acc[ai][bj][m][1] * r;
                        q += (a.x * a.x + a.y * a.y) + (a.z * a.z + a.w * a.w) + (b.x * b.x + b.y * b.y) + (b.z * b.z + b.w * b.w);
                        v4u w; w.x = cvtpk(a.x, a.y); w.y = cvtpk(a.z, a.w); w.z = cvtpk(b.x, b.y); w.w = cvtpk(b.z, b.w);
                        *(v4u*)(V + (size_t)row * AW + (u.pn - 16) * 256 + bj * 128 + wc * 32 + 8 * fq) = w; }
                    q += __shfl_xor(q, 16); q += __shfl_xor(q, 32);
                    if (fq == 0) vss[(size_t)row * 32 + (u.pn - 16) * 4 + wc] = q;
                }
            }
    }
};
struct EpiBf16S {
    static constexpr bool PERM = true, AFTER_DRAIN = false;
    const float* ss; bf16* O; int ldc;
    __device__ __forceinline__ void operator()(const f32x4 (&acc)[2][2][4][2], const pg8::Unit& u, int wr, int wc, int fr, int fq) const {
        const int row0 = u.pm * 256 + wr * 64 + fr;
#pragma unroll
        for (int ai = 0; ai < 2; ++ai)
#pragma unroll
            for (int m = 0; m < 4; ++m) {
                const int row = row0 + ai * 128 + m * 16; const float r = ss ? row_r16(ss, row, 1.0f / D) : 1.0f;
#pragma unroll
                for (int bj = 0; bj < 2; ++bj) { const f32x4 a = acc[ai][bj][m][0] * r, b = acc[ai][bj][m][1] * r;
                    v4u w; w.x = cvtpk(a.x, a.y); w.y = cvtpk(a.z, a.w); w.z = cvtpk(b.x, b.y); w.w = cvtpk(b.z, b.w);
                    *(v4u*)(O + (size_t)row * ldc + u.pn * 256 + bj * 128 + wc * 32 + 8 * fq) = w; }
            }
    }
};
struct EpiRes {
    static constexpr bool PERM = true, AFTER_DRAIN = false;
    const float* xin_p; const float* xin_s; float* x1f; bf16* x1b; float* ss1;
    __device__ __forceinline__ void operator()(const f32x4 (&acc)[2][2][4][2], const pg8::Unit& u, int wr, int wc, int fr, int fq) const {
        const int row0 = u.pm * 256 + wr * 64 + fr;
        const float* xb = (u.pm < TP / 256) ? xin_p : xin_s - (size_t)TP * D;
#pragma unroll
        for (int ai = 0; ai < 2; ++ai)
#pragma unroll
            for (int m = 0; m < 4; ++m) {
                const int row = row0 + ai * 128 + m * 16; float q = 0.f;
#pragma unroll
                for (int bj = 0; bj < 2; ++bj) { const size_t off = (size_t)row * D + u.pn * 256 + bj * 128 + wc * 32 + 8 * fq;
                    const f32x4 a = *(const f32x4*)(xb + off) + acc[ai][bj][m][0], b = *(const f32x4*)(xb + off + 4) + acc[ai][bj][m][1];
                    q += (a.x * a.x + a.y * a.y) + (a.z * a.z + a.w * a.w) + (b.x * b.x + b.y * b.y) + (b.z * b.z + b.w * b.w);
                    *(f32x4*)(x1f + off) = a; *(f32x4*)(x1f + off + 4) = b;
                    v4u w; w.x = cvtpk(a.x, a.y); w.y = cvtpk(a.z, a.w); w.z = cvtpk(b.x, b.y); w.w = cvtpk(b.z, b.w);
                    *(v4u*)(x1b + off) = w; }
                q += __shfl_xor(q, 16); q += __shfl_xor(q, 32);
                if (fq == 0) ss1[(size_t)row * 16 + u.pn * 4 + wc] = q;
            }
    }
};
struct EpiGate {
    static constexpr bool PERM = true, AFTER_DRAIN = false;
    const float* ss1; const float* x1f; const bf16* pe; float* xout; bf16* xb; float* ssx;
    __device__ __forceinline__ void operator()(const f32x4 (&acc)[2][2][4][2], const pg8::Unit& u, int wr, int wc, int fr, int fq) const {
        const int row0 = u.pm * 256 + wr * 64 + fr;
#pragma unroll
        for (int ai = 0; ai < 2; ++ai)
#pragma unroll
            for (int m = 0; m < 4; ++m) {
                const int row = row0 + ai * 128 + m * 16; const float r1 = row_r16(ss1, row, 1.0f / D); float q = 0.f;
#pragma unroll
                for (int bj = 0; bj < 2; ++bj) { const size_t off = (size_t)row * D + u.pn * 256 + bj * 128 + wc * 32 + 8 * fq;
                    const v4u pw = *(const v4u*)(pe + off); const f32x4 xa = *(const f32x4*)(x1f + off), xc = *(const f32x4*)(x1f + off + 4);
                    const f32x4 ga = acc[ai][bj][m][0] * r1, gb = acc[ai][bj][m][1] * r1;
                    f32x4 a, b;
                    a.x = xa.x + sigm(ga.x) * bflo(pw.x); a.y = xa.y + sigm(ga.y) * bfhi(pw.x); a.z = xa.z + sigm(ga.z) * bflo(pw.y); a.w = xa.w + sigm(ga.w) * bfhi(pw.y);
                    b.x = xc.x + sigm(gb.x) * bflo(pw.z); b.y = xc.y + sigm(gb.y) * bfhi(pw.z); b.z = xc.z + sigm(gb.z) * bflo(pw.w); b.w = xc.w + sigm(gb.w) * bfhi(pw.w);
                    q += (a.x * a.x + a.y * a.y) + (a.z * a.z + a.w * a.w) + (b.x * b.x + b.y * b.y) + (b.z * b.z + b.w * b.w);
                    *(f32x4*)(xout + off) = a; *(f32x4*)(xout + off + 4) = b;
                    v4u w; w.x = cvtpk(a.x, a.y); w.y = cvtpk(a.z, a.w); w.z = cvtpk(b.x, b.y); w.w = cvtpk(b.z, b.w);
                    *(v4u*)(xb + off) = w; }
                q += __shfl_xor(q, 16); q += __shfl_xor(q, 32);
                if (fq == 0) ssx[(size_t)row * 16 + u.pn * 4 + wc] = q;
            }
    }
};

struct Args { const void* in[22]; float* out; unsigned char* ws; int ph_lo, ph_hi; };
struct Ctx {
    LAS unsigned char* lds; int tid, lane, wave, G, bid;
    const float *x_prompt, *x_sample, *cache_k, *cache_v, *cache_ik; const int* page_table; const float *p_prompt, *p_sample, *g_norm, *w_in_a, *w_s_a, *b_s_a, *g_v_a, *w_out_a,
        *w_in_b, *g_q_b, *g_k_b, *g_ik_b, *w_out_b, *g_pe, *w_pe_gate, *w_pe_proj;
    float* out; unsigned char* ws;
};
#define WSP(T_, off) ((T_*)(C.ws + (off)))

__device__ __forceinline__ int srcA(int n) { if (n < 4096) { const int t = n >> 8, r = n & 255; return r < 128 ? 128 * t + r : 4096 + 128 * t + (r - 128); } return 2048 + (n - 4096); }
__device__ __forceinline__ int srcB(int n) { if (n < 2048) return n; if (n < 3072) return n + 72; if (n < 3144) return n - 1024; return -1; }
template <int MAP> __device__ __forceinline__ void tr_job(const float* W, int K, int Nsrc, const float* gs, bf16* WT, int Ndst, LAS float* scr, int& base, int gw, int NGW, int lane) {
    const int nblk = Ndst / 32, nitems = (K / 64) * nblk;
    int first = (gw - base) % NGW; if (first < 0) first += NGW;
    for (int it = first; it < nitems; it += NGW) {
        const int kb = it / nblk, nb = it % nblk, k0 = 64 * kb, n0 = 32 * nb;
        const int n = n0 + (lane & 31); const int src = MAP == 0 ? n : (MAP == 1 ? srcA(n) : srcB(n));
#pragma unroll 8
        for (int i = 0; i < 32; ++i) { const int kk = 2 * i + (lane >> 5); float v = 0.f; if (src >= 0) { v = W[(size_t)(k0 + kk) * Nsrc + src]; if (gs) v *= gs[k0 + kk]; } scr[kk * 33 + (lane & 31)] = v; }
        LDS_WAIT(); asm volatile("" ::: "memory");
        const int c = lane & 7;
#pragma unroll
        for (int j = 0; j < 4; ++j) { const int nn = (lane >> 3) + 8 * j; const LAS float* s = scr + (8 * c) * 33 + nn;
            v4u o; o.x = pk2(s[0 * 33], s[1 * 33]); o.y = pk2(s[2 * 33], s[3 * 33]); o.z = pk2(s[4 * 33], s[5 * 33]); o.w = pk2(s[6 * 33], s[7 * 33]);
            *(v4u*)(WT + (size_t)(n0 + nn) * K + k0 + 8 * c) = o; }
        LDS_WAIT(); asm volatile("" ::: "memory");
    }
    base = (base + nitems) % NGW;
}
__device__ __forceinline__ void sincos_d(double a, double& s, double& c) {
    const double k = rint(a * 0.63661977236758134308);
    double r = fma(-k, 1.5707963267948966192, a); r = fma(-k, 6.123233995736766e-17, r);
    const double r2 = r * r;
    double sp = -7.647163731819816e-13; sp = fma(sp, r2, 1.605904383682161e-10); sp = fma(sp, r2, -2.505210838544172e-08); sp = fma(sp, r2, 2.755731922398589e-06); sp = fma(sp, r2, -1.984126984126984e-04);
    sp = fma(sp, r2, 8.333333333333333e-03); sp = fma(sp, r2, -1.666666666666667e-01); const double sn = fma(sp * r2, r, r);
    double cp = 4.779477332387385e-14; cp = fma(cp, r2, -1.147074559772972e-11); cp = fma(cp, r2, 2.087675698786810e-09); cp = fma(cp, r2, -2.755731922398589e-07); cp = fma(cp, r2, 2.480158730158730e-05);
    cp = fma(cp, r2, -1.388888888888889e-03); cp = fma(cp, r2, 4.166666666666666e-02); cp = fma(cp, r2, -0.5); const double cs = fma(cp, r2, 1.0);
    const int q = (int)((long long)k & 3);
    s = (q == 0) ? sn : (q == 1) ? cs : (q == 2) ? -sn : -cs;
    c = (q == 0) ? cs : (q == 1) ? -sn : (q == 2) ? -cs : sn;
}
__device__ __forceinline__ void prologue(Ctx& C) {
    LAS float* scr = (LAS float*)(C.lds + C.wave * 16384);
    const int gw = C.bid * 8 + C.wave, NGW = C.G * 8, lane = C.lane; int base = 0;
    for (int j = 0; j < 2; ++j) {
        tr_job<1>(C.w_in_a + (size_t)j * D * NA_IN, D, NA_IN, C.g_norm + (2 * j) * D, WSP(bf16, WS_WINA + j * SZ_WINA), NA_IN, scr, base, gw, NGW, lane);
        tr_job<0>(C.w_out_a + (size_t)j * AW * D, AW, D, nullptr, WSP(bf16, WS_WOUTA + j * SZ_WOUTA), D, scr, base, gw, NGW, lane);
        tr_job<2>(C.w_in_b + (size_t)j * D * NB_SRC, D, NB_SRC, C.g_norm + (2 * j + 1) * D, WSP(bf16, WS_WINB + j * SZ_WINB), NB_IN, scr, base, gw, NGW, lane);
        tr_job<0>(C.w_out_b + (size_t)j * D * D, D, D, nullptr, WSP(bf16, WS_WOUTB + j * SZ_WSQ), D, scr, base, gw, NGW, lane);
    }
    for (int i = 0; i < 4; ++i) {
        tr_job<0>(C.w_pe_gate + (size_t)i * D * D, D, D, C.g_pe + i * D, WSP(bf16, WS_WGATE + i * SZ_WSQ), D, scr, base, gw, NGW, lane);
        tr_job<0>(C.w_pe_proj + (size_t)i * PD * D, PD, D, nullptr, WSP(bf16, WS_WPE + i * SZ_WPE), D, scr, base, gw, NGW, lane);
    }
    for (int r = gw; r < 4 * T; r += NGW) { const int i = r / T, m = r - i * T;
        const float* src = m < TP ? C.p_prompt + ((size_t)i * TP + m) * PD : C.p_sample + ((size_t)i * TS + (m - TP)) * PD;
        const f32x4 v = ((const f32x4*)src)[lane]; u32x2v w; w.x = cvtpk(v.x, v.y); w.y = cvtpk(v.z, v.w);
        ((u32x2v*)(WSP(bf16, WS_PB) + (size_t)r * PD))[lane] = w; }
    for (int m = gw; m < T; m += NGW) { const float* src = m < TP ? C.x_prompt + (size_t)m * D : C.x_sample + (size_t)(m - TP) * D; float s = 0.f;
        bf16* dst = WSP(bf16, WS_XB0) + (size_t)m * D;
#pragma unroll
        for (int j = 0; j < 4; ++j) { const f32x4 v = ((const f32x4*)src)[lane + 64 * j]; s += (v.x * v.x + v.y * v.y) + (v.z * v.z + v.w * v.w);
            u32x2v w; w.x = cvtpk(v.x, v.y); w.y = cvtpk(v.z, v.w); ((u32x2v*)dst)[lane + 64 * j] = w; }
        s = wave_sum(s); if (lane < 16) WSP(float, WS_SSX)[(size_t)m * 16 + lane] = lane == 0 ? s : 0.f; }
    for (int e = gw * 64 + lane; e < NPOS * 64; e += NGW * 64) { const int pos = e >> 6, i = e & 63; double inv = 1.0; for (int k = 0; k < i; ++k) inv *= 0.8659643233600653;
        double s, c; sincos_d((double)pos * inv, s, c); WSP(f32x2v, WS_ROPE)[e] = (f32x2v){(float)c, (float)s}; }
}

__device__ __forceinline__ s16x4 tr_read(LAS unsigned char* p) { return __builtin_bit_cast(s16x4, __builtin_amdgcn_ds_read_tr16_b64_v4i16((LAS s16x4*)p)); }
__device__ __forceinline__ int crow(int r, int hi) { return (r & 3) + 8 * (r >> 2) + 4 * hi; }
constexpr int GT_WM = 0, GT_WMS = 272, GT_V = 34816, GT_VS = 576, GT_RV = GT_V + 128 * GT_VS;
__device__ __forceinline__ void gate_phase(Ctx& C, int j) {
    const int tid = C.tid, lane = C.lane, w = C.wave, r32 = lane & 31, hi = lane >> 5;
    LAS unsigned char* lds = C.lds; LAS float* rvs = (LAS float*)(lds + GT_RV);
    const bf16* Vr = WSP(bf16, WS_VR); const bf16* UZ = WSP(bf16, WS_UZ); bf16* Y = WSP(bf16, WS_Y); const float* vss = WSP(float, WS_VSS);
    for (int unit = C.bid; unit < 136 * 8; unit += C.G) {
        const int tile = unit >> 3, g = unit & 7, row0 = tile * 128; const bool samp = tile >= 128;
        if (tid < 128) { const f32x4* p = (const f32x4*)(vss + (size_t)(row0 + tid) * 32); float s = 0.f;
#pragma unroll
            for (int i = 0; i < 8; ++i) { const f32x4 v = p[i]; s += (v.x + v.y) + (v.z + v.w); }
            rvs[tid] = rsq(s * (1.0f / AW) + EPS); }
        __syncthreads();
        { const float* wsg = C.w_s_a + (size_t)(j * 8 + g) * 128 * 128;
          const int t = tid >> 2, s0 = (tid & 3) * 32;
#pragma unroll 4
          for (int i = 0; i < 32; i += 2) { float v[2];
#pragma unroll
              for (int e = 0; e < 2; ++e) { const int s = s0 + i + e; bool ok; float wv;
                  if (!samp) { ok = s <= t; wv = wsg[t * 128 + s]; } else { ok = ((s >> 3) == (t >> 3)) && ((s & 7) <= (t & 7)); wv = wsg[(t & 7) * 128 + (s & 7)]; }
                  v[e] = ok ? wv * rvs[s] : 0.f; }
              *(LAS unsigned*)(lds + GT_WM + t * GT_WMS + (s0 + i) * 2) = cvtpk(v[0], v[1]); } }
#pragma unroll 2
        for (int i = 0; i < 8; ++i) { const int idx = tid + 512 * i, s = idx >> 5, c = (idx & 31) * 8;
            const v4u v = *(const v4u*)(Vr + (size_t)(row0 + s) * AW + g * 256 + c);
            *(LAS v4u*)(lds + GT_V + s * GT_VS + c * 2) = v;
            if (samp) { const int ms = row0 + s - TP, db = ms >> 3, tt = ms & 7; const float rv = rvs[s]; const float* gv = C.g_v_a + j * AW + g * 256 + c;
                float* o = C.out + O_CV + ((size_t)(db * 2 + j) * DSEQ + tt) * AW + g * 256 + c;
                f32x4 a, b; a.x = bflo(v.x) * rv * gv[0]; a.y = bfhi(v.x) * rv * gv[1]; a.z = bflo(v.y) * rv * gv[2]; a.w = bfhi(v.y) * rv * gv[3];
                b.x = bflo(v.z) * rv * gv[4]; b.y = bfhi(v.z) * rv * gv[5]; b.z = bflo(v.w) * rv * gv[6]; b.w = bfhi(v.w) * rv * gv[7];
                *(f32x4*)o = a; *(f32x4*)(o + 4) = b; } }
        __syncthreads();
        { LAS unsigned char* vb = lds + GT_V + (8 * hi + ((lane & 15) >> 2)) * GT_VS + (32 * w + 16 * ((lane >> 4) & 1) + 4 * (lane & 3)) * 2;
          bf16x8 Bf[8];
#pragma unroll
          for (int ks = 0; ks < 8; ++ks) { const s16x4 l = tr_read(vb + (16 * ks) * GT_VS), h = tr_read(vb + (16 * ks + 4) * GT_VS);
              Bf[ks] = (bf16x8){l[0], l[1], l[2], l[3], h[0], h[1], h[2], h[3]}; }
          const int ch = g * 256 + 32 * w + r32; const float gv = C.g_v_a[j * AW + ch]; const float* bs = C.b_s_a + (size_t)(j * 8 + g) * 128;
#pragma unroll
          for (int tb = 0; tb < 4; ++tb) { f32x16 acc = {};
#pragma unroll
              for (int ks = 0; ks < 8; ++ks) if (ks <= 2 * tb + 1) {
                  const bf16x8 af = *(LAS bf16x8*)(lds + GT_WM + (32 * tb + r32) * GT_WMS + (16 * ks + 8 * hi) * 2);
                  acc = __builtin_amdgcn_mfma_f32_32x32x16_bf16(af, Bf[ks], acc, 0, 0, 0); }
#pragma unroll
              for (int i = 0; i < 16; ++i) { const int t = 32 * tb + crow(i, hi); const size_t off = (size_t)(row0 + t) * AW + ch;
                  const float b = bs[samp ? (t & 7) : t]; const float y = bf2f(UZ[off]) * (gv * acc[i] + b); Y[off] = (bf16)f2bf(y); } } }
        __syncthreads();
    }
}

__device__ __forceinline__ void b1b_phase(Ctx& C, int j) {
    const int gw = C.bid * 8 + C.wave, NGW = C.G * 8, lane = C.lane;
    const bf16* RAW = WSP(bf16, WS_RAW); bf16* Q = WSP(bf16, WS_Q); bf16* KB = WSP(bf16, WS_KB); bf16* VB = WSP(bf16, WS_VB); bf16* IQ = WSP(bf16, WS_IQ); bf16* IKb = WSP(bf16, WS_IK);
    float* IW = WSP(float, WS_IW); bf16* SZ = WSP(bf16, WS_SZ); const f32x2v* rope = WSP(f32x2v, WS_ROPE);
    const float* gq = C.g_q_b + j * HD; const float* gk = C.g_k_b + j * HD; const float* gik = C.g_ik_b + j * IDXD;
    const float gq0 = gq[lane], gq1 = gq[64 + lane], gk0 = gk[lane], gk1 = gk[64 + lane], gi0 = gik[lane & 31], gi1 = gik[32 + (lane & 31)];
    for (int m = gw; m < T; m += NGW) {
        const bf16* raw = RAW + (size_t)m * NB_IN; int pos; float *ko, *vo, *iko;
        if (m < TP) { const int b = m >> 11, s = m & 2047; pos = s; const size_t r = (size_t)(b * 2 + j) * SEQ + s; ko = C.out + O_KP + r * KVW; vo = C.out + O_VP + r * KVW; iko = C.out + O_IKP + r * IDXD; }
        else { const int ms = m - TP, db = ms >> 3, t = ms & 7; pos = SEQ + t; const size_t r = (size_t)(db * 2 + j) * DSEQ + t; ko = C.out + O_KS + r * KVW; vo = C.out + O_VS + r * KVW; iko = C.out + O_IKS + r * IDXD; }
        const f32x2v cs = rope[pos * 64 + lane], cs2 = rope[pos * 64 + 2 * (lane & 31)];
#pragma unroll
        for (int h = 0; h < NH; ++h) { float a = bf2f(raw[h * 128 + lane]), b = bf2f(raw[h * 128 + 64 + lane]);
            const float r = rsq(wave_sum(a * a + b * b) * (1.0f / HD) + EPS); a *= r * gq0; b *= r * gq1;
            Q[(size_t)m * D + h * 128 + lane] = (bf16)f2bf(a * cs.x - b * cs.y); Q[(size_t)m * D + h * 128 + 64 + lane] = (bf16)f2bf(b * cs.x + a * cs.y); }
#pragma unroll
        for (int g = 0; g < NKV; ++g) { float a = bf2f(raw[1024 + g * 128 + lane]), b = bf2f(raw[1024 + g * 128 + 64 + lane]);
            const float r = rsq(wave_sum(a * a + b * b) * (1.0f / HD) + EPS); a *= r * gk0; b *= r * gk1;
            const float oa = a * cs.x - b * cs.y, ob = b * cs.x + a * cs.y;
            ko[g * 128 + lane] = oa; ko[g * 128 + 64 + lane] = ob; KB[(size_t)m * KVW + g * 128 + lane] = (bf16)f2bf(oa); KB[(size_t)m * KVW + g * 128 + 64 + lane] = (bf16)f2bf(ob); }
        { const u32x2v w = *(const u32x2v*)(raw + 1280 + 4 * lane); *(u32x2v*)(VB + (size_t)m * KVW + 4 * lane) = w;
          *(f32x4*)(vo + 4 * lane) = (f32x4){bflo(w.x), bfhi(w.x), bflo(w.y), bfhi(w.y)}; }
#pragma unroll
        for (int p = 0; p < 4; ++p) { const int hh = 2 * p + (lane >> 5), i = lane & 31; const float a = bf2f(raw[1536 + hh * 64 + i]), b = bf2f(raw[1536 + hh * 64 + 32 + i]);
            IQ[(size_t)m * 512 + hh * 64 + i] = (bf16)f2bf(a * cs2.x - b * cs2.y); IQ[(size_t)m * 512 + hh * 64 + 32 + i] = (bf16)f2bf(b * cs2.x + a * cs2.y); }
        { const int i = lane & 31; float a = bf2f(raw[3072 + i]), b = bf2f(raw[3072 + 32 + i]);
          const float r = rsq(wave_sum(lane < 32 ? a * a + b * b : 0.f) * (1.0f / IDXD) + EPS); a *= r * gi0; b *= r * gi1;
          const float oa = a * cs2.x - b * cs2.y, ob = b * cs2.x + a * cs2.y;
          if (lane < 32) { iko[i] = oa; iko[32 + i] = ob; IKb[(size_t)m * 64 + i] = (bf16)f2bf(oa); IKb[(size_t)m * 64 + 32 + i] = (bf16)f2bf(ob); } }
        if (lane < 8) IW[(size_t)m * 8 + lane] = bf2f(raw[3136 + lane]);
        { const v4u z0 = *(const v4u*)(raw + 2048 + 16 * lane), z1 = *(const v4u*)(raw + 2048 + 16 * lane + 8); v4u o0, o1;
#define SILU2(w) cvtpk(bflo(w) * sigm(bflo(w)), bfhi(w) * sigm(bfhi(w)))
          o0.x = SILU2(z0.x); o0.y = SILU2(z0.y); o0.z = SILU2(z0.z); o0.w = SILU2(z0.w); o1.x = SILU2(z1.x); o1.y = SILU2(z1.y); o1.z = SILU2(z1.z); o1.w = SILU2(z1.w);
#undef SILU2
          *(v4u*)(SZ + (size_t)m * D + 16 * lane) = o0; *(v4u*)(SZ + (size_t)m * D + 16 * lane + 8) = o1; }
    }
}

constexpr int SC_STRIDE = 2068;
__device__ __forceinline__ unsigned fkey(float x) { unsigned b = __builtin_bit_cast(unsigned, x); if (x == 0.f) b = 0u; return b ^ ((b >> 31) ? 0xffffffffu : 0x80000000u); }
__device__ __forceinline__ bf16x8 cvt8(const float* p) { const f32x4 a = *(const f32x4*)p, b = *(const f32x4*)(p + 4); v4u w; w.x = cvtpk(a.x, a.y); w.y = cvtpk(a.z, a.w); w.z = cvtpk(b.x, b.y); w.w = cvtpk(b.z, b.w); return __builtin_bit_cast(bf16x8, w); }
__device__ __forceinline__ void idx_phase(Ctx& C, int j) {
    const int lane = C.lane, wave = C.wave, fr = lane & 15, fq = lane >> 4;
    LAS float* sc = (LAS float*)C.lds;
    const bf16* IQ = WSP(bf16, WS_IQ); const bf16* IKb = WSP(bf16, WS_IK); const float* IW = WSP(float, WS_IW); u64* MASK = WSP(u64, WS_MASK);
    for (int unit = C.bid; unit < 1024 + DBATCH; unit += C.G) {
        const bool samp = unit >= 1024; int b = 0, qg = 0, db = 0, mq0, nkt;
        if (!samp) { b = unit >> 7; qg = unit & 127; mq0 = b * SEQ + 16 * qg; nkt = qg + 1; } else { db = unit - 1024; mq0 = TP + db * DSEQ; nkt = 129; }
        bf16x8 Af[8][2]; { const bf16* qp = IQ + (size_t)(mq0 + (samp ? (fr & 7) : fr)) * 512 + 8 * fq;
#pragma unroll
            for (int h = 0; h < 8; ++h) { Af[h][0] = *(const bf16x8*)(qp + h * 64); Af[h][1] = *(const bf16x8*)(qp + h * 64 + 32); } }
        float iwv[4][8];
#pragma unroll
        for (int r = 0; r < 4; ++r) { const int qi = 4 * fq + r; const float* ip = IW + (size_t)(mq0 + (samp ? (qi & 7) : qi)) * 8; const f32x4 a = *(const f32x4*)ip, c = *(const f32x4*)(ip + 4);
            iwv[r][0] = a.x; iwv[r][1] = a.y; iwv[r][2] = a.z; iwv[r][3] = a.w; iwv[r][4] = c.x; iwv[r][5] = c.y; iwv[r][6] = c.z; iwv[r][7] = c.w; }
        for (int kt = wave; kt < nkt; kt += 8) {
            const int key = 16 * kt + fr; bf16x8 B0, B1;
            if (!samp) { const bf16* kp = IKb + (size_t)(b * SEQ + key) * 64 + 8 * fq; B0 = *(const bf16x8*)kp; B1 = *(const bf16x8*)(kp + 32); }
            else if (key < SEQ) { const int page = C.page_table[db * NPAGES + (key >> 7)]; const float* kp = C.cache_ik + ((size_t)(page * 2 + j) * PAGE + (key & 127)) * IDXD + 8 * fq; B0 = cvt8(kp); B1 = cvt8(kp + 32); }
            else { const int t = key - SEQ; if (t < DSEQ) { const bf16* kp = IKb + (size_t)(TP + db * DSEQ + t) * 64 + 8 * fq; B0 = *(const bf16x8*)kp; B1 = *(const bf16x8*)(kp + 32); } else { B0 = (bf16x8){0, 0, 0, 0, 0, 0, 0, 0}; B1 = B0; } }
            f32x4 score = {0.f, 0.f, 0.f, 0.f};
#pragma unroll
            for (int h = 0; h < 8; ++h) { f32x4 acc = {0.f, 0.f, 0.f, 0.f};
                acc = __builtin_amdgcn_mfma_f32_16x16x32_bf16(Af[h][0], B0, acc, 0, 0, 0); acc = __builtin_amdgcn_mfma_f32_16x16x32_bf16(Af[h][1], B1, acc, 0, 0, 0);
#pragma unroll
                for (int r = 0; r < 4; ++r) score[r] = fmaf(iwv[r][h], fmaxf(acc[r], 0.f), score[r]); }
#pragma unroll
            for (int r = 0; r < 4; ++r) sc[(4 * fq + r) * SC_STRIDE + key] = score[r];
        }
        __syncthreads();
        for (int qq = 0; qq < (samp ? 1 : 2); ++qq) {
            const int qi = samp ? wave : 2 * wave + qq, qpos = samp ? SEQ + qi : 16 * qg + qi, n = qpos + 1;
            u64* mw = MASK + (size_t)(mq0 + qi) * MASKW; u64 myword = 0ull;
            if (n <= TOPK) { const int lo = 64 * lane; myword = (n >= lo + 64) ? ~0ull : (n > lo ? ((1ull << (n - lo)) - 1ull) : 0ull); }
            else {
                unsigned u[33];
#pragma unroll
                for (int i = 0; i < 33; ++i) { const int s = lane + 64 * i; u[i] = s < n ? fkey(sc[qi * SC_STRIDE + (s < SC_STRIDE ? s : 0)]) : 0u; }
                unsigned thr = 0u;
                for (int bit = 31; bit >= 0; --bit) { const unsigned cand = thr | (1u << bit); int cnt = 0;
#pragma unroll
                    for (int i = 0; i < 33; ++i) cnt += __popcll(__ballot(u[i] >= cand));
                    if (cnt >= TOPK) thr = cand; }
                int cgt = 0;
#pragma unroll
                for (int i = 0; i < 33; ++i) cgt += __popcll(__ballot(u[i] > thr));
                const int need = TOPK - cgt; int running = 0; const u64 ltmask = (1ull << lane) - 1ull;
#pragma unroll
                for (int i = 0; i < 33; ++i) { const bool eq = u[i] == thr; const u64 eb = __ballot(eq); const int rank = running + __popcll(eb & ltmask);
                    const u64 word = __ballot(u[i] > thr || (eq && rank < need)); running += __popcll(eb); if (lane == i) myword = word; }
            }
            if (lane < MASKW) mw[lane] = myword;
        }
        __syncthreads();
    }
}

__device__ __forceinline__ void attn_phase_gather(Ctx& C, int j) {
    const int lane = C.lane, gw = C.bid * 8 + C.wave, NGW = C.G * 8;
    LAS unsigned* idxl = (LAS unsigned*)(C.lds + C.wave * 8192); LAS float* qs = (LAS float*)(C.lds + C.wave * 8192 + 1024); LAS float* pl = (LAS float*)(C.lds + C.wave * 8192 + 3072);
    const u64* MASK = WSP(u64, WS_MASK); const bf16* Q = WSP(bf16, WS_Q); const bf16* SZ = WSP(bf16, WS_SZ); bf16* AO = WSP(bf16, WS_AO);
    const float scale = 0.08838834764831845f;
    for (int it = gw; it < 2 * T; it += NGW) {
        const int m = it >> 1, g = it & 1; const bool samp = m >= TP; int b = 0, db = 0;
        if (!samp) b = m >> 11; else db = (m - TP) >> 3;
        const float* kbase = samp ? C.out + O_KS + (size_t)(db * 2 + j) * DSEQ * KVW + g * HD : C.out + O_KP + (size_t)(b * 2 + j) * SEQ * KVW + g * HD;
        const float* vbase = samp ? C.out + O_VS + (size_t)(db * 2 + j) * DSEQ * KVW + g * HD : C.out + O_VP + (size_t)(b * 2 + j) * SEQ * KVW + g * HD;
        const u64* mw = MASK + (size_t)m * MASKW; int n = 0;
        for (int i = 0; i < MASKW; ++i) { const u64 word = mw[i]; const int pos = n + __popcll(word & ((1ull << lane) - 1ull)); if ((word >> lane) & 1ull) idxl[pos] = 64 * i + lane; n += __popcll(word); }
#pragma unroll
        for (int hh = 0; hh < 4; ++hh) { qs[hh * 128 + lane] = bf2f(Q[(size_t)m * D + (4 * g + hh) * 128 + lane]) * scale; qs[hh * 128 + 64 + lane] = bf2f(Q[(size_t)m * D + (4 * g + hh) * 128 + 64 + lane]) * scale; }
        LDS_WAIT(); asm volatile("" ::: "memory");
        const unsigned idx0 = idxl[0];
        float sv[4][4];
#pragma unroll
        for (int p = 0; p < 4; ++p) { const int kk = 64 * p + lane; const bool valid = kk < n; const unsigned kidx = valid ? idxl[kk] : idx0; if (!valid) idxl[kk] = idx0;
            const float* kr;
            if (!samp) kr = kbase + (size_t)kidx * KVW;
            else if (kidx < SEQ) { const int page = C.page_table[db * NPAGES + (kidx >> 7)]; kr = C.cache_k + ((size_t)(page * 2 + j) * PAGE + (kidx & 127)) * KVW + g * HD; }
            else kr = kbase + (size_t)(kidx - SEQ) * KVW;
            float s0 = 0.f, s1 = 0.f, s2 = 0.f, s3 = 0.f;
#pragma unroll 4
            for (int d = 0; d < HD; d += 4) { const f32x4 kv = *(const f32x4*)(kr + d); const f32x4 q0 = *(LAS f32x4*)(qs + d), q1 = *(LAS f32x4*)(qs + 128 + d), q2 = *(LAS f32x4*)(qs + 256 + d), q3 = *(LAS f32x4*)(qs + 384 + d);
                s0 += kv.x * q0.x + kv.y * q0.y + kv.z * q0.z + kv.w * q0.w; s1 += kv.x * q1.x + kv.y * q1.y + kv.z * q1.z + kv.w * q1.w;
                s2 += kv.x * q2.x + kv.y * q2.y + kv.z * q2.z + kv.w * q2.w; s3 += kv.x * q3.x + kv.y * q3.y + kv.z * q3.z + kv.w * q3.w; }
            sv[p][0] = valid ? s0 : -1e30f; sv[p][1] = valid ? s1 : -1e30f; sv[p][2] = valid ? s2 : -1e30f; sv[p][3] = valid ? s3 : -1e30f; }
        float linv[4];
#pragma unroll
        for (int hh = 0; hh < 4; ++hh) { const float mx = wave_max(fmaxf(fmaxf(sv[0][hh], sv[1][hh]), fmaxf(sv[2][hh], sv[3][hh]))); float l = 0.f;
#pragma unroll
            for (int p = 0; p < 4; ++p) { const float e = (64 * p + lane < n) ? __expf(sv[p][hh] - mx) : 0.f; sv[p][hh] = e; l += e; }
            linv[hh] = 1.0f / wave_sum(l); }
#pragma unroll
        for (int p = 0; p < 4; ++p) *(LAS f32x4*)(pl + (64 * p + lane) * 4) = (f32x4){sv[p][0], sv[p][1], sv[p][2], sv[p][3]};
        LDS_WAIT(); asm volatile("" ::: "memory");
        float o[4][2] = {{0.f, 0.f}, {0.f, 0.f}, {0.f, 0.f}, {0.f, 0.f}};
        const int nn = (n + 7) & ~7;
        for (int k0 = 0; k0 < nn; k0 += 8) {
#pragma unroll
            for (int e = 0; e < 8; ++e) { const unsigned kidx = (unsigned)__builtin_amdgcn_readfirstlane((int)idxl[k0 + e]); const float* vr;
                if (!samp) vr = vbase + (size_t)kidx * KVW;
                else if (kidx < SEQ) { const int page = C.page_table[db * NPAGES + (kidx >> 7)]; vr = C.cache_v + ((size_t)(page * 2 + j) * PAGE + (kidx & 127)) * KVW + g * HD; }
                else vr = vbase + (size_t)(kidx - SEQ) * KVW;
                const f32x2v v = *(const f32x2v*)(vr + 2 * lane); const f32x4 pv = *(LAS f32x4*)(pl + (k0 + e) * 4);
                o[0][0] += pv.x * v.x; o[0][1] += pv.x * v.y; o[1][0] += pv.y * v.x; o[1][1] += pv.y * v.y; o[2][0] += pv.z * v.x; o[2][1] += pv.z * v.y; o[3][0] += pv.w * v.x; o[3][1] += pv.w * v.y; }
        }
#pragma unroll
        for (int hh = 0; hh < 4; ++hh) { const size_t col = (size_t)m * D + (4 * g + hh) * 128 + 2 * lane; const unsigned sz = *(const unsigned*)(SZ + col);
            *(unsigned*)(AO + col) = cvtpk(o[hh][0] * linv[hh] * bflo(sz), o[hh][1] * linv[hh] * bfhi(sz)); }
        LDS_WAIT(); asm volatile("" ::: "memory");
    }
}

#ifndef ONLY_PHASE
#define PHASE_ON(k) true
#else
#define PHASE_ON(k) ((k) == ONLY_PHASE)
#endif
#define IN(k) (PHASE_ON(k) && lo <= (k) && (k) < hi)
#define SEAM(k) do { if (lo <= (k) && (k) + 1 < hi) xcd_barrier(bar); } while (0)
template <int jj> __device__ __forceinline__ void layer_pair(Ctx& C, const XcdBarrier& bar, const int lo, const int hi) {
    LAS unsigned char* ring = C.lds;
        const int ia = 2 * jj, ib = 2 * jj + 1, pb = 1 + 10 * jj;
        if (IN(pb)) { pg8::Gemm g{WSP(bf16, WS_XB0), WSP(bf16, WS_WINA + jj * SZ_WINA), T, NA_IN, D}; pg8::StaticOrder S; S.init(T, NA_IN, C.G, C.bid);
            EpiA1 E{WSP(float, WS_SSX), WSP(bf16, WS_UZ), WSP(bf16, WS_VR), WSP(float, WS_VSS)}; pg8::gemm_phase<EpiA1, pg8::StaticOrder, true, true>(ring, g, S, E); }
        SEAM(pb);
        if (IN(pb + 1)) gate_phase(C, jj);
        SEAM(pb + 1);
        if (IN(pb + 2)) {
            { pg8::Gemm g{WSP(bf16, WS_Y), WSP(bf16, WS_WOUTA + jj * SZ_WOUTA), T, D, AW}; pg8::StaticOrder S; S.init(T, D, C.G, C.bid);
              EpiRes E{jj == 0 ? C.x_prompt : WSP(float, WS_XF0), jj == 0 ? C.x_sample : WSP(float, WS_XF0) + (size_t)TP * D, WSP(float, WS_XF1), WSP(bf16, WS_XB1), WSP(float, WS_SS1)};
              pg8::gemm_phase<EpiRes, pg8::StaticOrder, true, true>(ring, g, S, E); }
            { pg8::Gemm g{WSP(bf16, WS_PB + ia * SZ_PB), WSP(bf16, WS_WPE + ia * SZ_WPE), T, D, PD}; pg8::StaticOrder S; S.init(T, D, C.G, C.bid);
              EpiBf16S E{nullptr, WSP(bf16, WS_PE), D}; pg8::gemm_phase<EpiBf16S, pg8::StaticOrder, true, true>(ring, g, S, E); } }
        SEAM(pb + 2);
        if (IN(pb + 3)) { pg8::Gemm g{WSP(bf16, WS_XB1), WSP(bf16, WS_WGATE + ia * SZ_WSQ), T, D, D}; pg8::StaticOrder S; S.init(T, D, C.G, C.bid);
            EpiGate E{WSP(float, WS_SS1), WSP(float, WS_XF1), WSP(bf16, WS_PE), WSP(float, WS_XF0), WSP(bf16, WS_XB0), WSP(float, WS_SSX)}; pg8::gemm_phase<EpiGate, pg8::StaticOrder, true, true>(ring, g, S, E); }
        SEAM(pb + 3);
        if (IN(pb + 4)) { pg8::Gemm g{WSP(bf16, WS_XB0), WSP(bf16, WS_WINB + jj * SZ_WINB), T, NB_IN, D}; pg8::StaticOrder S; S.init(T, NB_IN, C.G, C.bid);
            EpiBf16S E{WSP(float, WS_SSX), WSP(bf16, WS_RAW), NB_IN}; pg8::gemm_phase<EpiBf16S, pg8::StaticOrder, true, true>(ring, g, S, E); }
        SEAM(pb + 4);
        if (IN(pb + 5)) b1b_phase(C, jj);
        SEAM(pb + 5);
        if (IN(pb + 6)) idx_phase(C, jj);
        SEAM(pb + 6);
        if (IN(pb + 7)) attn_phase_gather(C, jj);
        SEAM(pb + 7);
        if (IN(pb + 8)) {
            { pg8::Gemm g{WSP(bf16, WS_AO), WSP(bf16, WS_WOUTB + jj * SZ_WSQ), T, D, D}; pg8::StaticOrder S; S.init(T, D, C.G, C.bid);
              EpiRes E{WSP(float, WS_XF0), WSP(float, WS_XF0) + (size_t)TP * D, WSP(float, WS_XF1), WSP(bf16, WS_XB1), WSP(float, WS_SS1)};
              pg8::gemm_phase<EpiRes, pg8::StaticOrder, true, true>(ring, g, S, E); }
            { pg8::Gemm g{WSP(bf16, WS_PB + ib * SZ_PB), WSP(bf16, WS_WPE + ib * SZ_WPE), T, D, PD}; pg8::StaticOrder S; S.init(T, D, C.G, C.bid);
              EpiBf16S E{nullptr, WSP(bf16, WS_PE), D}; pg8::gemm_phase<EpiBf16S, pg8::StaticOrder, true, true>(ring, g, S, E); } }
        SEAM(pb + 8);
        if (IN(pb + 9)) { pg8::Gemm g{WSP(bf16, WS_XB1), WSP(bf16, WS_WGATE + ib * SZ_WSQ), T, D, D}; pg8::StaticOrder S; S.init(T, D, C.G, C.bid);
            EpiGate E{WSP(float, WS_SS1), WSP(float, WS_XF1), WSP(bf16, WS_PE), jj == 1 ? C.out + O_Y : WSP(float, WS_XF0), WSP(bf16, WS_XB0), WSP(float, WS_SSX)}; pg8::gemm_phase<EpiGate, pg8::StaticOrder, true, true>(ring, g, S, E); }
        SEAM(pb + 9);
    }
constexpr int CW_BAR = 4096;
constexpr int N_PHASES = 21;
__global__ void __launch_bounds__(512, 2) fwd(Args args) {
    extern __shared__ __attribute__((aligned(16))) unsigned char lds_raw[];
    Ctx C; C.lds = (LAS unsigned char*)lds_raw; C.tid = threadIdx.x; C.lane = C.tid & 63; C.wave = __builtin_amdgcn_readfirstlane(C.tid >> 6); C.G = gridDim.x; C.bid = blockIdx.x;
    C.x_prompt = (const float*)args.in[0]; C.x_sample = (const float*)args.in[1]; C.cache_k = (const float*)args.in[2]; C.cache_v = (const float*)args.in[3]; C.cache_ik = (const float*)args.in[4];
    C.page_table = (const int*)args.in[5]; C.p_prompt = (const float*)args.in[6]; C.p_sample = (const float*)args.in[7]; C.g_norm = (const float*)args.in[8]; C.w_in_a = (const float*)args.in[9];
    C.w_s_a = (const float*)args.in[10]; C.b_s_a = (const float*)args.in[11]; C.g_v_a = (const float*)args.in[12]; C.w_out_a = (const float*)args.in[13]; C.w_in_b = (const float*)args.in[14];
    C.g_q_b = (const float*)args.in[15]; C.g_k_b = (const float*)args.in[16]; C.g_ik_b = (const float*)args.in[17]; C.w_out_b = (const float*)args.in[18]; C.g_pe = (const float*)args.in[19];
    C.w_pe_gate = (const float*)args.in[20]; C.w_pe_proj = (const float*)args.in[21]; C.out = args.out; C.ws = args.ws;
    volatile LAS unsigned* MISC = (volatile LAS unsigned*)(C.lds + MISC_OFF);
    if (C.tid < 64) MISC[C.tid] = 0u;
    __syncthreads();
    const int lo = args.ph_lo, hi = args.ph_hi;
    XcdBarrier bar; bar.bar = (unsigned*)(C.ws + WS_CTL) + CW_BAR; bar.x = 0; bar.st = nullptr;
    if (hi - lo > 1) bar = xcd_barrier_post((unsigned*)(C.ws + WS_CTL) + CW_BAR, MISC + 8);
    LAS unsigned char* ring = C.lds;
    if (IN(0)) prologue(C);
    SEAM(0);
    layer_pair<0>(C, bar, lo, hi);
    layer_pair<1>(C, bar, lo, hi);
#undef IN
#undef SEAM
}

#ifndef MK_FUSED
#define MK_FUSED 0
#endif
extern "C" void kernel_launch(void* const* d_in, const int* in_sizes, int n_in, void* d_out, int out_size, void* d_ws, size_t ws_size, hipStream_t stream) {
    static int grid = 0;
    if (grid == 0) {
        if (n_in != 22 || out_size != (int)O_END || ws_size < WS_END) { fprintf(stderr, "kernel_launch: shape mismatch n_in %d out %d ws %zu (need %zu)\n", n_in, out_size, ws_size, (size_t)WS_END); grid = -1; return; }
        int dev = 0, cus = 0, per_cu = 0;
        if (hipGetDevice(&dev) != hipSuccess || hipDeviceGetAttribute(&cus, hipDeviceAttributeMultiprocessorCount, dev) != hipSuccess) { grid = -1; return; }
        if (hipFuncSetAttribute((const void*)fwd, hipFuncAttributeMaxDynamicSharedMemorySize, LDS_BYTES) != hipSuccess) { fprintf(stderr, "kernel_launch: hipFuncSetAttribute failed\n"); grid = -1; return; }
        if (hipOccupancyMaxActiveBlocksPerMultiprocessor(&per_cu, (const void*)fwd, 512, LDS_BYTES) != hipSuccess || per_cu < 1) fprintf(stderr, "kernel_launch: occupancy query says %d\n", per_cu);
        (void)hipGetLastError();
        grid = cus;
    }
    if (grid < 0) return;
    if (hipMemsetAsync((char*)d_ws + WS_CTL, 0, CTL_BYTES, stream) != hipSuccess) return;
    Args a{};
    for (int i = 0; i < 22; ++i) a.in[i] = d_in[i];
    a.out = (float*)d_out; a.ws = (unsigned char*)d_ws;
#if MK_FUSED
    a.ph_lo = 0; a.ph_hi = N_PHASES;
    hipLaunchKernelGGL(fwd, dim3(grid), dim3(512), LDS_BYTES, stream, a);
#else
    for (int p = 0; p < N_PHASES; ++p) { a.ph_lo = p; a.ph_hi = p + 1; hipLaunchKernelGGL(fwd, dim3(grid), dim3(512), LDS_BYTES, stream, a); }
#endif
    const hipError_t le = hipPeekAtLastError();
    if (le != hipSuccess) fprintf(stderr, "kernel_launch: launch failed: %s\n", hipGetErrorName(le));
}
```

```cpp
#include <hip/hip_runtime.h>
#include <cstdio>
#include <cstdint>
namespace pg8 {
#define PG8_LAS __attribute__((address_space(3)))
typedef unsigned short bf16_t;
typedef short bf16x8 __attribute__((ext_vector_type(8)));
typedef float f32x4 __attribute__((ext_vector_type(4)));
typedef unsigned u32x4 __attribute__((ext_vector_type(4)));
constexpr int BM = 256, BK = 64, HALF = 128, HTB = HALF * BK * 2  , STAGE_BYTES = 8 * HTB, NXCD = 8, WGM = 4;

__host__ __device__ __forceinline__ int lds_byte(int r, int c) { const int st = (r >> 4) * 2 + (c >> 5), rr = r & 15, cc = c & 31, ob = rr * 64 + cc * 2; return st * 1024 + (ob ^ (((ob >> 9) & 1) << 5)); }
__host__ __device__ __forceinline__ void stage_rc(int b, int& R, int& C) { const int st = b / 1024, sb = b % 1024, swz = sb ^ (((sb >> 9) & 1) << 5); R = (st >> 1) * 16 + swz / 64; C = (st & 1) * 32 + (swz % 64) / 2; }
__host__ __device__ __forceinline__ int perm32(int rho) { const int n = rho >> 4, i = rho & 15; return 8 * (i >> 2) + 4 * n + (i & 3); }

struct Unit { int pm, pn; };
struct Gemm { const bf16_t* A; const bf16_t* Bt; int M, N, K; };

struct StaticOrder {
    int nM, nN, nwg, G, c;
    __host__ __device__ void init(int M, int N, int G_, int c_) { nM = M / BM; nN = N / BM; nwg = nM * nN; G = G_; c = c_; }
    __host__ __device__ bool next(int i, Unit& u) const {
        const long L = (long)i * G + c; if (L >= nwg) return false;
        int wgid = (int)L; { const int q = nwg / NXCD, r = nwg % NXCD, xcd = wgid % NXCD, off = wgid / NXCD; wgid = (xcd < r ? xcd * (q + 1) : r * (q + 1) + (xcd - r) * q) + off; }
        const int nig = WGM * nN, gid = wgid / nig, fm = gid * WGM, gsz = (nM - fm) < WGM ? (nM - fm) : WGM;
        u.pm = fm + ((wgid % nig) % gsz); u.pn = (wgid % nig) / gsz; return true;
    }
    __device__ __forceinline__ void a_ready(const Unit&) const {}
    __device__ __forceinline__ void done(const Unit&) const {}
};
__device__ __forceinline__ unsigned cvt_pk_bf16(float lo, float hi) { unsigned r; asm volatile("v_cvt_pk_bf16_f32 %0, %1, %2" : "=v"(r) : "v"(lo), "v"(hi)); return r; }
typedef float f32x2 __attribute__((ext_vector_type(2)));
template <class Epi, class Sched, bool ALIGN_EPI = false, bool SP2 = false>
__device__ __forceinline__ void gemm_phase(PG8_LAS unsigned char* lds, const Gemm g, const Sched& S, const Epi& E) {
    const int tid = threadIdx.x, wid = __builtin_amdgcn_readfirstlane(tid >> 6), lane = tid & 63, wr = wid >> 2, wc = wid & 3, fr = lane & 15, fq = lane >> 4;
    const int K = g.K, nt = K / BK;
    unsigned voffA[2], voffB[2];
#pragma unroll
    for (int i = 0; i < 2; ++i) { int R, C; stage_rc(tid * 16 + i * 8192, R, C); const int Rb = Epi::PERM ? ((R & ~31) + perm32(R & 31)) : R;
        voffA[i] = (unsigned)(R * K + C) * 2u; voffB[i] = (unsigned)(Rb * K + C) * 2u; }
    const size_t kstep = (size_t)(BK * 2);
    const size_t hstep = (size_t)HALF * K * 2;
    const size_t tstep = 2 * hstep;
    const unsigned ldsw = (unsigned)wid * 1024u;
    const int aoff = lds_byte(wr * 64 + fr, fq * 8), boff = lds_byte(wc * 32 + fr, fq * 8);
#define PG8_SA(b, h) (((b) * 2 + (h)) * HTB)
#define PG8_SB(b, h) ((4 + (b) * 2 + (h)) * HTB)
#define PG8_STAGE(bufoff, gbase, voff) do { _Pragma("unroll") for (int _i = 0; _i < 2; ++_i) \
        __builtin_amdgcn_global_load_lds((const unsigned*)((const char*)(gbase) + (voff)[_i]), (PG8_LAS unsigned*)(lds + (bufoff) + ldsw + _i * 8192), 16, 0, 0); } while (0)
#define PG8_LDA(dst, b, h) do { _Pragma("unroll") for (int m = 0; m < 4; ++m) _Pragma("unroll") for (int k = 0; k < 2; ++k) dst[m][k] = *(const PG8_LAS bf16x8*)(lds + PG8_SA(b, h) + aoff + m * 2048 + k * 1024); } while (0)
#define PG8_LDB(dst, b, h) do { _Pragma("unroll") for (int n = 0; n < 2; ++n) _Pragma("unroll") for (int k = 0; k < 2; ++k) dst[n][k] = *(const PG8_LAS bf16x8*)(lds + PG8_SB(b, h) + boff + n * 2048 + k * 1024); } while (0)
#define PG8_MMA(ai, bj, At, Bt) do { __builtin_amdgcn_s_setprio(1); _Pragma("unroll") for (int m = 0; m < 4; ++m) _Pragma("unroll") for (int n = 0; n < 2; ++n) _Pragma("unroll") for (int k = 0; k < 2; ++k) \
        acc[ai][bj][m][n] = __builtin_amdgcn_mfma_f32_16x16x32_bf16(Bt[n][k], At[m][k], acc[ai][bj][m][n], 0, 0, 0); __builtin_amdgcn_s_setprio(0); } while (0)
#define PG8_WAIT_V(n) asm volatile("s_waitcnt vmcnt(" #n ")" ::: "memory")
#define PG8_WAIT_L(n) asm volatile("s_waitcnt lgkmcnt(" #n ")" ::: "memory")
#define PG8_BAR __builtin_amdgcn_s_barrier()
#define PG8_SCHED __builtin_amdgcn_sched_barrier(0)
    Unit cur, nxt; int ui = 0;
    if (!S.next(0, cur)) return;
    f32x4 acc[2][2][4][2];
#pragma unroll
    for (int a = 0; a < 2; ++a)
#pragma unroll
        for (int b = 0; b < 2; ++b)
#pragma unroll
            for (int m = 0; m < 4; ++m)
#pragma unroll
                for (int n = 0; n < 2; ++n) acc[a][b][m][n] = (f32x4){0.f, 0.f, 0.f, 0.f};
    bf16x8 At[4][2], B0[2][2], B1[2][2];
    const char* cA = (const char*)g.A + (size_t)cur.pm * tstep; const char* cB = (const char*)g.Bt + (size_t)cur.pn * tstep;
    S.a_ready(cur);
    if constexpr (SP2) {
        PG8_STAGE(PG8_SB(0, 0), cB, voffB); PG8_STAGE(PG8_SB(0, 1), cB + hstep, voffB); PG8_STAGE(PG8_SA(0, 0), cA, voffA); PG8_STAGE(PG8_SA(0, 1), cA + hstep, voffA);
        if (wr == 1) PG8_BAR;
        PG8_WAIT_V(2); PG8_BAR;
        PG8_STAGE(PG8_SB(1, 0), cB + kstep, voffB); PG8_STAGE(PG8_SA(1, 0), cA + kstep, voffA); PG8_STAGE(PG8_SB(1, 1), cB + hstep + kstep, voffB);
        PG8_WAIT_V(6); PG8_BAR;
    } else {
        PG8_STAGE(PG8_SB(0, 0), cB, voffB); PG8_STAGE(PG8_SA(0, 0), cA, voffA); PG8_STAGE(PG8_SB(0, 1), cB + hstep, voffB); PG8_STAGE(PG8_SA(0, 1), cA + hstep, voffA);
        if (wr == 1) PG8_BAR;
        PG8_WAIT_V(4); PG8_BAR;
        PG8_STAGE(PG8_SB(1, 0), cB + kstep, voffB); PG8_STAGE(PG8_SA(1, 0), cA + kstep, voffA); PG8_STAGE(PG8_SB(1, 1), cB + hstep + kstep, voffB);
        PG8_WAIT_V(6); PG8_BAR;
    }
    for (;;) {
        const bool has_next = S.next(ui + 1, nxt);
        const char* nA = has_next ? (const char*)g.A + (size_t)nxt.pm * tstep : cA; const char* nB = has_next ? (const char*)g.Bt + (size_t)nxt.pn * tstep : cB;
#pragma clang loop unroll(disable)
        for (int t = 0; t < nt; t += 2) {
            const bool last = (t == nt - 2);
            const char* a1 = cA + (size_t)(t + 1) * kstep;
            const char* a2 = last ? nA : cA + (size_t)(t + 2) * kstep; const char* b2 = last ? nB : cB + (size_t)(t + 2) * kstep;
            const char* a3 = a2 + kstep; const char* b3 = b2 + kstep;
            if (last && has_next) S.a_ready(nxt);
            if constexpr (SP2) {
            PG8_LDB(B0, 0, 0); PG8_LDB(B1, 0, 1); PG8_SCHED; PG8_LDA(At, 0, 0); PG8_STAGE(PG8_SA(1, 1), a1 + hstep, voffA);
            PG8_WAIT_V(8); PG8_WAIT_L(0); PG8_BAR; PG8_MMA(0, 0, At, B0); PG8_MMA(0, 1, At, B1); PG8_BAR; PG8_SCHED;
            PG8_LDA(At, 0, 1); PG8_STAGE(PG8_SB(0, 0), b2, voffB); PG8_STAGE(PG8_SB(0, 1), b2 + hstep, voffB); PG8_STAGE(PG8_SA(0, 0), a2, voffA);
            PG8_WAIT_V(8); PG8_WAIT_L(0); PG8_BAR; PG8_MMA(1, 0, At, B0); PG8_MMA(1, 1, At, B1); PG8_BAR; PG8_SCHED;
            PG8_LDB(B0, 1, 0); PG8_LDB(B1, 1, 1); PG8_SCHED; PG8_LDA(At, 1, 0); PG8_STAGE(PG8_SA(0, 1), a2 + hstep, voffA);
            PG8_WAIT_V(8); PG8_WAIT_L(0); PG8_BAR; PG8_MMA(0, 0, At, B0); PG8_MMA(0, 1, At, B1); PG8_BAR; PG8_SCHED;
            PG8_LDA(At, 1, 1); PG8_STAGE(PG8_SB(1, 0), b3, voffB); PG8_STAGE(PG8_SB(1, 1), b3 + hstep, voffB); PG8_STAGE(PG8_SA(1, 0), a3, voffA);
            PG8_WAIT_V(8); PG8_WAIT_L(0); PG8_BAR; PG8_MMA(1, 0, At, B0); PG8_MMA(1, 1, At, B1); PG8_BAR; PG8_SCHED;
            } else {
            PG8_LDB(B0, 0, 0); PG8_SCHED; PG8_LDA(At, 0, 0); PG8_STAGE(PG8_SA(1, 1), a1 + hstep, voffA);
            PG8_WAIT_L(8); PG8_BAR; PG8_WAIT_L(0); PG8_MMA(0, 0, At, B0); PG8_BAR; PG8_SCHED;
            PG8_LDB(B1, 0, 1); PG8_STAGE(PG8_SB(0, 0), b2, voffB);
            PG8_BAR; PG8_WAIT_L(0); PG8_MMA(0, 1, At, B1); PG8_BAR;
            PG8_LDA(At, 0, 1); PG8_STAGE(PG8_SA(0, 0), a2, voffA);
            PG8_BAR; PG8_WAIT_L(0); PG8_MMA(1, 0, At, B0); PG8_BAR; PG8_SCHED;
            PG8_STAGE(PG8_SB(0, 1), b2 + hstep, voffB);
            PG8_WAIT_V(6); PG8_BAR; PG8_MMA(1, 1, At, B1); PG8_BAR;
            PG8_LDB(B0, 1, 0); PG8_SCHED; PG8_LDA(At, 1, 0); PG8_STAGE(PG8_SA(0, 1), a2 + hstep, voffA);
            PG8_WAIT_L(8); PG8_BAR; PG8_WAIT_L(0); PG8_MMA(0, 0, At, B0); PG8_BAR; PG8_SCHED;
            PG8_LDB(B1, 1, 1); PG8_STAGE(PG8_SB(1, 0), b3, voffB);
            PG8_BAR; PG8_WAIT_L(0); PG8_MMA(0, 1, At, B1); PG8_BAR;
            PG8_LDA(At, 1, 1); PG8_STAGE(PG8_SA(1, 0), a3, voffA);
            PG8_BAR; PG8_WAIT_L(0); PG8_MMA(1, 0, At, B0); PG8_BAR; PG8_SCHED;
            PG8_STAGE(PG8_SB(1, 1), b3 + hstep, voffB);
            PG8_WAIT_V(6); PG8_BAR; PG8_MMA(1, 1, At, B1); PG8_BAR;
            }
        }
        if constexpr (ALIGN_EPI) { if (wr == 0) PG8_BAR; }
        if constexpr (!Epi::AFTER_DRAIN) { E(acc, cur, wr, wc, fr, fq); S.done(cur); }
        if (!has_next) break;
#pragma unroll
        for (int a = 0; a < 2; ++a)
#pragma unroll
            for (int b = 0; b < 2; ++b)
#pragma unroll
                for (int m = 0; m < 4; ++m)
#pragma unroll
                    for (int n = 0; n < 2; ++n) acc[a][b][m][n] = (f32x4){0.f, 0.f, 0.f, 0.f};
        cur = nxt; cA = nA; cB = nB; ++ui;
        if constexpr (ALIGN_EPI) { if (wr == 1) PG8_BAR; }
    }
    PG8_WAIT_V(0);
    if constexpr (!ALIGN_EPI) { if (wr == 0) PG8_BAR; }
    PG8_BAR;
    if constexpr (Epi::AFTER_DRAIN) { E.fused(acc, cur, wr, wc, fr, fq, lds, wid, lane); S.done(cur); }
#undef PG8_SA
#undef PG8_SB
#undef PG8_STAGE
#undef PG8_LDA
#undef PG8_LDB
#undef PG8_MMA
#undef PG8_WAIT_V
#undef PG8_WAIT_L
#undef PG8_BAR
#undef PG8_SCHED
}
}
#define GAS __attribute__((address_space(1)))
#define LAS __attribute__((address_space(3)))
typedef unsigned short bf16;
typedef unsigned v4u __attribute__((ext_vector_type(4)));
typedef float f32x4 __attribute__((ext_vector_type(4)));
typedef short bf16x8 __attribute__((ext_vector_type(8)));
typedef GAS unsigned gu32;
typedef GAS unsigned long long gu64;
#define RLX_AGENT __ATOMIC_RELAXED, __HIP_MEMORY_SCOPE_AGENT
#define LDS_WAIT() asm volatile("s_waitcnt lgkmcnt(0)" ::: "memory")
#define VM_WAIT() asm volatile("s_waitcnt vmcnt(0)" ::: "memory")
__device__ __forceinline__ unsigned long long rt() { return __builtin_amdgcn_s_memrealtime(); }
__device__ __forceinline__ unsigned f2bf(float f) { unsigned u = __builtin_bit_cast(unsigned, f); return (u + 0x7fffu + ((u >> 16) & 1u)) >> 16; }
__device__ __forceinline__ unsigned pk2(float lo, float hi) { return f2bf(lo) | (f2bf(hi) << 16); }

#define XB_TMO      128
#define XB_XCNT(j)  (256  + 64 * (j))
#define XB_XSUB(j)  (1280 + 64 * (j))
#define XB_XGEN(j)  (2304 + 64 * (j))
#define XB_TOP      3328
#define XB_TOPGEN   3392
#define XCD_BAR_WORDS 3456
#define XB_SPIN_CAP (1u << 18)

__device__ __forceinline__ unsigned xb_ld(unsigned* p)              { return __hip_atomic_load(p, __ATOMIC_RELAXED, __HIP_MEMORY_SCOPE_AGENT); }
__device__ __forceinline__ unsigned xb_add(unsigned* p, unsigned v) { return __hip_atomic_fetch_add(p, v, __ATOMIC_RELAXED, __HIP_MEMORY_SCOPE_AGENT); }
__device__ __forceinline__ unsigned xb_xcc_id() { return (unsigned)__builtin_amdgcn_s_getreg((3 << 11) | 20) & 0xFu; }
#define XB_SPIN(cond, bar) do { unsigned _sp = 0; while (cond) { __builtin_amdgcn_s_sleep(1); \
    if ((++_sp & 255u) == 0u) { if (xb_ld(&(bar)[XB_TMO])) break; if (_sp > XB_SPIN_CAP) { atomicAdd(&(bar)[XB_TMO], 1u); break; } } } } while (0)

struct XcdBarrier {
    unsigned* bar; unsigned x;
    volatile LAS unsigned* st;
};

__device__ __forceinline__ XcdBarrier xcd_barrier_post(unsigned* bar, volatile LAS unsigned* st) {
    XcdBarrier b; b.bar = bar; b.x = xb_xcc_id(); b.st = st;
    if (threadIdx.x == 0) (void)xb_add(&bar[XB_XCNT(b.x)], 1u);
    return b;
}
__device__ __forceinline__ void xcd_barrier_complete(unsigned* bar, unsigned x, unsigned& nloc, unsigned& nx) {
    const unsigned G = gridDim.x * gridDim.y * gridDim.z;
    unsigned sum, cnt, mine, sp = 0u;
    for (;;) {
        sum = 0u; cnt = 0u; mine = 0u;
#pragma unroll
        for (unsigned j = 0; j < 16; ++j) { const unsigned c = xb_ld(&bar[XB_XCNT(j)]); sum += c; cnt += (c > 0u) ? 1u : 0u; mine = (j == x) ? c : mine; }
        if (sum == G) break;
        __builtin_amdgcn_s_sleep(1);
        if ((++sp & 255u) == 0u) { if (xb_ld(&bar[XB_TMO])) break; if (sp > XB_SPIN_CAP) { atomicAdd(&bar[XB_TMO], 1u); break; } }
    }
    nloc = mine > 0u ? mine : 1u; nx = cnt > 0u ? cnt : 1u;
}

__device__ __forceinline__ void xcd_barrier(const XcdBarrier& b) {
    asm volatile("s_waitcnt vmcnt(0)" ::: "memory");
    __syncthreads();
    if (threadIdx.x == 0) {
        unsigned* bar = b.bar;
        __builtin_amdgcn_s_waitcnt(0);
        unsigned nloc = b.st[0], nx = b.st[1];
        if (nloc == 0u) { xcd_barrier_complete(bar, b.x, nloc, nx); b.st[0] = nloc; b.st[1] = nx; }
        const unsigned old = xb_add(&bar[XB_XSUB(b.x)], 1u);
        const unsigned gen = old / nloc;
        if (old + 1u == (gen + 1u) * nloc) {
            __builtin_amdgcn_fence(__ATOMIC_RELEASE, "agent");
            asm volatile("s_waitcnt vmcnt(0)" ::: "memory");
            const unsigned og = xb_add(&bar[XB_TOP], 1u);
            const unsigned tg = og / nx;
            if (og + 1u == (tg + 1u) * nx) xb_add(&bar[XB_TOPGEN], 1u);
            else XB_SPIN(xb_ld(&bar[XB_TOPGEN]) == tg, bar);
            __builtin_amdgcn_fence(__ATOMIC_ACQUIRE, "agent");
            xb_add(&bar[XB_XGEN(b.x)], 1u);
            asm volatile("s_waitcnt vmcnt(0)" ::: "memory");
        } else {
            XB_SPIN(xb_ld(&bar[XB_XGEN(b.x)]) == gen, bar);
            __builtin_amdgcn_fence(__ATOMIC_ACQUIRE, "agent");
            asm volatile("s_waitcnt vmcnt(0)" ::: "memory");
        }
    }
    __syncthreads();
}

constexpr int D = 1024, TP = 16384, TS = 1024, T = TP + TS, SEQ = 2048, NBATCH = 8, DBATCH = 128, DSEQ = 8;
constexpr int AW = 2048, NA_IN = 6144, NB_IN = 3328, NB_SRC = 3144, PD = 256, NPAGES = 16, PAGE = 128;
constexpr int HD = 128, NH = 8, NKV = 2, KVW = 256, IDXH = 8, IDXD = 64, TOPK = 256;
constexpr int NPOS = SEQ + DSEQ;
constexpr int MASKW = 34;
constexpr float EPS = 1e-6f;
constexpr size_t O_Y = 0, O_KP = (size_t)T * D, O_VP = O_KP + (size_t)NBATCH * 2 * SEQ * KVW, O_IKP = O_VP + (size_t)NBATCH * 2 * SEQ * KVW,
                 O_KS = O_IKP + (size_t)NBATCH * 2 * SEQ * IDXD, O_VS = O_KS + (size_t)DBATCH * 2 * DSEQ * KVW, O_IKS = O_VS + (size_t)DBATCH * 2 * DSEQ * KVW,
                 O_CV = O_IKS + (size_t)DBATCH * 2 * DSEQ * IDXD, O_END = O_CV + (size_t)DBATCH * 2 * DSEQ * AW;
static_assert(O_END == 42074112, "output size");
constexpr size_t al256(size_t x) { return (x + 255) & ~(size_t)255; }
constexpr size_t WS_CTL = 0, CTL_BYTES = 1u << 20;
constexpr size_t SZ_WINA = (size_t)NA_IN * D * 2, SZ_WOUTA = (size_t)D * AW * 2, SZ_WINB = (size_t)NB_IN * D * 2, SZ_WSQ = (size_t)D * D * 2, SZ_WPE = (size_t)D * PD * 2;
constexpr size_t WS_WINA = CTL_BYTES, WS_WOUTA = WS_WINA + 2 * SZ_WINA, WS_WINB = WS_WOUTA + 2 * SZ_WOUTA, WS_WOUTB = WS_WINB + 2 * SZ_WINB,
                 WS_WGATE = WS_WOUTB + 2 * SZ_WSQ, WS_WPE = WS_WGATE + 4 * SZ_WSQ, WS_ROPE = WS_WPE + 4 * SZ_WPE;
constexpr size_t SZ_ROPE = al256((size_t)NPOS * 64 * 8), SZ_PB = (size_t)T * PD * 2, SZ_XB = (size_t)T * D * 2, SZ_XF = (size_t)T * D * 4, SZ_SS = (size_t)T * 16 * 4;
constexpr size_t WS_PB = WS_ROPE + SZ_ROPE, WS_XB0 = WS_PB + 4 * SZ_PB, WS_XB1 = WS_XB0 + SZ_XB, WS_XF0 = WS_XB1 + SZ_XB, WS_XF1 = WS_XF0 + SZ_XF,
                 WS_SSX = WS_XF1 + SZ_XF, WS_SS1 = WS_SSX + SZ_SS, WS_UZ = WS_SS1 + SZ_SS;
constexpr size_t SZ_AW = (size_t)T * AW * 2;
constexpr size_t WS_VR = WS_UZ + SZ_AW, WS_Y = WS_VR + SZ_AW, WS_VSS = WS_Y + SZ_AW, WS_PE = WS_VSS + (size_t)T * 32 * 4, WS_RAW = WS_PE + SZ_XB;
constexpr size_t WS_Q = WS_RAW + (size_t)T * NB_IN * 2, WS_KB = WS_Q + SZ_XB, WS_VB = WS_KB + (size_t)T * KVW * 2, WS_IQ = WS_VB + (size_t)T * KVW * 2,
                 WS_IK = WS_IQ + (size_t)T * 512 * 2, WS_IW = WS_IK + (size_t)T * 64 * 2, WS_SZ = WS_IW + (size_t)T * 8 * 4, WS_AO = WS_SZ + SZ_XB,
                 WS_MASK = WS_AO + SZ_XB, WS_QSS = WS_MASK + (size_t)T * MASKW * 8, WS_ROPE32 = WS_QSS + (size_t)T * NH * 4 * 4, WS_END = WS_ROPE32 + al256((size_t)NPOS * 32 * 8);
constexpr int SCR_BYTES = 153600, MISC_OFF = SCR_BYTES, LDS_BYTES = SCR_BYTES + 256;
constexpr int CW_BAR = 4096, CW_QUEUE = 16384;

typedef short s16x4 __attribute__((ext_vector_type(4)));
typedef float f32x16 __attribute__((ext_vector_type(16)));
typedef float f32x2v __attribute__((ext_vector_type(2)));
typedef unsigned u32x2v __attribute__((ext_vector_type(2)));
typedef unsigned long long u64;

__device__ __forceinline__ float bf2f(unsigned short b) { return __builtin_bit_cast(float, (unsigned)b << 16); }
__device__ __forceinline__ float bflo(unsigned w) { return __builtin_bit_cast(float, w << 16); }
__device__ __forceinline__ float bfhi(unsigned w) { return __builtin_bit_cast(float, w & 0xffff0000u); }
__device__ __forceinline__ unsigned cvtpk(float lo, float hi) { return pg8::cvt_pk_bf16(lo, hi); }
__device__ __forceinline__ float wave_sum(float v) {
#pragma unroll
    for (int o = 1; o < 64; o <<= 1) v += __shfl_xor(v, o);
    return v;
}
__device__ __forceinline__ float wave_max(float v) {
#pragma unroll
    for (int o = 1; o < 64; o <<= 1) v = fmaxf(v, __shfl_xor(v, o));
    return v;
}
__device__ __forceinline__ float rsq(float x) { return __builtin_amdgcn_rsqf(x); }
__device__ __forceinline__ float sigm(float x) { return __builtin_amdgcn_rcpf(1.0f + __builtin_amdgcn_exp2f(x * -1.4426950408889634f)); }
__device__ __forceinline__ float row_r16(const float* ss, int row, float inv_n) {
    const f32x4* p = (const f32x4*)(ss + (size_t)row * 16); const f32x4 a = p[0], b = p[1], c = p[2], d = p[3];
    const float s = (((a.x + a.y) + (a.z + a.w)) + ((b.x + b.y) + (b.z + b.w))) + (((c.x + c.y) + (c.z + c.w)) + ((d.x + d.y) + (d.z + d.w)));
    return rsq(s * inv_n + EPS);
}

__device__ __forceinline__ void rows_r8(const float* ss, int row0, int fq, float inv_n, float (&rr)[8]) {
    f32x4 v[8];
#pragma unroll
    for (int k = 0; k < 8; ++k) v[k] = *(const f32x4*)(ss + (size_t)(row0 + (k >> 2) * 128 + (k & 3) * 16) * 16 + 4 * fq);
#pragma unroll
    for (int k = 0; k < 8; ++k) { float t = (v[k].x + v[k].y) + (v[k].z + v[k].w); t += __shfl_xor(t, 16); t += __shfl_xor(t, 32); rr[k] = rsq(t * inv_n + EPS); }
}

struct EpiA1 {
    static constexpr bool PERM = true, AFTER_DRAIN = false;
    const float* ssx; bf16* UZ; bf16* V; float* vss;
    __device__ __forceinline__ void operator()(const f32x4 (&acc)[2][2][4][2], const pg8::Unit& u, int wr, int wc, int fr, int fq) const {
        const int row0 = u.pm * 256 + wr * 64 + fr; float rr[8]; rows_r8(ssx, row0, fq, 1.0f / D, rr);
#pragma unroll
        for (int ai = 0; ai < 2; ++ai)
#pragma unroll
            for (int m = 0; m < 4; ++m) {
                const int row = row0 + ai * 128 + m * 16; const float r = rr[ai * 4 + m];
                if (u.pn < 16) {
                    float o[8];
#pragma unroll
                    for (int n = 0; n < 2; ++n)
#pragma unroll
                        for (int j = 0; j < 4; ++j) { const float uu = acc[ai][0][m][n][j] * r, zz = acc[ai][1][m][n][j] * r; o[n * 4 + j] = uu * zz * sigm(zz); }
                    v4u w; w.x = cvtpk(o[0], o[1]); w.y = cvtpk(o[2], o[3]); w.z = cvtpk(o[4], o[5]); w.w = cvtpk(o[6], o[7]);
                    *(v4u*)(UZ + (size_t)row * AW + u.pn * 128 + wc * 32 + 8 * fq) = w;
                } else {
                    float q = 0.f;
#pragma unroll
                    for (int bj = 0; bj < 2; ++bj) { const f32x4 a = acc[ai][bj][m][0] * r, b = acc[ai][bj][m][1] * r;
                        q += (a.x * a.x + a.y * a.y) + (a.z * a.z + a.w * a.w) + (b.x * b.x + b.y * b.y) + (b.z * b.z + b.w * b.w);
                        v4u w; w.x = cvtpk(a.x, a.y); w.y = cvtpk(a.z, a.w); w.z = cvtpk(b.x, b.y); w.w = cvtpk(b.z, b.w);
                        *(v4u*)(V + (size_t)row * AW + (u.pn - 16) * 256 + bj * 128 + wc * 32 + 8 * fq) = w; }
                    q += __shfl_xor(q, 16); q += __shfl_xor(q, 32);
                    if (fq == 0) vss[(size_t)row * 32 + (u.pn - 16) * 4 + wc] = q;
                }
            }
    }
};
struct EpiBf16S {
    static constexpr bool PERM = true, AFTER_DRAIN = false;
    bf16* O; int ldc;
    __device__ __forceinline__ void operator()(const f32x4 (&acc)[2][2][4][2], const pg8::Unit& u, int wr, int wc, int fr, int fq) const {
        bf16* base = O + (size_t)(u.pm * 256 + wr * 64) * ldc + u.pn * 256 + wc * 32; const unsigned lo = (unsigned)fr * (unsigned)ldc + 8u * fq;
#pragma unroll
        for (int ai = 0; ai < 2; ++ai)
#pragma unroll
            for (int m = 0; m < 4; ++m)
#pragma unroll
                for (int bj = 0; bj < 2; ++bj) { const f32x4 a = acc[ai][bj][m][0], b = acc[ai][bj][m][1];
                    v4u w; w.x = cvtpk(a.x, a.y); w.y = cvtpk(a.z, a.w); w.z = cvtpk(b.x, b.y); w.w = cvtpk(b.z, b.w);
                    *(v4u*)(base + (lo + (unsigned)((ai * 128 + m * 16) * ldc + bj * 128))) = w; }
    }
};
struct EpiNull {
    static constexpr bool PERM = true, AFTER_DRAIN = false;
    float* O;
    __device__ __forceinline__ void operator()(const f32x4 (&acc)[2][2][4][2], const pg8::Unit& u, int wr, int wc, int fr, int fq) const {
        float s = 0.f;
#pragma unroll
        for (int ai = 0; ai < 2; ++ai)
#pragma unroll
            for (int bj = 0; bj < 2; ++bj)
#pragma unroll
                for (int m = 0; m < 4; ++m)
#pragma unroll
                    for (int n = 0; n < 2; ++n) s += (acc[ai][bj][m][n].x + acc[ai][bj][m][n].y) + (acc[ai][bj][m][n].z + acc[ai][bj][m][n].w);
        if (s == 12345.678f) O[threadIdx.x] = s;
    }
};
__device__ __forceinline__ void ld8f(const float* xf, const bf16* xb, size_t off, f32x4& a, f32x4& b) {
    if (xf) { a = *(const f32x4*)(xf + off); b = *(const f32x4*)(xf + off + 4); }
    else { const v4u w = *(const v4u*)(xb + off); a = (f32x4){bflo(w.x), bfhi(w.x), bflo(w.y), bfhi(w.y)}; b = (f32x4){bflo(w.z), bfhi(w.z), bflo(w.w), bfhi(w.w)}; } }
template <bool F32IN> struct EpiRes {
    static constexpr bool PERM = true, AFTER_DRAIN = false;
    const float* xf; const bf16* xbin; bf16* x1b; float* ss1;
    __device__ __forceinline__ void operator()(const f32x4 (&acc)[2][2][4][2], const pg8::Unit& u, int wr, int wc, int fr, int fq) const {
        const int row0 = u.pm * 256 + wr * 64 + fr;
#pragma unroll
        for (int ai = 0; ai < 2; ++ai)
#pragma unroll
            for (int m = 0; m < 4; ++m) {
                const int row = row0 + ai * 128 + m * 16; float q = 0.f;
#pragma unroll
                for (int bj = 0; bj < 2; ++bj) { const size_t off = (size_t)row * D + u.pn * 256 + bj * 128 + wc * 32 + 8 * fq;
                    f32x4 a, b; if (F32IN) ld8f(xf, nullptr, off, a, b); else ld8f(nullptr, xbin, off, a, b); a += acc[ai][bj][m][0]; b += acc[ai][bj][m][1];
                    q += (a.x * a.x + a.y * a.y) + (a.z * a.z + a.w * a.w) + (b.x * b.x + b.y * b.y) + (b.z * b.z + b.w * b.w);
                    v4u w; w.x = cvtpk(a.x, a.y); w.y = cvtpk(a.z, a.w); w.z = cvtpk(b.x, b.y); w.w = cvtpk(b.z, b.w);
                    *(v4u*)(x1b + off) = w; }
                q += __shfl_xor(q, 16); q += __shfl_xor(q, 32);
                if (fq == 0) ss1[(size_t)row * 16 + u.pn * 4 + wc] = q;
            }
    }
};
struct EpiGate {
    static constexpr bool PERM = true, AFTER_DRAIN = false;
    const float* ss1; const bf16* x1b; const bf16* pe; float* xout; bf16* xb; float* ssx;
    __device__ __forceinline__ void operator()(const f32x4 (&acc)[2][2][4][2], const pg8::Unit& u, int wr, int wc, int fr, int fq) const {
        const int row0 = u.pm * 256 + wr * 64 + fr; float rr[8]; rows_r8(ss1, row0, fq, 1.0f / D, rr);
#pragma unroll
        for (int ai = 0; ai < 2; ++ai)
#pragma unroll
            for (int m = 0; m < 4; ++m) {
                const int row = row0 + ai * 128 + m * 16; const float r1 = rr[ai * 4 + m]; float q = 0.f;
#pragma unroll
                for (int bj = 0; bj < 2; ++bj) { const size_t off = (size_t)row * D + u.pn * 256 + bj * 128 + wc * 32 + 8 * fq;
                    const v4u pw = *(const v4u*)(pe + off); f32x4 xa, xc; ld8f(nullptr, x1b, off, xa, xc);
                    const f32x4 ga = acc[ai][bj][m][0] * r1, gb = acc[ai][bj][m][1] * r1;
                    f32x4 a, b;
                    a.x = xa.x + sigm(ga.x) * bflo(pw.x); a.y = xa.y + sigm(ga.y) * bfhi(pw.x); a.z = xa.z + sigm(ga.z) * bflo(pw.y); a.w = xa.w + sigm(ga.w) * bfhi(pw.y);
                    b.x = xc.x + sigm(gb.x) * bflo(pw.z); b.y = xc.y + sigm(gb.y) * bfhi(pw.z); b.z = xc.z + sigm(gb.z) * bflo(pw.w); b.w = xc.w + sigm(gb.w) * bfhi(pw.w);
                    q += (a.x * a.x + a.y * a.y) + (a.z * a.z + a.w * a.w) + (b.x * b.x + b.y * b.y) + (b.z * b.z + b.w * b.w);
                    if (xout) { *(f32x4*)(xout + off) = a; *(f32x4*)(xout + off + 4) = b; }
                    v4u w; w.x = cvtpk(a.x, a.y); w.y = cvtpk(a.z, a.w); w.z = cvtpk(b.x, b.y); w.w = cvtpk(b.z, b.w);
                    *(v4u*)(xb + off) = w; }
                q += __shfl_xor(q, 16); q += __shfl_xor(q, 32);
                if (fq == 0) ssx[(size_t)row * 16 + u.pn * 4 + wc] = q;
            }
    }
};

struct Args { const void* in[22]; float* out; unsigned char* ws; int ph_lo, ph_hi; };
#define CAS __attribute__((address_space(4)))
__device__ __forceinline__ const unsigned char CAS* kargs() { const unsigned char CAS* p = (const unsigned char CAS*)__builtin_amdgcn_kernarg_segment_ptr(); asm volatile("" : "+s"(p)); return p; }
#define KIN(T_, i) (*(T_* const CAS*)(kargs() + 8 * (i)))
struct Ctx {
    LAS unsigned char* lds; int tid, lane, wave, G, bid;
    float* out; unsigned char* ws;
};
#define WSP(T_, off) ((T_*)(C.ws + (off)))

__device__ __forceinline__ int srcA(int n) { if (n < 4096) { const int t = n >> 8, r = n & 255; return r < 128 ? 128 * t + r : 4096 + 128 * t + (r - 128); } return 2048 + (n - 4096); }
__device__ __forceinline__ int srcB(int n) {
    const int tile = n >> 8, P = n & 255, bj = P >> 7, p = P & 127;
    if (tile < 5) { const int act = (p >> 3) * 4 + (p & 3) + ((p >> 2) & 1) * 64; return (tile < 4 ? (2 * tile + bj) * 128 : 1024 + bj * 128) + act; }
    if (tile == 5) return 1280 + P;
    if (tile < 8) { const int ih = 4 * (tile - 6) + 2 * bj + (p >> 6), pp = p & 63, act = (pp >> 3) * 4 + (pp & 3) + ((pp >> 2) & 1) * 32; return 1536 + ih * 64 + act; }
    if (tile < 12) return 2120 + (n - 2048);
    if (P < 32) return 2048 + P; if (P < 40) return 2112 + (P - 32); if (P >= 128 && P < 160) return 2048 + 32 + (P - 128); return -1;
}
template <int MAP> __device__ __forceinline__ void tr_job(const float* W, int K, int Nsrc, const float* gs, bf16* WT, int Ndst, int& base, int gw, int NGW, int lane) {
    const int nblk = Ndst / 256, nitems = (K / 64) * nblk;
    int first = (gw - base) % NGW; if (first < 0) first += NGW;
    for (int it = first; it < nitems; it += NGW) {
        const int kb = it / nblk, nb = it - kb * nblk, k0 = 64 * kb, n = 256 * nb + 4 * lane;
        const int src = MAP == 0 ? n : (MAP == 1 ? srcA(n) : srcB(n));
#pragma unroll
        for (int h = 0; h < 2; ++h) { f32x4 v[32];
#pragma unroll
            for (int i = 0; i < 32; ++i) v[i] = src >= 0 ? *(const f32x4*)(W + (size_t)(k0 + 32 * h + i) * Nsrc + src) : (f32x4){0.f, 0.f, 0.f, 0.f};
            if (gs) {
#pragma unroll
                for (int i = 0; i < 32; ++i) v[i] *= gs[k0 + 32 * h + i]; }
#pragma unroll
            for (int j = 0; j < 4; ++j) { bf16* dst = WT + (size_t)(n + j) * K + k0 + 32 * h;
#pragma unroll
                for (int q = 0; q < 4; ++q) { v4u o; o.x = cvtpk(v[8 * q][j], v[8 * q + 1][j]); o.y = cvtpk(v[8 * q + 2][j], v[8 * q + 3][j]); o.z = cvtpk(v[8 * q + 4][j], v[8 * q + 5][j]); o.w = cvtpk(v[8 * q + 6][j], v[8 * q + 7][j]);
                    *(v4u*)(dst + 8 * q) = o; } } }
    }
    base = (base + nitems) % NGW;
}
__device__ __forceinline__ void sincos_d(double a, double& s, double& c) {
    const double k = rint(a * 0.63661977236758134308);
    double r = fma(-k, 1.5707963267948966192, a); r = fma(-k, 6.123233995736766e-17, r);
    const double r2 = r * r;
    double sp = -7.647163731819816e-13; sp = fma(sp, r2, 1.605904383682161e-10); sp = fma(sp, r2, -2.505210838544172e-08); sp = fma(sp, r2, 2.755731922398589e-06); sp = fma(sp, r2, -1.984126984126984e-04);
    sp = fma(sp, r2, 8.333333333333333e-03); sp = fma(sp, r2, -1.666666666666667e-01); const double sn = fma(sp * r2, r, r);
    double cp = 4.779477332387385e-14; cp = fma(cp, r2, -1.147074559772972e-11); cp = fma(cp, r2, 2.087675698786810e-09); cp = fma(cp, r2, -2.755731922398589e-07); cp = fma(cp, r2, 2.480158730158730e-05);
    cp = fma(cp, r2, -1.388888888888889e-03); cp = fma(cp, r2, 4.166666666666666e-02); cp = fma(cp, r2, -0.5); const double cs = fma(cp, r2, 1.0);
    const int q = (int)((long long)k & 3);
    s = (q == 0) ? sn : (q == 1) ? cs : (q == 2) ? -sn : -cs;
    c = (q == 0) ? cs : (q == 1) ? -sn : (q == 2) ? -cs : sn;
}
__device__ __forceinline__ void prologue_part(Ctx& C, int part, bool split, int gw, int NGW) {
    const int lane = C.lane; int base = 0;
    const int j0 = split ? (part == 1 ? 1 : 0) : 0, j1 = split ? (part == 0 ? 1 : (part == 1 ? 2 : 0)) : 2;
    for (int j = j0; j < j1; ++j) {
        tr_job<1>(KIN(const float, 9) + (size_t)j * D * NA_IN, D, NA_IN, KIN(const float, 8) + (2 * j) * D, WSP(bf16, WS_WINA + j * SZ_WINA), NA_IN, base, gw, NGW, lane);
        tr_job<0>(KIN(const float, 13) + (size_t)j * AW * D, AW, D, nullptr, WSP(bf16, WS_WOUTA + j * SZ_WOUTA), D, base, gw, NGW, lane);
        tr_job<2>(KIN(const float, 14) + (size_t)j * D * NB_SRC, D, NB_SRC, KIN(const float, 8) + (2 * j + 1) * D, WSP(bf16, WS_WINB + j * SZ_WINB), NB_IN, base, gw, NGW, lane);
        tr_job<0>(KIN(const float, 18) + (size_t)j * D * D, D, D, nullptr, WSP(bf16, WS_WOUTB + j * SZ_WSQ), D, base, gw, NGW, lane);
        for (int i = 2 * j; i < 2 * j + 2; ++i) {
            tr_job<0>(KIN(const float, 20) + (size_t)i * D * D, D, D, KIN(const float, 19) + i * D, WSP(bf16, WS_WGATE + i * SZ_WSQ), D, base, gw, NGW, lane);
            tr_job<0>(KIN(const float, 21) + (size_t)i * PD * D, PD, D, nullptr, WSP(bf16, WS_WPE + i * SZ_WPE), D, base, gw, NGW, lane); }
    }
    const int pr0 = split ? (part == 2 ? T : 0) : 0, pr1 = split ? (part == 0 ? T : (part == 2 ? 4 * T : 0)) : 4 * T;
    for (int r0 = pr0 + gw * 4; r0 < pr1; r0 += NGW * 4) { f32x4 v[4];
#pragma unroll
        for (int e = 0; e < 4; ++e) { const int r = r0 + e, i = r / T, m = r - i * T;
            const float* src = m < TP ? KIN(const float, 6) + ((size_t)i * TP + m) * PD : KIN(const float, 7) + ((size_t)i * TS + (m - TP)) * PD; v[e] = ((const f32x4*)src)[lane]; }
#pragma unroll
        for (int e = 0; e < 4; ++e) { u32x2v w; w.x = cvtpk(v[e].x, v[e].y); w.y = cvtpk(v[e].z, v[e].w); ((u32x2v*)(WSP(bf16, WS_PB) + (size_t)(r0 + e) * PD))[lane] = w; } }
    if (part != 0) return;
    for (int m0 = gw * 2; m0 < T; m0 += NGW * 2) { f32x4 v[2][4];
#pragma unroll
        for (int e = 0; e < 2; ++e) { const int m = m0 + e; const float* src = m < TP ? KIN(const float, 0) + (size_t)m * D : KIN(const float, 1) + (size_t)(m - TP) * D;
#pragma unroll
            for (int j = 0; j < 4; ++j) v[e][j] = ((const f32x4*)src)[lane + 64 * j]; }
#pragma unroll
        for (int e = 0; e < 2; ++e) { const int m = m0 + e; bf16* dst = WSP(bf16, WS_XB0) + (size_t)m * D; float s = 0.f;
#pragma unroll
            for (int j = 0; j < 4; ++j) { const f32x4 x = v[e][j]; s += (x.x * x.x + x.y * x.y) + (x.z * x.z + x.w * x.w); u32x2v w; w.x = cvtpk(x.x, x.y); w.y = cvtpk(x.z, x.w); ((u32x2v*)dst)[lane + 64 * j] = w; }
            s = wave_sum(s); if (lane < 16) WSP(float, WS_SSX)[(size_t)m * 16 + lane] = lane == 0 ? s : 0.f; } }
    for (int e = gw * 64 + lane; e < NPOS * 64; e += NGW * 64) { const int pos = e >> 6, i = e & 63; double inv = 1.0; for (int k = 0; k < i; ++k) inv *= 0.8659643233600653;
        double s, c; sincos_d((double)pos * inv, s, c); const f32x2v v = (f32x2v){(float)c, (float)s}; WSP(f32x2v, WS_ROPE)[e] = v; if ((i & 1) == 0) WSP(f32x2v, WS_ROPE32)[pos * 32 + (i >> 1)] = v; }
}

__device__ __forceinline__ s16x4 tr_read(LAS unsigned char* p) { return __builtin_bit_cast(s16x4, __builtin_amdgcn_ds_read_tr16_b64_v4i16((LAS s16x4*)p)); }
__device__ __forceinline__ int crow(int r, int hi) { return (r & 3) + 8 * (r >> 2) + 4 * hi; }
constexpr int GT_WM = 0, GT_WMS = 272, GT_V = 34816, GT_VS = 576;
__device__ __forceinline__ void gate_build_wm(LAS unsigned char* lds, const float* wsg, bool samp, int tid) {
    const int t = tid >> 2, s0 = (tid & 3) * 32;
#pragma unroll 4
    for (int i = 0; i < 32; i += 2) { float v[2];
#pragma unroll
        for (int e = 0; e < 2; ++e) { const int s = s0 + i + e; bool ok; float wv;
            if (!samp) { ok = s <= t; wv = wsg[t * 128 + s]; } else { ok = ((s >> 3) == (t >> 3)) && ((s & 7) <= (t & 7)); wv = wsg[(t & 7) * 128 + (s & 7)]; }
            v[e] = ok ? wv : 0.f; }
        *(LAS unsigned*)(lds + GT_WM + t * GT_WMS + (s0 + i) * 2) = cvtpk(v[0], v[1]); }
}
__device__ __forceinline__ void gate_phase(Ctx& C, int j) {
    int tid = C.tid; asm volatile("" : "+v"(tid));
    const int lane = tid & 63, w = __builtin_amdgcn_readfirstlane(tid >> 6), r32 = lane & 31, hi = lane >> 5;
    LAS unsigned char* lds = C.lds;
    const bf16* Vr = WSP(bf16, WS_VR); const bf16* UZ = WSP(bf16, WS_UZ); bf16* Y = WSP(bf16, WS_Y); const float* vss = WSP(float, WS_VSS);
    int wm_state = -1;
#define GATE_DECODE(item_, samp_, tile_, g_, t0_, nit_) const bool samp_ = (item_) >= 1024; int tile_, g_, t0_, nit_; \
        if (!samp_) { tile_ = (item_) >> 3; g_ = (item_) & 7; t0_ = 0; nit_ = 8; } else { const int s_ = (item_) - 1024; g_ = s_ & 7; tile_ = 128 + ((s_ >> 3) & 7); t0_ = 32 * (s_ >> 6); nit_ = 2; }
#define GATE_LOAD(V_, Q_, tile_, g_, t0_, nit_) do { _Pragma("unroll") for (int i = 0; i < 8; ++i) if (i < (nit_)) { const int idx = tid + 512 * i, t = (t0_) + (idx >> 5), c = (idx & 31) * 8; \
        const size_t off = (size_t)((tile_) * 128 + t) * AW + (g_) * 256 + c; V_[i] = *(const v4u*)(Vr + off); Q_[i] = vss[(size_t)((tile_) * 128 + t) * 32 + (lane & 31)]; } } while (0)
    v4u vn[8]; float qn[8];
    if (C.bid < 1024 + 256) { GATE_DECODE(C.bid, s0_, ti0_, g0_, t00_, n0_); GATE_LOAD(vn, qn, ti0_, g0_, t00_, n0_); }
    for (int item = C.bid; item < 1024 + 256; item += C.G) {
        GATE_DECODE(item, samp, tile, g, t0, nit);
        const int row0 = tile * 128;
        if (wm_state != g * 2 + (samp ? 1 : 0)) { __syncthreads(); gate_build_wm(lds, KIN(const float, 10) + (size_t)(j * 8 + g) * 128 * 128, samp, tid); wm_state = g * 2 + (samp ? 1 : 0); }
        v4u uzr[8], vr[8]; float qr_[8];
#pragma unroll
        for (int i = 0; i < 8; ++i) { vr[i] = vn[i]; qr_[i] = qn[i]; }
#pragma unroll
        for (int i = 0; i < 8; ++i) if (i < nit) { const int idx = tid + 512 * i, t = t0 + (idx >> 5), c = (idx & 31) * 8; uzr[i] = *(const v4u*)(UZ + (size_t)(row0 + t) * AW + g * 256 + c); }
#pragma unroll
        for (int i = 0; i < 8; ++i) if (i < nit) { const int idx = tid + 512 * i, s = t0 + (idx >> 5), c = (idx & 31) * 8; const v4u v = vr[i]; float q = qr_[i];
#pragma unroll
            for (int o = 1; o < 32; o <<= 1) q += __shfl_xor(q, o);
            const float rv = rsq(q * (1.0f / AW) + EPS);
            f32x4 a = (f32x4){bflo(v.x), bfhi(v.x), bflo(v.y), bfhi(v.y)} * rv, b = (f32x4){bflo(v.z), bfhi(v.z), bflo(v.w), bfhi(v.w)} * rv;
            v4u wv; wv.x = cvtpk(a.x, a.y); wv.y = cvtpk(a.z, a.w); wv.z = cvtpk(b.x, b.y); wv.w = cvtpk(b.z, b.w);
            *(LAS v4u*)(lds + GT_V + s * GT_VS + c * 2) = wv;
            if (samp) { const int ms = row0 + s - TP, db = ms >> 3, tt = ms & 7; const float* gv = KIN(const float, 12) + j * AW + g * 256 + c;
                float* o = C.out + O_CV + ((size_t)(db * 2 + j) * DSEQ + tt) * AW + g * 256 + c;
                *(f32x4*)o = a * *(const f32x4*)gv; *(f32x4*)(o + 4) = b * *(const f32x4*)(gv + 4); } }
        __syncthreads();
        { LAS unsigned char* vb = lds + GT_V + (8 * hi + ((lane & 15) >> 2)) * GT_VS + (32 * w + 16 * ((lane >> 4) & 1) + 4 * (lane & 3)) * 2;
          const int tb0 = t0 >> 5, tb1 = samp ? tb0 + 1 : 4;
          bf16x8 Bf[8];
#pragma unroll
          for (int ks = 0; ks < 8; ++ks) if (!samp || (ks >> 1) == tb0) { const s16x4 l = tr_read(vb + (16 * ks) * GT_VS), h = tr_read(vb + (16 * ks + 4) * GT_VS);
              Bf[ks] = (bf16x8){l[0], l[1], l[2], l[3], h[0], h[1], h[2], h[3]}; }
          __syncthreads();
          if (item + C.G < 1024 + 256) { GATE_DECODE(item + C.G, sn_, tin_, gn_, t0n_, nn_); GATE_LOAD(vn, qn, tin_, gn_, t0n_, nn_); }
          const float gv = KIN(const float, 12)[j * AW + g * 256 + 32 * w + r32]; const float* bs = KIN(const float, 11) + (size_t)(j * 8 + g) * 128;
#pragma unroll
          for (int tb = 0; tb < 4; ++tb) if (tb >= tb0 && tb < tb1) { f32x16 acc = {};
#pragma unroll
              for (int ks = 0; ks < 8; ++ks) if (ks <= 2 * tb + 1 && (!samp || (ks >> 1) == tb)) {
                  const bf16x8 af = *(LAS bf16x8*)(lds + GT_WM + (32 * tb + r32) * GT_WMS + (16 * ks + 8 * hi) * 2);
                  acc = __builtin_amdgcn_mfma_f32_32x32x16_bf16(af, Bf[ks], acc, 0, 0, 0); }
#pragma unroll
              for (int i = 0; i < 16; ++i) { const int t = 32 * tb + crow(i, hi); *(LAS bf16*)(lds + GT_V + t * GT_VS + (32 * w + r32) * 2) = (bf16)f2bf(gv * acc[i] + bs[samp ? (t & 7) : t]); } } }
        __syncthreads();
#pragma unroll
        for (int i = 0; i < 8; ++i) if (i < nit) { const int idx = tid + 512 * i, t = t0 + (idx >> 5), c = (idx & 31) * 8; const size_t off = (size_t)(row0 + t) * AW + g * 256 + c;
            const v4u mx = *(const LAS v4u*)(lds + GT_V + t * GT_VS + c * 2), uz = uzr[i]; v4u y;
            y.x = cvtpk(bflo(uz.x) * bflo(mx.x), bfhi(uz.x) * bfhi(mx.x)); y.y = cvtpk(bflo(uz.y) * bflo(mx.y), bfhi(uz.y) * bfhi(mx.y));
            y.z = cvtpk(bflo(uz.z) * bflo(mx.z), bfhi(uz.z) * bfhi(mx.z)); y.w = cvtpk(bflo(uz.w) * bflo(mx.w), bfhi(uz.w) * bfhi(mx.w));
            *(v4u*)(Y + off) = y; }
        __syncthreads();
    }
}

struct EpiB1 {
    static constexpr bool PERM = true, AFTER_DRAIN = false;
    unsigned char* ws; const float *gq, *gk, *gik; float* out; int j; LAS float* xch;
#define EB1(T_, off) ((T_*)(ws + (off)))
    __device__ __forceinline__ static void rot4(const f32x4& a, const f32x4& b, const f32x4& cs01, const f32x4& cs23, f32x4& oa, f32x4& ob) {
        oa.x = a.x * cs01.x - b.x * cs01.y; ob.x = b.x * cs01.x + a.x * cs01.y; oa.y = a.y * cs01.z - b.y * cs01.w; ob.y = b.y * cs01.z + a.y * cs01.w;
        oa.z = a.z * cs23.x - b.z * cs23.y; ob.z = b.z * cs23.x + a.z * cs23.y; oa.w = a.w * cs23.z - b.w * cs23.w; ob.w = b.w * cs23.z + a.w * cs23.w; }
    __device__ __forceinline__ static u32x2v pk4(const f32x4& a) { u32x2v w; w.x = cvtpk(a.x, a.y); w.y = cvtpk(a.z, a.w); return w; }
    __device__ __forceinline__ void operator()(const f32x4 (&acc)[2][2][4][2], const pg8::Unit& u, int wr, int wc, int fr_, int fq_) const {
        int fr = fr_, fq = fq_; asm volatile("" : "+v"(fr), "+v"(fq));
        const int row0 = u.pm * 256 + wr * 64 + fr, pn = u.pn; float rr[8]; rows_r8(EB1(const float, WS_SSX), row0, fq, 1.0f / D, rr);
        if (pn < 5) {
            const bool isk = pn == 4; const int c = 16 * wc + 4 * fq; const float* gg = isk ? gk : gq;
            const f32x4 g0 = *(const f32x4*)(gg + c), g1 = *(const f32x4*)(gg + 64 + c);
            if (isk) {
#pragma unroll
                for (int ai = 0; ai < 2; ++ai)
#pragma unroll
                    for (int m = 0; m < 4; ++m) { const int row = row0 + ai * 128 + m * 16; const float r = rr[ai * 4 + m];
#pragma unroll
                        for (int bj = 0; bj < 2; ++bj) { const f32x4 a = acc[ai][bj][m][0] * r, b = acc[ai][bj][m][1] * r;
                            float q = (a.x * a.x + a.y * a.y) + (a.z * a.z + a.w * a.w) + (b.x * b.x + b.y * b.y) + (b.z * b.z + b.w * b.w);
                            q += __shfl_xor(q, 16); q += __shfl_xor(q, 32);
                            if (fq == 0) xch[((wr * 64 + ai * 128 + m * 16 + fr) * 2 + bj) * 4 + wc] = q; } }
                asm volatile("s_waitcnt lgkmcnt(0)" ::: "memory"); __builtin_amdgcn_s_barrier(); asm volatile("" ::: "memory");
            }
#pragma unroll
            for (int ai = 0; ai < 2; ++ai)
#pragma unroll
                for (int m = 0; m < 4; ++m) {
                    const int row = row0 + ai * 128 + m * 16; const float r = rr[ai * 4 + m];
                    const int pos = row < TP ? (row & (SEQ - 1)) : SEQ + ((row - TP) & (DSEQ - 1));
                    const f32x4 cs01 = *(const f32x4*)(EB1(const f32x2v, WS_ROPE) + pos * 64 + c), cs23 = *(const f32x4*)(EB1(const f32x2v, WS_ROPE) + pos * 64 + c + 2);
                    float* ko = nullptr;
                    if (isk) { if (row < TP) ko = out + O_KP + ((size_t)((row >> 11) * 2 + j) * SEQ + (row & (SEQ - 1))) * KVW; else { const int ms = row - TP; ko = out + O_KS + ((size_t)((ms >> 3) * 2 + j) * DSEQ + (ms & 7)) * KVW; } }
#pragma unroll
                    for (int bj = 0; bj < 2; ++bj) { const f32x4 a = acc[ai][bj][m][0] * r, b = acc[ai][bj][m][1] * r;
                        f32x4 ra, rb; rot4(a * g0, b * g1, cs01, cs23, ra, rb);
                        if (!isk) { const int hd = 2 * pn + bj;
                            float q = (a.x * a.x + a.y * a.y) + (a.z * a.z + a.w * a.w) + (b.x * b.x + b.y * b.y) + (b.z * b.z + b.w * b.w);
                            q += __shfl_xor(q, 16); q += __shfl_xor(q, 32);
                            if (fq == 0) EB1(float, WS_QSS)[((size_t)row * NH + hd) * 4 + wc] = q;
                            bf16* qp = EB1(bf16, WS_Q) + (size_t)row * D + hd * HD + c; *(u32x2v*)qp = pk4(ra); *(u32x2v*)(qp + 64) = pk4(rb); }
                        else { const f32x4 pq = *(const LAS f32x4*)(xch + ((wr * 64 + ai * 128 + m * 16 + fr) * 2 + bj) * 4);
                            const float rk = rsq(((pq.x + pq.y) + (pq.z + pq.w)) * (1.0f / HD) + EPS); const f32x4 ka = ra * rk, kb = rb * rk;
                            *(f32x4*)(ko + bj * HD + c) = ka; *(f32x4*)(ko + bj * HD + 64 + c) = kb;
                            bf16* kp = EB1(bf16, WS_KB) + (size_t)row * KVW + bj * HD + c; *(u32x2v*)kp = pk4(ka); *(u32x2v*)(kp + 64) = pk4(kb); } }
                }
        } else if (pn == 5) {
#pragma unroll
            for (int ai = 0; ai < 2; ++ai)
#pragma unroll
                for (int m = 0; m < 4; ++m) { const int row = row0 + ai * 128 + m * 16; const float r = rr[ai * 4 + m]; float* vo;
                    if (row < TP) vo = out + O_VP + ((size_t)((row >> 11) * 2 + j) * SEQ + (row & (SEQ - 1))) * KVW; else { const int ms = row - TP; vo = out + O_VS + ((size_t)((ms >> 3) * 2 + j) * DSEQ + (ms & 7)) * KVW; }
#pragma unroll
                    for (int bj = 0; bj < 2; ++bj) { const int cc = bj * 128 + wc * 32 + 8 * fq; const f32x4 a = acc[ai][bj][m][0] * r, b = acc[ai][bj][m][1] * r;
                        *(f32x4*)(vo + cc) = a; *(f32x4*)(vo + cc + 4) = b; v4u w; w.x = cvtpk(a.x, a.y); w.y = cvtpk(a.z, a.w); w.z = cvtpk(b.x, b.y); w.w = cvtpk(b.z, b.w);
                        *(v4u*)(EB1(bf16, WS_VB) + (size_t)row * KVW + cc) = w; } }
        } else if (pn < 8) {
            const int c = 16 * (wc & 1) + 4 * fq;
#pragma unroll
            for (int ai = 0; ai < 2; ++ai)
#pragma unroll
                for (int m = 0; m < 4; ++m) { const int row = row0 + ai * 128 + m * 16; const float r = rr[ai * 4 + m];
                    const int pos = row < TP ? (row & (SEQ - 1)) : SEQ + ((row - TP) & (DSEQ - 1));
                    const f32x4 cs01 = *(const f32x4*)(EB1(const f32x2v, WS_ROPE32) + pos * 32 + c), cs23 = *(const f32x4*)(EB1(const f32x2v, WS_ROPE32) + pos * 32 + c + 2);
#pragma unroll
                    for (int bj = 0; bj < 2; ++bj) { f32x4 ra, rb; rot4(acc[ai][bj][m][0] * r, acc[ai][bj][m][1] * r, cs01, cs23, ra, rb);
                        bf16* ip = EB1(bf16, WS_IQ) + (size_t)row * 512 + (4 * (pn - 6) + 2 * bj + (wc >> 1)) * IDXD + c; *(u32x2v*)ip = pk4(ra); *(u32x2v*)(ip + 32) = pk4(rb); } }
        } else if (pn < 12) {
#pragma unroll
            for (int ai = 0; ai < 2; ++ai)
#pragma unroll
                for (int m = 0; m < 4; ++m) { const int row = row0 + ai * 128 + m * 16; const float r = rr[ai * 4 + m];
#pragma unroll
                    for (int bj = 0; bj < 2; ++bj) { const f32x4 a = acc[ai][bj][m][0] * r, b = acc[ai][bj][m][1] * r; v4u w;
                        w.x = cvtpk(a.x * sigm(a.x), a.y * sigm(a.y)); w.y = cvtpk(a.z * sigm(a.z), a.w * sigm(a.w)); w.z = cvtpk(b.x * sigm(b.x), b.y * sigm(b.y)); w.w = cvtpk(b.z * sigm(b.z), b.w * sigm(b.w));
                        *(v4u*)(EB1(bf16, WS_SZ) + (size_t)row * D + (pn - 8) * 256 + bj * 128 + wc * 32 + 8 * fq) = w; } }
        } else if (wc == 0) {
            const int c = 8 * fq; const f32x4 g0a = *(const f32x4*)(gik + c), g0b = *(const f32x4*)(gik + c + 4), g1a = *(const f32x4*)(gik + 32 + c), g1b = *(const f32x4*)(gik + 32 + c + 4);
#pragma unroll
            for (int ai = 0; ai < 2; ++ai)
#pragma unroll
                for (int m = 0; m < 4; ++m) { const int row = row0 + ai * 128 + m * 16; const float r = rr[ai * 4 + m];
                    const int pos = row < TP ? (row & (SEQ - 1)) : SEQ + ((row - TP) & (DSEQ - 1)); float* iko;
                    if (row < TP) iko = out + O_IKP + ((size_t)((row >> 11) * 2 + j) * SEQ + (row & (SEQ - 1))) * IDXD; else { const int ms = row - TP; iko = out + O_IKS + ((size_t)((ms >> 3) * 2 + j) * DSEQ + (ms & 7)) * IDXD; }
                    const f32x4 a0 = acc[ai][0][m][0] * r, a1 = acc[ai][0][m][1] * r, b0 = acc[ai][1][m][0] * r, b1 = acc[ai][1][m][1] * r;
                    float q = ((a0.x * a0.x + a0.y * a0.y) + (a0.z * a0.z + a0.w * a0.w)) + ((a1.x * a1.x + a1.y * a1.y) + (a1.z * a1.z + a1.w * a1.w))
                            + ((b0.x * b0.x + b0.y * b0.y) + (b0.z * b0.z + b0.w * b0.w)) + ((b1.x * b1.x + b1.y * b1.y) + (b1.z * b1.z + b1.w * b1.w));
                    q += __shfl_xor(q, 16); q += __shfl_xor(q, 32); const float rk = rsq(q * (1.0f / IDXD) + EPS);
                    const f32x4 c01 = *(const f32x4*)(EB1(const f32x2v, WS_ROPE32) + pos * 32 + c), c23 = *(const f32x4*)(EB1(const f32x2v, WS_ROPE32) + pos * 32 + c + 2), c45 = *(const f32x4*)(EB1(const f32x2v, WS_ROPE32) + pos * 32 + c + 4), c67 = *(const f32x4*)(EB1(const f32x2v, WS_ROPE32) + pos * 32 + c + 6);
                    f32x4 ra0, rb0, ra1, rb1; rot4(a0 * g0a * rk, b0 * g1a * rk, c01, c23, ra0, rb0); rot4(a1 * g0b * rk, b1 * g1b * rk, c45, c67, ra1, rb1);
                    *(f32x4*)(iko + c) = ra0; *(f32x4*)(iko + c + 4) = ra1; *(f32x4*)(iko + 32 + c) = rb0; *(f32x4*)(iko + 32 + c + 4) = rb1;
                    bf16* kp = EB1(bf16, WS_IK) + (size_t)row * IDXD + c; v4u w0, w1; w0.x = cvtpk(ra0.x, ra0.y); w0.y = cvtpk(ra0.z, ra0.w); w0.z = cvtpk(ra1.x, ra1.y); w0.w = cvtpk(ra1.z, ra1.w);
                    w1.x = cvtpk(rb0.x, rb0.y); w1.y = cvtpk(rb0.z, rb0.w); w1.z = cvtpk(rb1.x, rb1.y); w1.w = cvtpk(rb1.z, rb1.w); *(v4u*)kp = w0; *(v4u*)(kp + 32) = w1; }
        } else if (wc == 1 && fq == 0) {
#pragma unroll
            for (int ai = 0; ai < 2; ++ai)
#pragma unroll
                for (int m = 0; m < 4; ++m) { const int row = row0 + ai * 128 + m * 16; const float r = rr[ai * 4 + m];
                    *(f32x4*)(EB1(float, WS_IW) + (size_t)row * 8) = acc[ai][0][m][0] * r; *(f32x4*)(EB1(float, WS_IW) + (size_t)row * 8 + 4) = acc[ai][0][m][1] * r; }
        }
    }
};
#undef EB1

constexpr int SC_STRIDE = 2068;
__device__ __forceinline__ unsigned fkey(float x) { const unsigned b = __builtin_bit_cast(unsigned, x + 0.0f); return b ^ ((unsigned)((int)b >> 31) | 0x80000000u); }
__device__ __forceinline__ bf16x8 cvt8(const float* p) { const f32x4 a = *(const f32x4*)p, b = *(const f32x4*)(p + 4); v4u w; w.x = cvtpk(a.x, a.y); w.y = cvtpk(a.z, a.w); w.z = cvtpk(b.x, b.y); w.w = cvtpk(b.z, b.w); return __builtin_bit_cast(bf16x8, w); }
template <int LN> __device__ __forceinline__ unsigned wrlane(unsigned sval, unsigned old) { asm volatile("s_nop 1\n\tv_writelane_b32 %0, %1, %2" : "+v"(old) : "s"(sval), "n"(LN)); return old; }
__device__ __forceinline__ int wave_total6(int c) { int t = 0;
#pragma unroll
    for (int b = 0; b < 6; ++b) t += __popcll(__ballot((c >> b) & 1)) << b;
    return t; }
__device__ __forceinline__ int cnt_ge(const unsigned (&u)[33], unsigned cand, int nq) {
    int c0 = 0, c1 = 0;
#pragma unroll
    for (int i = 0; i < 8; i += 2) { c0 += u[i] >= cand; c1 += u[i + 1] >= cand; }
    if (nq > 1) {
#pragma unroll
        for (int i = 8; i < 16; i += 2) { c0 += u[i] >= cand; c1 += u[i + 1] >= cand; } }
    if (nq > 2) {
#pragma unroll
        for (int i = 16; i < 24; i += 2) { c0 += u[i] >= cand; c1 += u[i + 1] >= cand; } }
    if (nq > 3) {
#pragma unroll
        for (int i = 24; i < 32; i += 2) { c0 += u[i] >= cand; c1 += u[i + 1] >= cand; }
        c0 += u[32] >= cand; }
    return c0 + c1;
}
__device__ __forceinline__ void hist_find(const LAS unsigned* hist, int K, int lane, int& bin, int& above) {
    const v4u a = *(const LAS v4u*)(hist + 8 * lane), b = *(const LAS v4u*)(hist + 8 * lane + 4);
    const int h0 = a.x, h1 = a.y, h2 = a.z, h3 = a.w, h4 = b.x, h5 = b.y, h6 = b.z, h7 = b.w;
    const int s = ((h0 + h1) + (h2 + h3)) + ((h4 + h5) + (h6 + h7)); int S = s;
#pragma unroll
    for (int o = 1; o < 64; o <<= 1) { const int t = __shfl_down(S, o); if (lane + o < 64) S += t; }
    const u64 m = __ballot(S >= K); const int L = 63 - __builtin_clzll(m);
    int acc = S - s, lb = 0, la = 0; bool done = false;
#define HF_(hh, i) if (!done) { if (acc + (hh) >= K) { lb = 8 * lane + (i); la = acc; done = true; } else acc += (hh); }
    HF_(h7, 7) HF_(h6, 6) HF_(h5, 5) HF_(h4, 4) HF_(h3, 3) HF_(h2, 2) HF_(h1, 1) HF_(h0, 0)
#undef HF_
    bin = __builtin_amdgcn_readlane(lb, L); above = __builtin_amdgcn_readlane(la, L);
}
__device__ __forceinline__ void idx_phase(Ctx& C, int j) {
    int tid_ = C.tid; asm volatile("" : "+v"(tid_));
    const int lane = tid_ & 63, wave = __builtin_amdgcn_readfirstlane(tid_ >> 6), fr = lane & 15, fq = lane >> 4;
    LAS float* sc = (LAS float*)C.lds; LAS unsigned* tbuf = (LAS unsigned*)(C.lds + 16 * SC_STRIDE * 4) + wave * 64; LAS unsigned* hist = (LAS unsigned*)(C.lds + 16 * SC_STRIDE * 4 + 2048) + wave * 576;
    const bf16* IQ = WSP(bf16, WS_IQ); const bf16* IKb = WSP(bf16, WS_IK); const float* IW = WSP(float, WS_IW); u64* MASK = WSP(u64, WS_MASK);
    constexpr int NUNITS = 1024 + DBATCH;
    for (int rowi = 0; rowi * C.G < NUNITS; ++rowi) {
#ifndef DUP_IDX_SAMPLE
#define DUP_IDX_SAMPLE 1
#endif
#ifndef DUP_IDX_PROMPT
#define DUP_IDX_PROMPT 1
#endif
        for (int rep_ = 0; rep_ < ((rowi * C.G + ((rowi & 1) ? C.G - 1 - C.bid : C.bid)) < DBATCH ? DUP_IDX_SAMPLE : DUP_IDX_PROMPT); ++rep_)
        { const int unit = rowi * C.G + ((rowi & 1) ? C.G - 1 - C.bid : C.bid);
        if (unit >= NUNITS) continue;
        const bool samp = unit < DBATCH; int b = 0, qg = 0, db = 0, mq0, nkt;
        if (!samp) { const int r = unit - DBATCH; b = r & 7; qg = 127 - (r >> 3); mq0 = b * SEQ + 16 * qg; nkt = qg + 1; } else { db = unit; mq0 = TP + db * DSEQ; nkt = 129; }
        bf16x8 Af[8][2]; { const bf16* qp = IQ + (size_t)(mq0 + (samp ? (fr & 7) : fr)) * 512 + 8 * fq;
#pragma unroll
            for (int h = 0; h < 8; ++h) { Af[h][0] = *(const bf16x8*)(qp + h * 64); Af[h][1] = *(const bf16x8*)(qp + h * 64 + 32); } }
        float iwv[4][8];
#pragma unroll
        for (int r = 0; r < 4; ++r) { const int qi = 4 * fq + r; const float* ip = IW + (size_t)(mq0 + (samp ? (qi & 7) : qi)) * 8; const f32x4 a = *(const f32x4*)ip, c = *(const f32x4*)(ip + 4);
            iwv[r][0] = a.x; iwv[r][1] = a.y; iwv[r][2] = a.z; iwv[r][3] = a.w; iwv[r][4] = c.x; iwv[r][5] = c.y; iwv[r][6] = c.z; iwv[r][7] = c.w; }
        f32x4 raw[4]; const int pgv = samp ? KIN(const int, 5)[db * NPAGES + (lane & 15)] : 0;
#define IDX_LOAD(kt_) do { const int key_ = 16 * (kt_) + fr; \
            if (!samp) { const bf16* kp = IKb + (size_t)(b * SEQ + key_) * 64 + 8 * fq; raw[0] = *(const f32x4*)kp; raw[1] = *(const f32x4*)(kp + 32); } \
            else if (key_ < SEQ) { const int page = __builtin_amdgcn_readlane(pgv, (kt_) >> 3);     const float* kp = KIN(const float, 4) + ((size_t)(page * 2 + j) * PAGE + (key_ & 127)) * IDXD + 8 * fq; \
                raw[0] = *(const f32x4*)kp; raw[1] = *(const f32x4*)(kp + 4); raw[2] = *(const f32x4*)(kp + 32); raw[3] = *(const f32x4*)(kp + 36); } \
            else { const int t_ = key_ - SEQ; const bf16* kp = IKb + (size_t)(TP + db * DSEQ + (t_ < DSEQ ? t_ : 0)) * 64 + 8 * fq; raw[0] = *(const f32x4*)kp; raw[1] = *(const f32x4*)(kp + 32); \
                if (t_ >= DSEQ) { raw[0] = (f32x4){0.f, 0.f, 0.f, 0.f}; raw[1] = raw[0]; } } } while (0)
        if (wave < nkt) IDX_LOAD(wave);
#ifndef PROBE_IDX
#define PROBE_IDX 0
#endif
        const int pmode = rep_ > 0 ? PROBE_IDX : 0;
        for (int kt = wave; kt < ((pmode & 2) ? 0 : nkt); kt += 8) {
            const int key = 16 * kt + fr; bf16x8 B0, B1;
            if (samp && key < SEQ) { v4u w0, w1; w0.x = cvtpk(raw[0].x, raw[0].y); w0.y = cvtpk(raw[0].z, raw[0].w); w0.z = cvtpk(raw[1].x, raw[1].y); w0.w = cvtpk(raw[1].z, raw[1].w);
                w1.x = cvtpk(raw[2].x, raw[2].y); w1.y = cvtpk(raw[2].z, raw[2].w); w1.z = cvtpk(raw[3].x, raw[3].y); w1.w = cvtpk(raw[3].z, raw[3].w); B0 = __builtin_bit_cast(bf16x8, w0); B1 = __builtin_bit_cast(bf16x8, w1); }
            else { B0 = __builtin_bit_cast(bf16x8, raw[0]); B1 = __builtin_bit_cast(bf16x8, raw[1]); }
            if (kt + 8 < nkt) IDX_LOAD(kt + 8);
            f32x4 score = {0.f, 0.f, 0.f, 0.f};
#pragma unroll
            for (int h = 0; h < 8; ++h) { f32x4 acc = {0.f, 0.f, 0.f, 0.f};
                acc = __builtin_amdgcn_mfma_f32_16x16x32_bf16(Af[h][0], B0, acc, 0, 0, 0); acc = __builtin_amdgcn_mfma_f32_16x16x32_bf16(Af[h][1], B1, acc, 0, 0, 0);
#pragma unroll
                for (int r = 0; r < 4; ++r) score[r] = fmaf(iwv[r][h], fmaxf(acc[r], 0.f), score[r]); }
#pragma unroll
            for (int r = 0; r < 4; ++r) { const int qrow = 4 * fq + r, qp_ = samp ? SEQ + (qrow & 7) : 16 * qg + qrow;
                ((LAS unsigned*)sc)[qrow * SC_STRIDE + key] = key <= qp_ ? fkey(score[r]) : 0u; }
        }
#undef IDX_LOAD
        { const int k0 = 16 * nkt, nmax = samp ? SEQ + DSEQ : 16 * qg + 16, k1r = ((nmax + 511) >> 9) << 9, k1 = k1r < SC_STRIDE ? k1r : SC_STRIDE;
          for (int e = tid_; e < 16 * (k1 - k0); e += 512) { const int rw = e / (k1 - k0), kk = k0 + (e - rw * (k1 - k0)); ((LAS unsigned*)sc)[rw * SC_STRIDE + kk] = 0u; } }
        __syncthreads();
        for (int qq = 0; qq < ((pmode & 1) ? 0 : (samp ? 1 : 2)); ++qq) {
            const int qi = samp ? wave : 2 * wave + qq, qpos = samp ? SEQ + qi : 16 * qg + qi, n = qpos + 1;
            u64* mw = (pmode ? WSP(u64, WS_RAW) : MASK) + (size_t)(mq0 + qi) * MASKW; u64 myword = 0ull;
            if (n <= TOPK) { const int lo = 64 * lane; myword = (n >= lo + 64) ? ~0ull : (n > lo ? ((1ull << (n - lo)) - 1ull) : 0ull); }
            else {
                const int nq = (n + 511) >> 9;
                unsigned u[33];
#define R8_(B, o) B((o) + 0) B((o) + 1) B((o) + 2) B((o) + 3) B((o) + 4) B((o) + 5) B((o) + 6) B((o) + 7)
#define FOR_NQ(B) do { R8_(B, 0) if (nq > 1) { R8_(B, 8) } if (nq > 2) { R8_(B, 16) } if (nq > 3) { R8_(B, 24) B(32) } } while (0)
#pragma unroll
                for (int i = 0; i < 33; ++i) u[i] = 0u;
#define B_LOAD(i) { const int s = lane + 64 * (i); if ((i) < 32) u[i] = ((const LAS unsigned*)sc)[qi * SC_STRIDE + s]; else if (s < n) u[i] = ((const LAS unsigned*)sc)[qi * SC_STRIDE + (s < SC_STRIDE ? s : 0)]; }
                FOR_NQ(B_LOAD);
                unsigned thr; int need2, mt = 0;
                { *(LAS v4u*)(hist + 8 * lane) = (v4u){0u, 0u, 0u, 0u}; *(LAS v4u*)(hist + 8 * lane + 4) = (v4u){0u, 0u, 0u, 0u};
#define B_H1(i) { __hip_atomic_fetch_add(hist + (u[i] != 0u ? (u[i] >> 23) : 512u + lane), 1u, __ATOMIC_RELAXED, __HIP_MEMORY_SCOPE_WAVEFRONT); }
                  FOR_NQ(B_H1);
#undef B_H1
                  int b1, ab1; hist_find(hist, TOPK, lane, b1, ab1); const unsigned pre1 = (unsigned)b1 << 23;
                  *(LAS v4u*)(hist + 8 * lane) = (v4u){0u, 0u, 0u, 0u}; *(LAS v4u*)(hist + 8 * lane + 4) = (v4u){0u, 0u, 0u, 0u};
#define B_H2(i) { const unsigned t_ = (u[i] - pre1) >> 14; __hip_atomic_fetch_add(hist + (t_ < 512u ? t_ : 512u + lane), 1u, __ATOMIC_RELAXED, __HIP_MEMORY_SCOPE_WAVEFRONT); }
                  FOR_NQ(B_H2);
#undef B_H2
                  int b2, ab2; hist_find(hist, TOPK - ab1, lane, b2, ab2);
                  thr = ((unsigned)b1 << 23) | ((unsigned)b2 << 14); need2 = TOPK - ab1 - ab2; }
#define B_TIE(i) { const u64 eb = __ballot(((u[i] ^ thr) >> 14) == 0u); if (eb != 0ull) { const int pos = mt + __popcll(eb & ((1ull << lane) - 1ull)); \
                    if (((eb >> lane) & 1ull) && pos < 64) tbuf[pos] = u[i] & 0x3fffu; mt += __popcll(eb); } }
                FOR_NQ(B_TIE);
                int cge;
                if (mt <= 64) { asm volatile("s_waitcnt lgkmcnt(0)" ::: "memory"); const unsigned my = lane < mt ? tbuf[lane] : 0u; unsigned lo = 0u; const bool in = lane < mt;
                    for (int bit = 13; bit >= 0; --bit) { const unsigned cand = lo | (1u << bit); if (__popcll(__ballot(in && my >= cand)) >= need2) lo = cand; }
                    thr |= lo; cge = (TOPK - need2) + __popcll(__ballot(in && my >= lo)); }
                else { for (int bit = 13; bit >= 0; --bit) { const unsigned cand = thr | (1u << bit); if (wave_total6(cnt_ge(u, cand, nq)) >= TOPK) thr = cand; }
                    cge = wave_total6(cnt_ge(u, thr, nq)); }
                unsigned wlo = 0u, whi = 0u;
#define B_FAST(i) { const u64 word = __ballot(u[i] >= thr); wlo = wrlane<(i)>((unsigned)word, wlo); whi = wrlane<(i)>((unsigned)(word >> 32), whi); }
#define B_SLOW(i) { const bool eq = u[i] == thr; const u64 eb = __ballot(eq); const int rank = running + __popcll(eb & ltmask); \
                    const u64 word = __ballot(u[i] > thr || (eq && rank < need)); running += __popcll(eb); wlo = wrlane<(i)>((unsigned)word, wlo); whi = wrlane<(i)>((unsigned)(word >> 32), whi); }
                if (cge == TOPK) { FOR_NQ(B_FAST); }
                else { const int cgt = (thr == 0xffffffffu) ? 0 : wave_total6(cnt_ge(u, thr + 1u, nq)); const int need = TOPK - cgt; int running = 0; const u64 ltmask = (1ull << lane) - 1ull;
                    FOR_NQ(B_SLOW); }
                myword = ((u64)whi << 32) | wlo;
#undef B_LOAD
#undef B_TIE
#undef B_FAST
#undef B_SLOW
#undef FOR_NQ
#undef R8_
            }
            if (lane < MASKW) mw[lane] = myword;
        }
        __syncthreads();
        }
    }
}


namespace att {
#ifndef ATT_SDEPTH
#define ATT_SDEPTH 1
#endif
constexpr float SCALE = 0.088388347648318440f, THR = 8.f, NEG = -3.0e38f;
constexpr int SHM_V = 16384, SHM_K = 16384;
#define KSWZ(row, colB) ((row) * 256 + ((colB) ^ (((row) & 7) << 4)))
#define SBAR() __builtin_amdgcn_sched_barrier(0)
__device__ __forceinline__ int v_st(int k, int c) { const int kk = (k & ~0xC) | ((k & 4) << 1) | ((k & 8) >> 1); return ((kk >> 3) * 4 + (c >> 5)) * 512 + ((kk & 7) * 32 + (c & 31)) * 2; }
__device__ __forceinline__ int v_rd_base(int lane) { return ((lane & 3) << 3) | (((lane >> 2) & 3) << 6) | (((lane >> 4) & 1) << 5) | (((lane >> 5) & 1) << 8); }
constexpr int v_rd_off(int d0, int ks, int half) { return d0 * 512 + ks * 4096 + half * 2048; }
template <int OFF> __device__ __forceinline__ s16x4 tr_read_i(int vb) { s16x4 r; asm volatile("ds_read_b64_tr_b16 %0, %1 offset:%2" : "=&v"(r) : "v"(vb), "i"(OFF) : "memory"); return r; }
#define MASK16(P, W) do { const unsigned nw_ = ~(W); _Pragma("unroll") for (int r = 0; r < 16; ++r) { \
    const unsigned sel_ = ((nw_ << (31 - ((r & 3) + 8 * (r >> 2)))) & 0x80000000u) | selc; P[r] = __builtin_amdgcn_fmed3f(P[r], __builtin_bit_cast(float, sel_), NEG); } } while (0)
template <bool TWO> __device__ __forceinline__ void partialSM(f32x16& p0, f32x16& p1, float& m_reg, float& mn, float& alpha) {
    constexpr float Cc = SCALE * 1.4426950408889634f;
    float pmax = p0[0];
#pragma unroll
    for (int r = 1; r < 16; ++r) pmax = fmaxf(pmax, p0[r]);
    if (TWO) {
#pragma unroll
        for (int r = 0; r < 16; ++r) pmax = fmaxf(pmax, p1[r]); }
    { auto rr = __builtin_amdgcn_permlane32_swap(__float_as_uint(pmax), __float_as_uint(pmax), false, false); pmax = fmaxf(__uint_as_float(rr[0]), __uint_as_float(rr[1])); }
    if (__builtin_expect(__all(pmax - m_reg <= THR / SCALE), 1)) { mn = m_reg; alpha = 1.f; }
    else { mn = fmaxf(m_reg, pmax); alpha = __builtin_amdgcn_exp2f((m_reg - mn) * Cc); m_reg = mn; }
    const float mnC = -mn * Cc;
#pragma unroll
    for (int r = 0; r < 16; ++r) p0[r] = fmaf(p0[r], Cc, mnC);
    if (TWO) {
#pragma unroll
        for (int r = 0; r < 16; ++r) p1[r] = fmaf(p1[r], Cc, mnC); }
#pragma unroll
    for (int r = 0; r < 16; ++r) p0[r] = __builtin_amdgcn_exp2f(p0[r]);
}
#define PK4(P, BASE, OUT) do { unsigned a0 = cvtpk(P[BASE + 0], P[BASE + 1]), a1 = cvtpk(P[BASE + 2], P[BASE + 3]);   \
    unsigned b0 = cvtpk(P[BASE + 4], P[BASE + 5]), b1 = cvtpk(P[BASE + 6], P[BASE + 7]);                              \
    auto r0 = __builtin_amdgcn_permlane32_swap(a0, b0, false, false); auto r1 = __builtin_amdgcn_permlane32_swap(a1, b1, false, false); \
    v4u w_ = {r0[0], r1[0], r0[1], r1[1]}; OUT = __builtin_bit_cast(bf16x8, w_); } while (0)
__device__ __forceinline__ void finishSM(f32x16& p0, f32x16& p1, float alpha, float& l_reg, bf16x8& pa0, bf16x8& pa1, bf16x8& pa2, bf16x8& pa3) {
#pragma unroll
    for (int r = 0; r < 16; ++r) p1[r] = __builtin_amdgcn_exp2f(p1[r]);
    float ps = 0;
#pragma unroll
    for (int r = 0; r < 16; ++r) ps += p0[r];
#pragma unroll
    for (int r = 0; r < 16; ++r) ps += p1[r];
    { auto rr = __builtin_amdgcn_permlane32_swap(__float_as_uint(ps), __float_as_uint(ps), false, false); ps = __uint_as_float(rr[0]) + __uint_as_float(rr[1]); }
    l_reg = l_reg * alpha + ps;
    PK4(p0, 0, pa0); PK4(p0, 8, pa1); PK4(p1, 0, pa2); PK4(p1, 8, pa3);
}
__device__ __forceinline__ void qkt(f32x16& p0, f32x16& p1, int Ks, const bf16x8* qr, int r32, int hi) {
    p0 = f32x16{}; p1 = f32x16{};
#pragma unroll
    for (int d0 = 0; d0 < 8; ++d0) { const int cb = (d0 * 16 + hi * 8) * 2;
        const bf16x8 b0 = *(const LAS bf16x8*)(uintptr_t)(Ks + KSWZ(r32, cb)); const bf16x8 b1 = *(const LAS bf16x8*)(uintptr_t)(Ks + KSWZ(32 + r32, cb));
        p0 = __builtin_amdgcn_mfma_f32_32x32x16_bf16(b0, qr[d0], p0, 0, 0, 0); p1 = __builtin_amdgcn_mfma_f32_32x32x16_bf16(b1, qr[d0], p1, 0, 0, 0); }
}
#define PKLH(L, H) (bf16x8){L[0], L[1], L[2], L[3], H[0], H[1], H[2], H[3]}
template <int D0> __device__ __forceinline__ void pv_one(f32x16& od, int vb, bf16x8 pa0, bf16x8 pa1, bf16x8 pa2, bf16x8 pa3) {
    const s16x4 l0 = tr_read_i<v_rd_off(D0, 0, 0)>(vb), h0 = tr_read_i<v_rd_off(D0, 0, 1)>(vb), l1 = tr_read_i<v_rd_off(D0, 1, 0)>(vb), h1 = tr_read_i<v_rd_off(D0, 1, 1)>(vb);
    const s16x4 l2 = tr_read_i<v_rd_off(D0, 2, 0)>(vb), h2 = tr_read_i<v_rd_off(D0, 2, 1)>(vb), l3 = tr_read_i<v_rd_off(D0, 3, 0)>(vb), h3 = tr_read_i<v_rd_off(D0, 3, 1)>(vb);
    asm volatile("s_waitcnt lgkmcnt(0)" ::: "memory"); SBAR();
    od = __builtin_amdgcn_mfma_f32_32x32x16_bf16(pa0, PKLH(l0, h0), od, 0, 0, 0); od = __builtin_amdgcn_mfma_f32_32x32x16_bf16(pa1, PKLH(l1, h1), od, 0, 0, 0);
    od = __builtin_amdgcn_mfma_f32_32x32x16_bf16(pa2, PKLH(l2, h2), od, 0, 0, 0); od = __builtin_amdgcn_mfma_f32_32x32x16_bf16(pa3, PKLH(l3, h3), od, 0, 0, 0);
}
__device__ __forceinline__ void pv_d0(f32x16* o, int vb, bf16x8 pa0, bf16x8 pa1, bf16x8 pa2, bf16x8 pa3) {
    pv_one<0>(o[0], vb, pa0, pa1, pa2, pa3); pv_one<1>(o[1], vb, pa0, pa1, pa2, pa3); pv_one<2>(o[2], vb, pa0, pa1, pa2, pa3); pv_one<3>(o[3], vb, pa0, pa1, pa2, pa3);
}
template <int D0> __device__ __forceinline__ void pv_one32(f32x16& od, int vb, bf16x8 pa0, bf16x8 pa1) {
    const s16x4 l0 = tr_read_i<v_rd_off(D0, 0, 0)>(vb), h0 = tr_read_i<v_rd_off(D0, 0, 1)>(vb), l1 = tr_read_i<v_rd_off(D0, 1, 0)>(vb), h1 = tr_read_i<v_rd_off(D0, 1, 1)>(vb);
    asm volatile("s_waitcnt lgkmcnt(0)" ::: "memory"); SBAR();
    od = __builtin_amdgcn_mfma_f32_32x32x16_bf16(pa0, PKLH(l0, h0), od, 0, 0, 0); od = __builtin_amdgcn_mfma_f32_32x32x16_bf16(pa1, PKLH(l1, h1), od, 0, 0, 0);
}

__device__ __forceinline__ bf16x8 scale8(bf16x8 x, float s) { const v4u w = __builtin_bit_cast(v4u, x); v4u o;
    o.x = cvtpk(bflo(w.x) * s, bfhi(w.x) * s); o.y = cvtpk(bflo(w.y) * s, bfhi(w.y) * s); o.z = cvtpk(bflo(w.z) * s, bfhi(w.z) * s); o.w = cvtpk(bflo(w.w) * s, bfhi(w.w) * s); return __builtin_bit_cast(bf16x8, o); }
constexpr int PR_V = 0, PR_K = 3 * SHM_V, PR_WS = PR_K + 3 * SHM_K;
#ifndef PROBE_ATT
#define PROBE_ATT 0
#endif
template <int PM> __device__ __forceinline__ void prompt_unit(Ctx& C, int b, int qblk, int g) {
    int tid = C.tid; asm volatile("" : "+v"(tid));
    const int wid = __builtin_amdgcn_readfirstlane(tid >> 6), lane = tid & 63, r32 = lane & 31, hi = lane >> 5, hh = wid >> 1, qs = wid & 1;
    unsigned selc = 0x7f61b1e6u; asm volatile("" : "+v"(selc));
    const int V_lds = (int)(uintptr_t)C.lds + PR_V, K_lds = (int)(uintptr_t)C.lds + PR_K; LAS float* wsm = (LAS float*)(C.lds + PR_WS) + wid * 64; LAS float* li_l = wsm; LAS float* al_l = wsm + 32;
    const bf16* Q = WSP(bf16, WS_Q); const bf16* Kh = WSP(bf16, WS_KB) + (size_t)b * SEQ * KVW + g * HD; const bf16* Vh = WSP(bf16, WS_VB) + (size_t)b * SEQ * KVW + g * HD;
    const int mq = b * SEQ + 64 * qblk + 32 * qs + r32; const u64* MK = WSP(u64, WS_MASK); const unsigned mo = (unsigned)mq * MASKW;
    float m_reg = -1e30f, l_reg = 0; f32x16 o[4] = {}; bf16x8 qr[8];
    { const unsigned qo = (unsigned)mq * D + (4 * g + hh) * HD + hi * 8;
#pragma unroll
      for (int d0 = 0; d0 < 8; ++d0) qr[d0] = *(const bf16x8*)(Q + (qo + d0 * 16));
      const f32x4 pq = *(const f32x4*)(WSP(float, WS_QSS) + ((size_t)mq * NH + (4 * g + hh)) * 4); const float rq = rsq(((pq.x + pq.y) + (pq.z + pq.w)) * (1.0f / HD) + EPS);
#pragma unroll
      for (int d0 = 0; d0 < 8; ++d0) qr[d0] = scale8(qr[d0], rq); }
    unsigned koff[2], voff[2];
#pragma unroll
    for (int i = 0; i < 2; ++i) { const int s = tid + 512 * i; { const int row = s >> 4, chunk = (s & 15) ^ (row & 7); koff[i] = (unsigned)(row * KVW + chunk * 8); }
        { const int blk = s >> 5, kk = ((blk >> 2) << 3) | ((s & 31) >> 2), k = (kk & ~0xC) | ((kk & 4) << 1) | ((kk & 8) >> 1), c = (blk & 3) * 32 + (s & 3) * 8; voff[i] = (unsigned)(k * KVW + c); } }
    const int vb0 = V_lds + v_rd_base(lane);
#define GLDS(t_) do { const int sl_ = (t_) % 3; const bf16* Kt_ = Kh + (size_t)(t_) * 64 * KVW; const bf16* Vt_ = Vh + (size_t)(t_) * 64 * KVW; _Pragma("unroll") for (int i_ = 0; i_ < 2; ++i_) { \
    __builtin_amdgcn_global_load_lds((const unsigned*)(Kt_ + koff[i_]), (LAS unsigned*)(uintptr_t)(K_lds + sl_ * SHM_K + wid * 1024 + i_ * 8192), 16, 0, 0); \
    __builtin_amdgcn_global_load_lds((const unsigned*)(Vt_ + voff[i_]), (LAS unsigned*)(uintptr_t)(V_lds + sl_ * SHM_V + wid * 1024 + i_ * 8192), 16, 0, 0); } } while (0)
#define STEP_SYNC() do { asm volatile("s_waitcnt vmcnt(0)" ::: "memory"); __builtin_amdgcn_s_barrier(); asm volatile("" ::: "memory"); } while (0)
#define RESC(a) do { if (__any((a) < 1.f)) { if (hi == 0) al_l[r32] = (a); asm volatile("s_waitcnt lgkmcnt(0)" ::: "memory"); \
    _Pragma("unroll") for (int d = 0; d < 4; ++d) _Pragma("unroll") for (int r = 0; r < 16; ++r) o[d][r] *= al_l[crow(r, hi)]; } } while (0)
#define APPLYMASK(P0, P1, MK_) do { if (PM & 1) break; const unsigned w0_ = (unsigned)(MK_) >> (4 * hi), w1_ = (unsigned)((MK_) >> 32) >> (4 * hi); MASK16(P0, w0_); MASK16(P1, w1_); } while (0)
    f32x16 pA0 = {}, pA1 = {}, pB0 = {}, pB1 = {}; float mnA, mnB, alA, alB; bf16x8 pa0, pa1, pa2, pa3; const int NT = (qblk + 2) & ~1;
    u64 mk = MK[mo];
    GLDS(0); GLDS(1); STEP_SYNC();
    if (!(PM & 4)) qkt(pA0, pA1, K_lds, qr, r32, hi); APPLYMASK(pA0, pA1, mk); mk = MK[mo + 1]; partialSM<true>(pA0, pA1, m_reg, mnA, alA);
    int sK = 1, sV = 0;
    for (int jt = 1; jt + 1 < NT; jt += 2) {
        { const int t_ = jt + 1; GLDS(t_); }
        SBAR(); if (!(PM & 4)) qkt(pB0, pB1, K_lds + sK * SHM_K, qr, r32, hi);
        finishSM(pA0, pA1, alA, l_reg, pa0, pa1, pa2, pa3); SBAR();
        if (!(PM & 2)) pv_d0(o, vb0 + sV * SHM_V, pa0, pa1, pa2, pa3); APPLYMASK(pB0, pB1, mk); mk = MK[mo + (unsigned)(jt + 1)]; partialSM<true>(pB0, pB1, m_reg, mnB, alB);
        RESC(alB); STEP_SYNC();
        sV = sK; sK = sK == 2 ? 0 : sK + 1;
        if (jt + 2 < NT) { const int t_ = jt + 2; GLDS(t_); }
        SBAR(); if (!(PM & 4)) qkt(pA0, pA1, K_lds + sK * SHM_K, qr, r32, hi);
        finishSM(pB0, pB1, alB, l_reg, pa0, pa1, pa2, pa3); SBAR();
        if (!(PM & 2)) pv_d0(o, vb0 + sV * SHM_V, pa0, pa1, pa2, pa3); APPLYMASK(pA0, pA1, mk); mk = MK[mo + (unsigned)(jt + 2)]; partialSM<true>(pA0, pA1, m_reg, mnA, alA);
        RESC(alA); STEP_SYNC();
        sV = sK; sK = sK == 2 ? 0 : sK + 1;
    }
    SBAR(); if (!(PM & 4)) qkt(pB0, pB1, K_lds + sK * SHM_K, qr, r32, hi);
    finishSM(pA0, pA1, alA, l_reg, pa0, pa1, pa2, pa3); SBAR();
    if (!(PM & 2)) pv_d0(o, vb0 + sV * SHM_V, pa0, pa1, pa2, pa3); APPLYMASK(pB0, pB1, mk); partialSM<true>(pB0, pB1, m_reg, mnB, alB);
    RESC(alB);
    finishSM(pB0, pB1, alB, l_reg, pa0, pa1, pa2, pa3); SBAR();
    if (!(PM & 2)) pv_d0(o, vb0 + sK * SHM_V, pa0, pa1, pa2, pa3);
    if (hi == 0) li_l[r32] = l_reg; asm volatile("s_waitcnt lgkmcnt(0)" ::: "memory");
    __syncthreads();
    { const int ot = (int)(uintptr_t)C.lds + wid * 8704;
#pragma unroll
      for (int r = 0; r < 16; ++r) { const int orow = crow(r, hi); const float rl = __builtin_amdgcn_rcpf(li_l[orow]);
#pragma unroll
          for (int d0 = 0; d0 < 4; ++d0) *(LAS bf16*)(uintptr_t)(ot + orow * 272 + (d0 * 32 + r32) * 2) = (bf16)f2bf(o[d0][r] * rl); }
      asm volatile("s_waitcnt lgkmcnt(0)" ::: "memory");
      const bf16* SZ = WSP(bf16, WS_SZ); bf16* AO = PM ? WSP(bf16, WS_RAW) : WSP(bf16, WS_AO);
#pragma unroll
      for (int e = 0; e < 8; ++e) { const int idx = lane + 64 * e, row = idx >> 4, ch = idx & 15; const unsigned off = (unsigned)(b * SEQ + 64 * qblk + 32 * qs + row) * D + (4 * g + hh) * HD + ch * 8;
          const v4u ov = *(const LAS v4u*)(uintptr_t)(ot + row * 272 + ch * 16), sz = *(const v4u*)(SZ + off); v4u y;
          y.x = cvtpk(bflo(ov.x) * bflo(sz.x), bfhi(ov.x) * bfhi(sz.x)); y.y = cvtpk(bflo(ov.y) * bflo(sz.y), bfhi(ov.y) * bfhi(sz.y));
          y.z = cvtpk(bflo(ov.z) * bflo(sz.z), bfhi(ov.z) * bfhi(sz.z)); y.w = cvtpk(bflo(ov.w) * bflo(sz.w), bfhi(ov.w) * bfhi(sz.w));
          *(v4u*)(AO + off) = y; } }
    __syncthreads();
#undef GLDS
#undef STEP_SYNC
}

constexpr int SU_ROFF = 65536, SU_QB = SU_ROFF + 2112 * 4, SU_CM = SU_QB + 2112, SU_ML = 131072, SU_N = SU_ML + 2048 + 1024, SU_MQ = SU_CM + 8 * 68 * 4, SU_PFX = SU_MQ + 9 * 34 * 8;
__device__ __forceinline__ void sample_unit(Ctx& C, int j, int db, int g) {
    int tid = C.tid; asm volatile("" : "+v"(tid));
    const int wid = __builtin_amdgcn_readfirstlane(tid >> 6), lane = tid & 63, r32 = lane & 31, hi = lane >> 5;
    unsigned selc = 0x7f61b1e6u; asm volatile("" : "+v"(selc));
    LAS unsigned char* lds = C.lds; LAS unsigned* roff = (LAS unsigned*)(lds + SU_ROFF); LAS unsigned char* qb = lds + SU_QB; LAS unsigned* cm = (LAS unsigned*)(lds + SU_CM);
    LAS float* ml = (LAS float*)(lds + SU_ML); LAS int* nUp = (LAS int*)(lds + SU_N);
    const int m0 = TP + db * DSEQ; const u64* mp = WSP(u64, WS_MASK) + (size_t)m0 * MASKW;
    LAS u64* mq = (LAS u64*)(lds + SU_MQ); LAS int* pfx = (LAS int*)(lds + SU_PFX);
    if (lane < 33) mq[wid * 34 + lane] = mp[wid * MASKW + lane];
    __syncthreads();
    if (wid == 0) { u64 uw = 0ull; if (lane < 33) {
#pragma unroll
            for (int t = 0; t < 8; ++t) uw |= mq[t * 34 + lane]; }
        const int cnt = __popcll(uw); int inc = cnt;
#pragma unroll
        for (int o = 1; o < 64; o <<= 1) { const int v = __shfl_up(inc, o); if (lane >= o) inc += v; }
        if (lane < 34) { pfx[lane] = inc - cnt; mq[8 * 34 + lane] = uw; }
        if (lane == 63) nUp[0] = inc; }
    __syncthreads();
    const int nU = nUp[0], nT = (nU + 31) >> 5;
    for (int s = tid; s < 33 * 64; s += 512) { const int i = s >> 6, bt = s & 63; const u64 uw = mq[8 * 34 + i];
        if ((uw >> bt) & 1ull) { const int pos = pfx[i] + __popcll(uw & ((1ull << bt) - 1ull)); unsigned off;
            if (s < SEQ) { const int page = KIN(const int, 5)[db * NPAGES + (s >> 7)]; off = (unsigned)(((page * 2 + j) * PAGE + (s & 127)) * KVW); } else off = 0x80000000u | (unsigned)((s - SEQ) * KVW);
            roff[pos] = off; unsigned qq = 0;
#pragma unroll
            for (int t = 0; t < 8; ++t) qq |= (unsigned)((mq[t * 34 + i] >> bt) & 1ull) << t;
            qb[pos] = (unsigned char)qq; } }
    __syncthreads();
    { const unsigned off0 = roff[0]; for (int c = nU + tid; c < nT * 32; c += 512) { roff[c] = off0; qb[c] = 0; } }
    __syncthreads();
    for (int c0 = wid * 64; c0 < nT * 32; c0 += 512) { const unsigned qq = (c0 + lane < nT * 32) ? qb[c0 + lane] : 0u;
#pragma unroll
        for (int t = 0; t < 8; ++t) { const u64 bw = __ballot((qq >> t) & 1u); if (lane == 0) { cm[t * 68 + (c0 >> 5)] = (unsigned)bw; cm[t * 68 + (c0 >> 5) + 1] = (unsigned)(bw >> 32); } } }
    __syncthreads();
    const float* kc = KIN(const float, 2) + g * HD; const float* vc = KIN(const float, 3) + g * HD;
    const float* kn = C.out + O_KS + (size_t)(db * 2 + j) * DSEQ * KVW + g * HD; const float* vn = C.out + O_VS + (size_t)(db * 2 + j) * DSEQ * KVW + g * HD;
    const int hh = r32 >> 3, t = r32 & 7;
    bf16x8 qr[8]; { const bf16* Qw = WSP(bf16, WS_Q) + (size_t)(m0 + t) * D + (4 * g + hh) * HD + hi * 8;
#pragma unroll
        for (int d0 = 0; d0 < 8; ++d0) qr[d0] = *(const bf16x8*)(Qw + d0 * 16);
        const f32x4 pq = *(const f32x4*)(WSP(float, WS_QSS) + ((size_t)(m0 + t) * NH + (4 * g + hh)) * 4); const float rq = rsq(((pq.x + pq.y) + (pq.z + pq.w)) * (1.0f / HD) + EPS);
#pragma unroll
        for (int d0 = 0; d0 < 8; ++d0) qr[d0] = scale8(qr[d0], rq); }
    const int kt = (int)(uintptr_t)lds + wid * 8192, vt = kt, vbr = vt + v_rd_base(lane); const int cc = lane & 31;
    LAS float* al_l = ml + 512 + wid * 32;
    float m_reg = -1e30f, l_reg = 0.f; f32x16 o[4] = {};
    for (int ti = wid; ti < nT; ti += 8) {
        { f32x4 st[16];
#pragma unroll
          for (int k = 0; k < 16; ++k) { const unsigned ro = roff[ti * 32 + 2 * k + hi]; st[k] = *(const f32x4*)(((ro >> 31) ? kn : kc) + (ro & 0x7fffffffu) + 4 * cc); }
#pragma unroll
          for (int k = 0; k < 16; ++k) { const int i = 2 * k + hi; u32x2v w; w.x = cvtpk(st[k].x, st[k].y); w.y = cvtpk(st[k].z, st[k].w); *(LAS u32x2v*)(uintptr_t)(kt + KSWZ(i, cc * 8)) = w; } }
        f32x4 sv[16];
#pragma unroll
        for (int k = 0; k < 16; ++k) { const unsigned ro = roff[ti * 32 + 2 * k + hi]; sv[k] = *(const f32x4*)(((ro >> 31) ? vn : vc) + (ro & 0x7fffffffu) + 4 * cc); }
        f32x16 p0 = {}, pdummy = {};
#pragma unroll
        for (int d0 = 0; d0 < 8; ++d0) { const bf16x8 kf = *(const LAS bf16x8*)(uintptr_t)(kt + KSWZ(r32, (d0 * 16 + hi * 8) * 2)); p0 = __builtin_amdgcn_mfma_f32_32x32x16_bf16(kf, qr[d0], p0, 0, 0, 0); }
        const unsigned cw = cm[t * 68 + ti] >> (4 * hi); MASK16(p0, cw);
        float mn, alpha; partialSM<false>(p0, pdummy, m_reg, mn, alpha);
        float ps = 0;
#pragma unroll
        for (int r = 0; r < 16; ++r) ps += p0[r];
        { auto rr = __builtin_amdgcn_permlane32_swap(__float_as_uint(ps), __float_as_uint(ps), false, false); ps = __uint_as_float(rr[0]) + __uint_as_float(rr[1]); }
        l_reg = l_reg * alpha + ps;
        bf16x8 pa0, pa1; PK4(p0, 0, pa0); PK4(p0, 8, pa1);
        if (__any(alpha < 1.f)) { if (hi == 0) al_l[r32] = alpha; asm volatile("s_waitcnt lgkmcnt(0)" ::: "memory");
#pragma unroll
            for (int d = 0; d < 4; ++d)
#pragma unroll
                for (int r = 0; r < 16; ++r) o[d][r] *= al_l[crow(r, hi)]; }
        asm volatile("s_waitcnt lgkmcnt(0)" ::: "memory");
#pragma unroll
        for (int k = 0; k < 16; ++k) { const int i = 2 * k + hi; u32x2v w; w.x = cvtpk(sv[k].x, sv[k].y); w.y = cvtpk(sv[k].z, sv[k].w); *(LAS u32x2v*)(uintptr_t)(vt + v_st(i, 4 * cc)) = w; }
        asm volatile("s_waitcnt lgkmcnt(0)" ::: "memory");
        pv_one32<0>(o[0], vbr, pa0, pa1); pv_one32<1>(o[1], vbr, pa0, pa1); pv_one32<2>(o[2], vbr, pa0, pa1); pv_one32<3>(o[3], vbr, pa0, pa1);
    }
    if (hi == 0) { ml[(wid * 32 + r32) * 2] = m_reg; ml[(wid * 32 + r32) * 2 + 1] = l_reg; }
    __syncthreads();
    { constexpr float Cc = SCALE * 1.4426950408889634f;
      float fac[16];
#pragma unroll
      for (int r = 0; r < 16; ++r) { const int row = crow(r, hi); float M = -1e30f;
#pragma unroll
          for (int w = 0; w < 8; ++w) M = fmaxf(M, ml[(w * 32 + row) * 2]);
          float L = 0.f;
#pragma unroll
          for (int w = 0; w < 8; ++w) L += ml[(w * 32 + row) * 2 + 1] * __builtin_amdgcn_exp2f((ml[(w * 32 + row) * 2] - M) * Cc);
          fac[r] = __builtin_amdgcn_exp2f((ml[(wid * 32 + row) * 2] - M) * Cc) * __builtin_amdgcn_rcpf(L); }
      LAS float* part = (LAS float*)lds + wid * 4096;
#pragma unroll
      for (int d0 = 0; d0 < 4; ++d0)
#pragma unroll
          for (int r = 0; r < 16; ++r) part[crow(r, hi) * 128 + d0 * 32 + r32] = o[d0][r] * fac[r]; }
    __syncthreads();
    { const bf16* SZ = WSP(bf16, WS_SZ); bf16* AO = WSP(bf16, WS_AO); const LAS float* part = (const LAS float*)lds;
#pragma unroll
      for (int e = 0; e < 8; ++e) { const int idx = tid + 512 * e, row = idx >> 7, d = idx & 127; float s = 0.f;
#pragma unroll
          for (int w = 0; w < 8; ++w) s += part[w * 4096 + idx];
          const size_t off = (size_t)(m0 + (row & 7)) * D + (4 * g + (row >> 3)) * HD + d; AO[off] = (bf16)f2bf(s * bf2f(SZ[off])); } }
    __syncthreads();
}
#undef RESC
#undef APPLYMASK
}

__device__ __forceinline__ void attn_phase(Ctx& C, int j) {
    const int c = C.bid;
    for (int pass = 0; pass < 2; ++pass) {
        if ((pass == 0) == ((c & 1) == 0)) { for (int u = c; u < DBATCH * NKV; u += C.G) att::sample_unit(C, j, u >> 1, u & 1); }
        else {
            for (int u = c; u < 256; u += C.G) { const int x = u & 7, y = u >> 3, bg = 2 * x + (y >> 4), qp = y & 15;
#pragma clang loop unroll(disable)
                for (int k = 0; k < 2; ++k) att::prompt_unit<0>(C, bg >> 1, k ? 31 - qp : qp, bg & 1); }
#if PROBE_ATT
            for (int u = c; u < 256; u += C.G) { const int x = u & 7, y = u >> 3, bg = 2 * x + (y >> 4), qp = y & 15;
#pragma clang loop unroll(disable)
                for (int k = 0; k < 2; ++k) att::prompt_unit<PROBE_ATT>(C, bg >> 1, k ? 31 - qp : qp, bg & 1); }
#endif
        }
    }
}

template <class F> __device__ __forceinline__ void small_gemm(Ctx& C, const bf16* A, const bf16* Bt, int N, int K, const F& f) {
    int tid = C.tid; asm volatile("" : "+v"(tid));
    const int lane = tid & 63, wave = __builtin_amdgcn_readfirstlane(tid >> 6), fr = lane & 15, fq = lane >> 4;
    LAS float* part = (LAS float*)C.lds;
    const int ntn = N / 64, ntiles = (TS / 64) * ntn, kw = K / 8;
#ifdef NO_SMALL
    if (true) return;
#endif
    for (int tile = C.bid; tile < ntiles; tile += C.G) {
        const int tm = tile / ntn, tn = tile - tm * ntn;
        f32x4 acc[4][4];
#pragma unroll
        for (int m = 0; m < 4; ++m)
#pragma unroll
            for (int n = 0; n < 4; ++n) acc[m][n] = (f32x4){0.f, 0.f, 0.f, 0.f};
        const bf16* ap = A + (size_t)(TP + 64 * tm + fr) * K + wave * kw + 8 * fq; const bf16* bp = Bt + (size_t)(64 * tn + fr) * K + wave * kw + 8 * fq;
        for (int kc = 0; kc < kw; kc += 128) { bf16x8 af[4][4], bfr[4][4];
#pragma unroll
            for (int q = 0; q < 4; ++q) if (kc + 32 * q < kw) {
#pragma unroll
                for (int m = 0; m < 4; ++m) { af[q][m] = *(const bf16x8*)(ap + (size_t)(16 * m) * K + kc + 32 * q); bfr[q][m] = *(const bf16x8*)(bp + (size_t)(16 * m) * K + kc + 32 * q); } }
#pragma unroll
            for (int q = 0; q < 4; ++q) if (kc + 32 * q < kw) {
#pragma unroll
                for (int m = 0; m < 4; ++m)
#pragma unroll
                    for (int n = 0; n < 4; ++n) acc[m][n] = __builtin_amdgcn_mfma_f32_16x16x32_bf16(bfr[q][n], af[q][m], acc[m][n], 0, 0, 0); } }
#pragma unroll
        for (int m = 0; m < 4; ++m)
#pragma unroll
            for (int n = 0; n < 4; ++n)
                *(LAS f32x4*)(part + (wave * 64 + 16 * m + fr) * 68 + 16 * n + 4 * fq) = acc[m][n];
        __syncthreads();
        { const int row = tid >> 3, c8 = (tid & 7) * 8; f32x4 s0 = {0.f, 0.f, 0.f, 0.f}, s1 = s0;
#pragma unroll
          for (int w = 0; w < 8; ++w) { s0 += *(const LAS f32x4*)(part + (w * 64 + row) * 68 + c8); s1 += *(const LAS f32x4*)(part + (w * 64 + row) * 68 + c8 + 4); }
          f(TP + 64 * tm + row, 64 * tn + c8, s0, s1, tid); }
        __syncthreads();
    }
}
__device__ __forceinline__ float sq8(const f32x4& a, const f32x4& b) { return (a.x * a.x + a.y * a.y) + (a.z * a.z + a.w * a.w) + (b.x * b.x + b.y * b.y) + (b.z * b.z + b.w * b.w); }
__device__ __forceinline__ v4u pack8(const f32x4& a, const f32x4& b) { v4u w; w.x = cvtpk(a.x, a.y); w.y = cvtpk(a.z, a.w); w.z = cvtpk(b.x, b.y); w.w = cvtpk(b.z, b.w); return w; }
__device__ __forceinline__ float sum8lanes(float q) { q += __shfl_xor(q, 1); q += __shfl_xor(q, 2); q += __shfl_xor(q, 4); return q; }
struct SEpiBf16 { bf16* O; int ldc;
    __device__ __forceinline__ void operator()(int row, int col, const f32x4& a, const f32x4& b, int) const { *(v4u*)(O + (size_t)row * ldc + col) = pack8(a, b); } };
struct SEpiRes { const float* xf; const bf16* xbin; bf16* x1b; float* ss1;
    __device__ __forceinline__ void operator()(int row, int col, const f32x4& sa, const f32x4& sb, int tid) const { const size_t off = (size_t)row * D + col;
        f32x4 a, b; ld8f(xf, xbin, off, a, b); a += sa; b += sb;
        *(v4u*)(x1b + off) = pack8(a, b);
        const float q = sum8lanes(sq8(a, b)); if ((tid & 7) == 0) ss1[(size_t)row * 16 + (col >> 6)] = q; } };
struct SEpiGate { const float* ss1; const bf16* x1b; const bf16* pe; float* xout; bf16* xb; float* ssx;
    __device__ __forceinline__ void operator()(int row, int col, const f32x4& sa, const f32x4& sb, int tid) const { const size_t off = (size_t)row * D + col; const float r1 = row_r16(ss1, row, 1.0f / D);
        const v4u pw = *(const v4u*)(pe + off); f32x4 xa, xc; ld8f(nullptr, x1b, off, xa, xc); const f32x4 ga = sa * r1, gb = sb * r1; f32x4 a, b;
        a.x = xa.x + sigm(ga.x) * bflo(pw.x); a.y = xa.y + sigm(ga.y) * bfhi(pw.x); a.z = xa.z + sigm(ga.z) * bflo(pw.y); a.w = xa.w + sigm(ga.w) * bfhi(pw.y);
        b.x = xc.x + sigm(gb.x) * bflo(pw.z); b.y = xc.y + sigm(gb.y) * bfhi(pw.z); b.z = xc.z + sigm(gb.z) * bflo(pw.w); b.w = xc.w + sigm(gb.w) * bfhi(pw.w);
        if (xout) { *(f32x4*)(xout + off) = a; *(f32x4*)(xout + off + 4) = b; } *(v4u*)(xb + off) = pack8(a, b);
        const float q = sum8lanes(sq8(a, b)); if ((tid & 7) == 0) ssx[(size_t)row * 16 + (col >> 6)] = q; } };
#ifndef ONLY_PHASE
#define PHASE_ON(k) true
#else
#define PHASE_ON(k) ((k) == ONLY_PHASE)
#endif
#define IN(k) (PHASE_ON(k) && lo <= (k) && (k) < hi)
#ifndef DUP_PHASE
#define DUP_PHASE (-1)
#endif
#define RUN(k, ...) do { if (IN(k)) { __VA_ARGS__; if ((k) == DUP_PHASE) { xcd_barrier(bar); __VA_ARGS__; } } } while (0)
#ifndef SEAM_REPS
#define SEAM_REPS 1
#endif
#define SEAM(k) do { if (lo <= (k) && (k) + 1 < hi) { for (int r_ = 0; r_ < SEAM_REPS; ++r_) xcd_barrier(bar); } } while (0)
template <int jj> __device__ __forceinline__ void layer_pair(Ctx& C, const XcdBarrier& bar, const int lo, const int hi) {
    LAS unsigned char* ring = C.lds;
        const int ia = 2 * jj, ib = 2 * jj + 1, pb = 1 + 9 * jj;
        RUN(pb, { pg8::Gemm g{WSP(bf16, WS_XB0), WSP(bf16, WS_WINA + jj * SZ_WINA), T, NA_IN, D}; pg8::StaticOrder S; S.init(T, NA_IN, C.G, C.bid);
            EpiA1 E{WSP(float, WS_SSX), WSP(bf16, WS_UZ), WSP(bf16, WS_VR), WSP(float, WS_VSS)}; pg8::gemm_phase<EpiA1, pg8::StaticOrder, true, true>(ring, g, S, E);
            if (jj == 0 && C.G == 256 && C.bid >= 96) prologue_part(C, 1, true, (C.bid - 96) * 8 + C.wave, 160 * 8); });
#ifdef PROBE_PLAIN_A1
        if (IN(pb)) { xcd_barrier(bar); pg8::Gemm g{WSP(bf16, WS_XB0), WSP(bf16, WS_WINA + jj * SZ_WINA), T, NA_IN, D}; pg8::StaticOrder S; S.init(T, NA_IN, C.G, C.bid);
#if PROBE_PLAIN_A1 == 2
            EpiNull E{WSP(float, WS_RAW)}; pg8::gemm_phase<EpiNull, pg8::StaticOrder, true, true>(ring, g, S, E); }
#else
            EpiBf16S E{WSP(bf16, WS_RAW), NA_IN}; pg8::gemm_phase<EpiBf16S, pg8::StaticOrder, true, true>(ring, g, S, E); }
#endif
#endif
        SEAM(pb);
        RUN(pb + 1, gate_phase(C, jj));
        SEAM(pb + 1);
        RUN(pb + 2, {
            { pg8::Gemm g{WSP(bf16, WS_Y), WSP(bf16, WS_WOUTA + jj * SZ_WOUTA), TP, D, AW}; pg8::StaticOrder S; S.init(TP, D, C.G, C.bid);
              EpiRes<jj == 0> E{KIN(const float, 0), WSP(bf16, WS_XB0), WSP(bf16, WS_XB1), WSP(float, WS_SS1)};
              pg8::gemm_phase<EpiRes<jj == 0>, pg8::StaticOrder, true, true>(ring, g, S, E); }
            { SEpiRes E{jj == 0 ? KIN(const float, 1) - (size_t)TP * D : nullptr, WSP(bf16, WS_XB0), WSP(bf16, WS_XB1), WSP(float, WS_SS1)};
              small_gemm(C, WSP(bf16, WS_Y), WSP(bf16, WS_WOUTA + jj * SZ_WOUTA), D, AW, E); }
            { pg8::Gemm g{WSP(bf16, WS_PB + ia * SZ_PB), WSP(bf16, WS_WPE + ia * SZ_WPE), TP, D, PD}; pg8::StaticOrder S; S.init(TP, D, C.G, C.bid);
              EpiBf16S E{WSP(bf16, WS_PE), D}; pg8::gemm_phase<EpiBf16S, pg8::StaticOrder, true, true>(ring, g, S, E); }
            { SEpiBf16 E{WSP(bf16, WS_PE), D}; small_gemm(C, WSP(bf16, WS_PB + ia * SZ_PB), WSP(bf16, WS_WPE + ia * SZ_WPE), D, PD, E); } });
        SEAM(pb + 2);
        RUN(pb + 3, { { pg8::Gemm g{WSP(bf16, WS_XB1), WSP(bf16, WS_WGATE + ia * SZ_WSQ), TP, D, D}; pg8::StaticOrder S; S.init(TP, D, C.G, C.bid);
            EpiGate E{WSP(float, WS_SS1), WSP(bf16, WS_XB1), WSP(bf16, WS_PE), nullptr, WSP(bf16, WS_XB0), WSP(float, WS_SSX)}; pg8::gemm_phase<EpiGate, pg8::StaticOrder, true, true>(ring, g, S, E); }
            { SEpiGate E{WSP(float, WS_SS1), WSP(bf16, WS_XB1), WSP(bf16, WS_PE), nullptr, WSP(bf16, WS_XB0), WSP(float, WS_SSX)}; small_gemm(C, WSP(bf16, WS_XB1), WSP(bf16, WS_WGATE + ia * SZ_WSQ), D, D, E); } });
        SEAM(pb + 3);
        RUN(pb + 4, { pg8::Gemm g{WSP(bf16, WS_XB0), WSP(bf16, WS_WINB + jj * SZ_WINB), T, NB_IN, D}; pg8::StaticOrder S; S.init(T, NB_IN, C.G, C.bid);
            EpiB1 E{C.ws, KIN(const float, 15) + jj * HD, KIN(const float, 16) + jj * HD, KIN(const float, 17) + jj * IDXD, C.out, jj, (LAS float*)(C.lds + 131072)};
            pg8::gemm_phase<EpiB1, pg8::StaticOrder, true, true>(ring, g, S, E);
            if (jj == 0 && C.G == 256 && C.bid >= 116) prologue_part(C, 2, true, (C.bid - 116) * 8 + C.wave, 140 * 8); });
#ifdef PROBE_PLAIN_B1
        if (IN(pb + 4)) { xcd_barrier(bar); pg8::Gemm g{WSP(bf16, WS_XB0), WSP(bf16, WS_WINB + jj * SZ_WINB), T, NB_IN, D}; pg8::StaticOrder S; S.init(T, NB_IN, C.G, C.bid);
            EpiBf16S E{WSP(bf16, WS_RAW), NB_IN}; pg8::gemm_phase<EpiBf16S, pg8::StaticOrder, true, true>(ring, g, S, E); }
#endif
        SEAM(pb + 4);
        RUN(pb + 5, idx_phase(C, jj));
        SEAM(pb + 5);
        RUN(pb + 6, attn_phase(C, jj));
        SEAM(pb + 6);
        RUN(pb + 7, {
            { pg8::Gemm g{WSP(bf16, WS_AO), WSP(bf16, WS_WOUTB + jj * SZ_WSQ), TP, D, D}; pg8::StaticOrder S; S.init(TP, D, C.G, C.bid);
              EpiRes<false> E{nullptr, WSP(bf16, WS_XB0), WSP(bf16, WS_XB1), WSP(float, WS_SS1)};
              pg8::gemm_phase<EpiRes<false>, pg8::StaticOrder, true, true>(ring, g, S, E); }
            { SEpiRes E{nullptr, WSP(bf16, WS_XB0), WSP(bf16, WS_XB1), WSP(float, WS_SS1)}; small_gemm(C, WSP(bf16, WS_AO), WSP(bf16, WS_WOUTB + jj * SZ_WSQ), D, D, E); }
            { pg8::Gemm g{WSP(bf16, WS_PB + ib * SZ_PB), WSP(bf16, WS_WPE + ib * SZ_WPE), TP, D, PD}; pg8::StaticOrder S; S.init(TP, D, C.G, C.bid);
              EpiBf16S E{WSP(bf16, WS_PE), D}; pg8::gemm_phase<EpiBf16S, pg8::StaticOrder, true, true>(ring, g, S, E); }
            { SEpiBf16 E{WSP(bf16, WS_PE), D}; small_gemm(C, WSP(bf16, WS_PB + ib * SZ_PB), WSP(bf16, WS_WPE + ib * SZ_WPE), D, PD, E); } });
        SEAM(pb + 7);
        RUN(pb + 8, { { pg8::Gemm g{WSP(bf16, WS_XB1), WSP(bf16, WS_WGATE + ib * SZ_WSQ), TP, D, D}; pg8::StaticOrder S; S.init(TP, D, C.G, C.bid);
            EpiGate E{WSP(float, WS_SS1), WSP(bf16, WS_XB1), WSP(bf16, WS_PE), jj == 1 ? C.out + O_Y : nullptr, WSP(bf16, WS_XB0), WSP(float, WS_SSX)}; pg8::gemm_phase<EpiGate, pg8::StaticOrder, true, true>(ring, g, S, E); }
            { SEpiGate E{WSP(float, WS_SS1), WSP(bf16, WS_XB1), WSP(bf16, WS_PE), jj == 1 ? C.out + O_Y : nullptr, WSP(bf16, WS_XB0), WSP(float, WS_SSX)}; small_gemm(C, WSP(bf16, WS_XB1), WSP(bf16, WS_WGATE + ib * SZ_WSQ), D, D, E); } });
        SEAM(pb + 8);
    }
constexpr int N_PHASES = 19;
__global__ void __launch_bounds__(512, 2) fwd(Args args) {
    extern __shared__ __attribute__((aligned(16))) unsigned char lds_raw[];
    Ctx C; C.lds = (LAS unsigned char*)lds_raw; C.tid = threadIdx.x; C.lane = C.tid & 63; C.wave = __builtin_amdgcn_readfirstlane(C.tid >> 6); C.G = gridDim.x; C.bid = blockIdx.x;
    C.out = args.out; C.ws = args.ws;
    volatile LAS unsigned* MISC = (volatile LAS unsigned*)(C.lds + MISC_OFF);
    if (C.tid < 64) MISC[C.tid] = 0u;
    __syncthreads();
    const int lo = args.ph_lo, hi = args.ph_hi;
    XcdBarrier bar; bar.bar = (unsigned*)(C.ws + WS_CTL) + CW_BAR; bar.x = 0; bar.st = nullptr;
    if (hi - lo > 1) bar = xcd_barrier_post((unsigned*)(C.ws + WS_CTL) + CW_BAR, MISC + 8);
    LAS unsigned char* ring = C.lds;
    RUN(0, prologue_part(C, 0, C.G == 256, C.bid * 8 + C.wave, C.G * 8));
    SEAM(0);
    layer_pair<0>(C, bar, lo, hi);
    layer_pair<1>(C, bar, lo, hi);
#undef IN
#undef SEAM
}

#ifndef MK_FUSED
#define MK_FUSED 1
#endif
extern "C" void kernel_launch(void* const* d_in, const int* in_sizes, int n_in, void* d_out, int out_size, void* d_ws, size_t ws_size, hipStream_t stream) {
    static int grid = 0;
    if (grid == 0) {
        if (n_in != 22 || out_size != (int)O_END || ws_size < WS_END) { fprintf(stderr, "kernel_launch: shape mismatch n_in %d out %d ws %zu (need %zu)\n", n_in, out_size, ws_size, (size_t)WS_END); grid = -1; return; }
        int dev = 0, cus = 0, per_cu = 0;
        if (hipGetDevice(&dev) != hipSuccess || hipDeviceGetAttribute(&cus, hipDeviceAttributeMultiprocessorCount, dev) != hipSuccess) { grid = -1; return; }
        if (hipFuncSetAttribute((const void*)fwd, hipFuncAttributeMaxDynamicSharedMemorySize, LDS_BYTES) != hipSuccess) { fprintf(stderr, "kernel_launch: hipFuncSetAttribute failed\n"); grid = -1; return; }
        if (hipOccupancyMaxActiveBlocksPerMultiprocessor(&per_cu, (const void*)fwd, 512, LDS_BYTES) != hipSuccess || per_cu < 1) fprintf(stderr, "kernel_launch: occupancy query says %d\n", per_cu);
        (void)hipGetLastError();
        grid = cus;
    }
    if (grid < 0) return;
    if (hipMemsetAsync((char*)d_ws + WS_CTL, 0, CTL_BYTES, stream) != hipSuccess) return;
    Args a{};
    for (int i = 0; i < 22; ++i) a.in[i] = d_in[i];
    a.out = (float*)d_out; a.ws = (unsigned char*)d_ws;
#if MK_FUSED
    a.ph_lo = 0; a.ph_hi = N_PHASES;
    hipLaunchKernelGGL(fwd, dim3(grid), dim3(512), LDS_BYTES, stream, a);
#else
    for (int p = 0; p < N_PHASES; ++p) { a.ph_lo = p; a.ph_hi = p + 1; hipLaunchKernelGGL(fwd, dim3(grid), dim3(512), LDS_BYTES, stream, a); }
#endif
    const hipError_t le = hipPeekAtLastError();
    if (le != hipSuccess) fprintf(stderr, "kernel_launch: launch failed: %s\n", hipGetErrorName(le));
}
```

```cpp
#include <hip/hip_runtime.h>
#include <cstdio>
#include <cstdint>
namespace pg8 {
#define PG8_LAS __attribute__((address_space(3)))
typedef unsigned short bf16_t;
typedef short bf16x8 __attribute__((ext_vector_type(8)));
typedef float f32x4 __attribute__((ext_vector_type(4)));
typedef unsigned u32x4 __attribute__((ext_vector_type(4)));
constexpr int BM = 256, BK = 64, HALF = 128, HTB = HALF * BK * 2  , STAGE_BYTES = 8 * HTB, NXCD = 8, WGM = 4;

__host__ __device__ __forceinline__ int lds_byte(int r, int c) { const int st = (r >> 4) * 2 + (c >> 5), rr = r & 15, cc = c & 31, ob = rr * 64 + cc * 2; return st * 1024 + (ob ^ (((ob >> 9) & 1) << 5)); }
__host__ __device__ __forceinline__ void stage_rc(int b, int& R, int& C) { const int st = b / 1024, sb = b % 1024, swz = sb ^ (((sb >> 9) & 1) << 5); R = (st >> 1) * 16 + swz / 64; C = (st & 1) * 32 + (swz % 64) / 2; }
__host__ __device__ __forceinline__ int perm32(int rho) { const int n = rho >> 4, i = rho & 15; return 8 * (i >> 2) + 4 * n + (i & 3); }

struct Unit { int pm, pn; };
struct Gemm { const bf16_t* A; const bf16_t* Bt; int M, N, K; };

struct StaticOrder {
    int nM, nN, nwg, G, c;
    __host__ __device__ void init(int M, int N, int G_, int c_) { nM = M / BM; nN = N / BM; nwg = nM * nN; G = G_; c = c_; }
    __host__ __device__ bool next(int i, Unit& u) const {
        const long L = (long)i * G + c; if (L >= nwg) return false;
        int wgid = (int)L; { const int q = nwg / NXCD, r = nwg % NXCD, xcd = wgid % NXCD, off = wgid / NXCD; wgid = (xcd < r ? xcd * (q + 1) : r * (q + 1) + (xcd - r) * q) + off; }
        const int nig = WGM * nN, gid = wgid / nig, fm = gid * WGM, gsz = (nM - fm) < WGM ? (nM - fm) : WGM;
        u.pm = fm + ((wgid % nig) % gsz); u.pn = (wgid % nig) / gsz; return true;
    }
    __device__ __forceinline__ void a_ready(const Unit&) const {}
    __device__ __forceinline__ void done(const Unit&) const {}
};
__device__ __forceinline__ unsigned cvt_pk_bf16(float lo, float hi) { unsigned r; asm volatile("v_cvt_pk_bf16_f32 %0, %1, %2" : "=v"(r) : "v"(lo), "v"(hi)); return r; }
typedef float f32x2 __attribute__((ext_vector_type(2)));
template <class Epi, class Sched, bool ALIGN_EPI = false, bool SP2 = false>
__device__ __forceinline__ void gemm_phase(PG8_LAS unsigned char* lds, const Gemm g, const Sched& S, const Epi& E) {
    const int tid = threadIdx.x, wid = __builtin_amdgcn_readfirstlane(tid >> 6), lane = tid & 63, wr = wid >> 2, wc = wid & 3, fr = lane & 15, fq = lane >> 4;
    const int K = g.K, nt = K / BK;
    unsigned voffA[2], voffB[2];
#pragma unroll
    for (int i = 0; i < 2; ++i) { int R, C; stage_rc(tid * 16 + i * 8192, R, C); const int Rb = Epi::PERM ? ((R & ~31) + perm32(R & 31)) : R;
        voffA[i] = (unsigned)(R * K + C) * 2u; voffB[i] = (unsigned)(Rb * K + C) * 2u; }
    const size_t kstep = (size_t)(BK * 2);
    const size_t hstep = (size_t)HALF * K * 2;
    const size_t tstep = 2 * hstep;
    const unsigned ldsw = (unsigned)wid * 1024u;
    const int aoff = lds_byte(wr * 64 + fr, fq * 8), boff = lds_byte(wc * 32 + fr, fq * 8);
#define PG8_SA(b, h) (((b) * 2 + (h)) * HTB)
#define PG8_SB(b, h) ((4 + (b) * 2 + (h)) * HTB)
#define PG8_STAGE(bufoff, gbase, voff) do { _Pragma("unroll") for (int _i = 0; _i < 2; ++_i) \
        __builtin_amdgcn_global_load_lds((const unsigned*)((const char*)(gbase) + (voff)[_i]), (PG8_LAS unsigned*)(lds + (bufoff) + ldsw + _i * 8192), 16, 0, 0); } while (0)
#define PG8_LDA(dst, b, h) do { _Pragma("unroll") for (int m = 0; m < 4; ++m) _Pragma("unroll") for (int k = 0; k < 2; ++k) dst[m][k] = *(const PG8_LAS bf16x8*)(lds + PG8_SA(b, h) + aoff + m * 2048 + k * 1024); } while (0)
#define PG8_LDB(dst, b, h) do { _Pragma("unroll") for (int n = 0; n < 2; ++n) _Pragma("unroll") for (int k = 0; k < 2; ++k) dst[n][k] = *(const PG8_LAS bf16x8*)(lds + PG8_SB(b, h) + boff + n * 2048 + k * 1024); } while (0)
#define PG8_MMA(ai, bj, At, Bt) do { __builtin_amdgcn_s_setprio(1); _Pragma("unroll") for (int m = 0; m < 4; ++m) _Pragma("unroll") for (int n = 0; n < 2; ++n) _Pragma("unroll") for (int k = 0; k < 2; ++k) \
        acc[ai][bj][m][n] = __builtin_amdgcn_mfma_f32_16x16x32_bf16(Bt[n][k], At[m][k], acc[ai][bj][m][n], 0, 0, 0); __builtin_amdgcn_s_setprio(0); } while (0)
#define PG8_WAIT_V(n) asm volatile("s_waitcnt vmcnt(" #n ")" ::: "memory")
#define PG8_WAIT_L(n) asm volatile("s_waitcnt lgkmcnt(" #n ")" ::: "memory")
#define PG8_BAR __builtin_amdgcn_s_barrier()
#define PG8_SCHED __builtin_amdgcn_sched_barrier(0)
    Unit cur, nxt; int ui = 0;
    if (!S.next(0, cur)) return;
    f32x4 acc[2][2][4][2];
#pragma unroll
    for (int a = 0; a < 2; ++a)
#pragma unroll
        for (int b = 0; b < 2; ++b)
#pragma unroll
            for (int m = 0; m < 4; ++m)
#pragma unroll
                for (int n = 0; n < 2; ++n) acc[a][b][m][n] = (f32x4){0.f, 0.f, 0.f, 0.f};
    bf16x8 At[4][2], B0[2][2], B1[2][2];
    const char* cA = (const char*)g.A + (size_t)cur.pm * tstep; const char* cB = (const char*)g.Bt + (size_t)cur.pn * tstep;
    S.a_ready(cur);
    if constexpr (SP2) {
        PG8_STAGE(PG8_SB(0, 0), cB, voffB); PG8_STAGE(PG8_SB(0, 1), cB + hstep, voffB); PG8_STAGE(PG8_SA(0, 0), cA, voffA); PG8_STAGE(PG8_SA(0, 1), cA + hstep, voffA);
        if (wr == 1) PG8_BAR;
        PG8_WAIT_V(2); PG8_BAR;
        PG8_STAGE(PG8_SB(1, 0), cB + kstep, voffB); PG8_STAGE(PG8_SA(1, 0), cA + kstep, voffA); PG8_STAGE(PG8_SB(1, 1), cB + hstep + kstep, voffB);
        PG8_WAIT_V(6); PG8_BAR;
    } else {
        PG8_STAGE(PG8_SB(0, 0), cB, voffB); PG8_STAGE(PG8_SA(0, 0), cA, voffA); PG8_STAGE(PG8_SB(0, 1), cB + hstep, voffB); PG8_STAGE(PG8_SA(0, 1), cA + hstep, voffA);
        if (wr == 1) PG8_BAR;
        PG8_WAIT_V(4); PG8_BAR;
        PG8_STAGE(PG8_SB(1, 0), cB + kstep, voffB); PG8_STAGE(PG8_SA(1, 0), cA + kstep, voffA); PG8_STAGE(PG8_SB(1, 1), cB + hstep + kstep, voffB);
        PG8_WAIT_V(6); PG8_BAR;
    }
    for (;;) {
        const bool has_next = S.next(ui + 1, nxt);
        const char* nA = has_next ? (const char*)g.A + (size_t)nxt.pm * tstep : cA; const char* nB = has_next ? (const char*)g.Bt + (size_t)nxt.pn * tstep : cB;
#pragma clang loop unroll(disable)
        for (int t = 0; t < nt; t += 2) {
            const bool last = (t == nt - 2);
            const char* a1 = cA + (size_t)(t + 1) * kstep;
            const char* a2 = last ? nA : cA + (size_t)(t + 2) * kstep; const char* b2 = last ? nB : cB + (size_t)(t + 2) * kstep;
            const char* a3 = a2 + kstep; const char* b3 = b2 + kstep;
            if (last && has_next) S.a_ready(nxt);
            if constexpr (SP2) {
            PG8_LDB(B0, 0, 0); PG8_LDB(B1, 0, 1); PG8_SCHED; PG8_LDA(At, 0, 0); PG8_STAGE(PG8_SA(1, 1), a1 + hstep, voffA);
            PG8_WAIT_V(8); PG8_WAIT_L(0); PG8_BAR; PG8_MMA(0, 0, At, B0); PG8_MMA(0, 1, At, B1); PG8_BAR; PG8_SCHED;
            PG8_LDA(At, 0, 1); PG8_STAGE(PG8_SB(0, 0), b2, voffB); PG8_STAGE(PG8_SB(0, 1), b2 + hstep, voffB); PG8_STAGE(PG8_SA(0, 0), a2, voffA);
            PG8_WAIT_V(8); PG8_WAIT_L(0); PG8_BAR; PG8_MMA(1, 0, At, B0); PG8_MMA(1, 1, At, B1); PG8_BAR; PG8_SCHED;
            PG8_LDB(B0, 1, 0); PG8_LDB(B1, 1, 1); PG8_SCHED; PG8_LDA(At, 1, 0); PG8_STAGE(PG8_SA(0, 1), a2 + hstep, voffA);
            PG8_WAIT_V(8); PG8_WAIT_L(0); PG8_BAR; PG8_MMA(0, 0, At, B0); PG8_MMA(0, 1, At, B1); PG8_BAR; PG8_SCHED;
            PG8_LDA(At, 1, 1); PG8_STAGE(PG8_SB(1, 0), b3, voffB); PG8_STAGE(PG8_SB(1, 1), b3 + hstep, voffB); PG8_STAGE(PG8_SA(1, 0), a3, voffA);
            PG8_WAIT_V(8); PG8_WAIT_L(0); PG8_BAR; PG8_MMA(1, 0, At, B0); PG8_MMA(1, 1, At, B1); PG8_BAR; PG8_SCHED;
            } else {
            PG8_LDB(B0, 0, 0); PG8_SCHED; PG8_LDA(At, 0, 0); PG8_STAGE(PG8_SA(1, 1), a1 + hstep, voffA);
            PG8_WAIT_L(8); PG8_BAR; PG8_WAIT_L(0); PG8_MMA(0, 0, At, B0); PG8_BAR; PG8_SCHED;
            PG8_LDB(B1, 0, 1); PG8_STAGE(PG8_SB(0, 0), b2, voffB);
            PG8_BAR; PG8_WAIT_L(0); PG8_MMA(0, 1, At, B1); PG8_BAR;
            PG8_LDA(At, 0, 1); PG8_STAGE(PG8_SA(0, 0), a2, voffA);
            PG8_BAR; PG8_WAIT_L(0); PG8_MMA(1, 0, At, B0); PG8_BAR; PG8_SCHED;
            PG8_STAGE(PG8_SB(0, 1), b2 + hstep, voffB);
            PG8_WAIT_V(6); PG8_BAR; PG8_MMA(1, 1, At, B1); PG8_BAR;
            PG8_LDB(B0, 1, 0); PG8_SCHED; PG8_LDA(At, 1, 0); PG8_STAGE(PG8_SA(0, 1), a2 + hstep, voffA);
            PG8_WAIT_L(8); PG8_BAR; PG8_WAIT_L(0); PG8_MMA(0, 0, At, B0); PG8_BAR; PG8_SCHED;
            PG8_LDB(B1, 1, 1); PG8_STAGE(PG8_SB(1, 0), b3, voffB);
            PG8_BAR; PG8_WAIT_L(0); PG8_MMA(0, 1, At, B1); PG8_BAR;
            PG8_LDA(At, 1, 1); PG8_STAGE(PG8_SA(1, 0), a3, voffA);
            PG8_BAR; PG8_WAIT_L(0); PG8_MMA(1, 0, At, B0); PG8_BAR; PG8_SCHED;
            PG8_STAGE(PG8_SB(1, 1), b3 + hstep, voffB);
            PG8_WAIT_V(6); PG8_BAR; PG8_MMA(1, 1, At, B1); PG8_BAR;
            }
        }
        if constexpr (ALIGN_EPI) { if (wr == 0) PG8_BAR; }
        if constexpr (!Epi::AFTER_DRAIN) { E(acc, cur, wr, wc, fr, fq); S.done(cur); }
        if (!has_next) break;
#pragma unroll
        for (int a = 0; a < 2; ++a)
#pragma unroll
            for (int b = 0; b < 2; ++b)
#pragma unroll
                for (int m = 0; m < 4; ++m)
#pragma unroll
                    for (int n = 0; n < 2; ++n) acc[a][b][m][n] = (f32x4){0.f, 0.f, 0.f, 0.f};
        cur = nxt; cA = nA; cB = nB; ++ui;
        if constexpr (ALIGN_EPI) { if (wr == 1) PG8_BAR; }
    }
    PG8_WAIT_V(0);
    if constexpr (!ALIGN_EPI) { if (wr == 0) PG8_BAR; }
    PG8_BAR;
    if constexpr (Epi::AFTER_DRAIN) { E.fused(acc, cur, wr, wc, fr, fq, lds, wid, lane); S.done(cur); }
#undef PG8_SA
#undef PG8_SB
#undef PG8_STAGE
#undef PG8_LDA
#undef PG8_LDB
#undef PG8_MMA
#undef PG8_WAIT_V
#undef PG8_WAIT_L
#undef PG8_BAR
#undef PG8_SCHED
}
}
#define GAS __attribute__((address_space(1)))
#define LAS __attribute__((address_space(3)))
typedef unsigned short bf16;
typedef unsigned v4u __attribute__((ext_vector_type(4)));
typedef float f32x4 __attribute__((ext_vector_type(4)));
typedef short bf16x8 __attribute__((ext_vector_type(8)));
typedef GAS unsigned gu32;
typedef GAS unsigned long long gu64;
#define RLX_AGENT __ATOMIC_RELAXED, __HIP_MEMORY_SCOPE_AGENT
#define LDS_WAIT() asm volatile("s_waitcnt lgkmcnt(0)" ::: "memory")
#define VM_WAIT() asm volatile("s_waitcnt vmcnt(0)" ::: "memory")
__device__ __forceinline__ unsigned long long rt() { return __builtin_amdgcn_s_memrealtime(); }
__device__ __forceinline__ unsigned f2bf(float f) { unsigned u = __builtin_bit_cast(unsigned, f); return (u + 0x7fffu + ((u >> 16) & 1u)) >> 16; }
__device__ __forceinline__ unsigned pk2(float lo, float hi) { return f2bf(lo) | (f2bf(hi) << 16); }

#define XB_TMO      128
#define XB_XCNT(j)  (256  + 64 * (j))
#define XB_XSUB(j)  (1280 + 64 * (j))
#define XB_XGEN(j)  (2304 + 64 * (j))
#define XB_TOP      3328
#define XB_TOPGEN   3392
#define XCD_BAR_WORDS 3456
#define XB_SPIN_CAP (1u << 18)

__device__ __forceinline__ unsigned xb_ld(unsigned* p)              { return __hip_atomic_load(p, __ATOMIC_RELAXED, __HIP_MEMORY_SCOPE_AGENT); }
__device__ __forceinline__ unsigned xb_add(unsigned* p, unsigned v) { return __hip_atomic_fetch_add(p, v, __ATOMIC_RELAXED, __HIP_MEMORY_SCOPE_AGENT); }
__device__ __forceinline__ unsigned xb_xcc_id() { return (unsigned)__builtin_amdgcn_s_getreg((3 << 11) | 20) & 0xFu; }
#define XB_SPIN(cond, bar) do { unsigned _sp = 0; while (cond) { __builtin_amdgcn_s_sleep(1); \
    if ((++_sp & 255u) == 0u) { if (xb_ld(&(bar)[XB_TMO])) break; if (_sp > XB_SPIN_CAP) { atomicAdd(&(bar)[XB_TMO], 1u); break; } } } } while (0)

struct XcdBarrier {
    unsigned* bar; unsigned x;
    volatile LAS unsigned* st;
};

__device__ __forceinline__ XcdBarrier xcd_barrier_post(unsigned* bar, volatile LAS unsigned* st) {
    XcdBarrier b; b.bar = bar; b.x = xb_xcc_id(); b.st = st;
    if (threadIdx.x == 0) (void)xb_add(&bar[XB_XCNT(b.x)], 1u);
    return b;
}
__device__ __forceinline__ void xcd_barrier_complete(unsigned* bar, unsigned x, unsigned& nloc, unsigned& nx) {
    const unsigned G = gridDim.x * gridDim.y * gridDim.z;
    unsigned sum, cnt, mine, sp = 0u;
    for (;;) {
        sum = 0u; cnt = 0u; mine = 0u;
#pragma unroll
        for (unsigned j = 0; j < 16; ++j) { const unsigned c = xb_ld(&bar[XB_XCNT(j)]); sum += c; cnt += (c > 0u) ? 1u : 0u; mine = (j == x) ? c : mine; }
        if (sum == G) break;
        __builtin_amdgcn_s_sleep(1);
        if ((++sp & 255u) == 0u) { if (xb_ld(&bar[XB_TMO])) break; if (sp > XB_SPIN_CAP) { atomicAdd(&bar[XB_TMO], 1u); break; } }
    }
    nloc = mine > 0u ? mine : 1u; nx = cnt > 0u ? cnt : 1u;
}

__device__ __forceinline__ void xcd_barrier(const XcdBarrier& b) {
    asm volatile("s_waitcnt vmcnt(0)" ::: "memory");
    __syncthreads();
    if (threadIdx.x == 0) {
        unsigned* bar = b.bar;
        __builtin_amdgcn_s_waitcnt(0);
        unsigned nloc = b.st[0], nx = b.st[1];
        if (nloc == 0u) { xcd_barrier_complete(bar, b.x, nloc, nx); b.st[0] = nloc; b.st[1] = nx; }
        const unsigned old = xb_add(&bar[XB_XSUB(b.x)], 1u);
        const unsigned gen = old / nloc;
        if (old + 1u == (gen + 1u) * nloc) {
            __builtin_amdgcn_fence(__ATOMIC_RELEASE, "agent");
            asm volatile("s_waitcnt vmcnt(0)" ::: "memory");
            const unsigned og = xb_add(&bar[XB_TOP], 1u);
            const unsigned tg = og / nx;
            if (og + 1u == (tg + 1u) * nx) xb_add(&bar[XB_TOPGEN], 1u);
            else XB_SPIN(xb_ld(&bar[XB_TOPGEN]) == tg, bar);
            __builtin_amdgcn_fence(__ATOMIC_ACQUIRE, "agent");
            xb_add(&bar[XB_XGEN(b.x)], 1u);
            asm volatile("s_waitcnt vmcnt(0)" ::: "memory");
        } else {
            XB_SPIN(xb_ld(&bar[XB_XGEN(b.x)]) == gen, bar);
            __builtin_amdgcn_fence(__ATOMIC_ACQUIRE, "agent");
            asm volatile("s_waitcnt vmcnt(0)" ::: "memory");
        }
    }
    __syncthreads();
}

constexpr int D = 1024, TP = 16384, TS = 1024, T = TP + TS, SEQ = 2048, NBATCH = 8, DBATCH = 128, DSEQ = 8;
constexpr int AW = 2048, NA_IN = 6144, NB_IN = 3328, NB_SRC = 3144, PD = 256, NPAGES = 16, PAGE = 128;
constexpr int HD = 128, NH = 8, NKV = 2, KVW = 256, IDXH = 8, IDXD = 64, TOPK = 256;
constexpr int NPOS = SEQ + DSEQ;
constexpr int MASKW = 34;
constexpr float EPS = 1e-6f;
constexpr size_t O_Y = 0, O_KP = (size_t)T * D, O_VP = O_KP + (size_t)NBATCH * 2 * SEQ * KVW, O_IKP = O_VP + (size_t)NBATCH * 2 * SEQ * KVW,
                 O_KS = O_IKP + (size_t)NBATCH * 2 * SEQ * IDXD, O_VS = O_KS + (size_t)DBATCH * 2 * DSEQ * KVW, O_IKS = O_VS + (size_t)DBATCH * 2 * DSEQ * KVW,
                 O_CV = O_IKS + (size_t)DBATCH * 2 * DSEQ * IDXD, O_END = O_CV + (size_t)DBATCH * 2 * DSEQ * AW;
static_assert(O_END == 42074112, "output size");
constexpr size_t al256(size_t x) { return (x + 255) & ~(size_t)255; }
constexpr size_t WS_CTL = 0, CTL_BYTES = 1u << 20;
constexpr size_t SZ_WINA = (size_t)NA_IN * D * 2, SZ_WOUTA = (size_t)D * AW * 2, SZ_WINB = (size_t)NB_IN * D * 2, SZ_WSQ = (size_t)D * D * 2, SZ_WPE = (size_t)D * PD * 2;
constexpr size_t WS_WINA = CTL_BYTES, WS_WOUTA = WS_WINA + 2 * SZ_WINA, WS_WINB = WS_WOUTA + 2 * SZ_WOUTA, WS_WOUTB = WS_WINB + 2 * SZ_WINB,
                 WS_WGATE = WS_WOUTB + 2 * SZ_WSQ, WS_WPE = WS_WGATE + 4 * SZ_WSQ, WS_ROPE = WS_WPE + 4 * SZ_WPE;
constexpr size_t SZ_ROPE = al256((size_t)NPOS * 64 * 8), SZ_PB = (size_t)T * PD * 2, SZ_XB = (size_t)T * D * 2, SZ_XF = (size_t)T * D * 4, SZ_SS = (size_t)T * 16 * 4;
constexpr size_t WS_PB = WS_ROPE + SZ_ROPE, WS_XB0 = WS_PB + 4 * SZ_PB, WS_XB1 = WS_XB0 + SZ_XB, WS_XF0 = WS_XB1 + SZ_XB, WS_XF1 = WS_XF0 + SZ_XF,
                 WS_SSX = WS_XF1 + SZ_XF, WS_SS1 = WS_SSX + SZ_SS, WS_UZ = WS_SS1 + SZ_SS;
constexpr size_t SZ_AW = (size_t)T * AW * 2;
constexpr size_t WS_VR = WS_UZ + SZ_AW, WS_Y = WS_VR + SZ_AW, WS_VSS = WS_Y + SZ_AW, WS_PE = WS_VSS + (size_t)T * 32 * 4, WS_RAW = WS_PE + SZ_XB;
constexpr size_t WS_Q = WS_RAW + (size_t)T * NB_IN * 2, WS_KB = WS_Q + SZ_XB, WS_VB = WS_KB + (size_t)T * KVW * 2, WS_IQ = WS_VB + (size_t)T * KVW * 2,
                 WS_IK = WS_IQ + (size_t)T * 512 * 2, WS_IW = WS_IK + (size_t)T * 64 * 2, WS_SZ = WS_IW + (size_t)T * 8 * 4, WS_AO = WS_SZ + SZ_XB,
                 WS_MASK = WS_AO + SZ_XB, WS_QSS = WS_MASK + (size_t)T * MASKW * 8, WS_ROPE32 = WS_QSS + (size_t)T * NH * 4 * 4, WS_END = WS_ROPE32 + al256((size_t)NPOS * 32 * 8);
constexpr int SCR_BYTES = 153600, MISC_OFF = SCR_BYTES, LDS_BYTES = SCR_BYTES + 256;
constexpr int CW_BAR = 4096, CW_QUEUE = 16384;

typedef short s16x4 __attribute__((ext_vector_type(4)));
typedef float f32x16 __attribute__((ext_vector_type(16)));
typedef float f32x2v __attribute__((ext_vector_type(2)));
typedef unsigned u32x2v __attribute__((ext_vector_type(2)));
typedef unsigned long long u64;

__device__ __forceinline__ float bf2f(unsigned short b) { return __builtin_bit_cast(float, (unsigned)b << 16); }
__device__ __forceinline__ float bflo(unsigned w) { return __builtin_bit_cast(float, w << 16); }
__device__ __forceinline__ float bfhi(unsigned w) { return __builtin_bit_cast(float, w & 0xffff0000u); }
__device__ __forceinline__ unsigned cvtpk(float lo, float hi) { return pg8::cvt_pk_bf16(lo, hi); }
__device__ __forceinline__ float wave_sum(float v) {
#pragma unroll
    for (int o = 1; o < 64; o <<= 1) v += __shfl_xor(v, o);
    return v;
}
__device__ __forceinline__ float wave_max(float v) {
#pragma unroll
    for (int o = 1; o < 64; o <<= 1) v = fmaxf(v, __shfl_xor(v, o));
    return v;
}
__device__ __forceinline__ float rsq(float x) { return __builtin_amdgcn_rsqf(x); }
__device__ __forceinline__ float sigm(float x) { return __builtin_amdgcn_rcpf(1.0f + __builtin_amdgcn_exp2f(x * -1.4426950408889634f)); }
__device__ __forceinline__ float row_r16(const float* ss, int row, float inv_n) {
    const f32x4* p = (const f32x4*)(ss + (size_t)row * 16); const f32x4 a = p[0], b = p[1], c = p[2], d = p[3];
    const float s = (((a.x + a.y) + (a.z + a.w)) + ((b.x + b.y) + (b.z + b.w))) + (((c.x + c.y) + (c.z + c.w)) + ((d.x + d.y) + (d.z + d.w)));
    return rsq(s * inv_n + EPS);
}

__device__ __forceinline__ void rows_r8(const float* ss, int row0, int fq, float inv_n, float (&rr)[8]) {
    f32x4 v[8];
#pragma unroll
    for (int k = 0; k < 8; ++k) v[k] = *(const f32x4*)(ss + (size_t)(row0 + (k >> 2) * 128 + (k & 3) * 16) * 16 + 4 * fq);
#pragma unroll
    for (int k = 0; k < 8; ++k) { float t = (v[k].x + v[k].y) + (v[k].z + v[k].w); t += __shfl_xor(t, 16); t += __shfl_xor(t, 32); rr[k] = rsq(t * inv_n + EPS); }
}

struct EpiA1 {
    static constexpr bool PERM = true, AFTER_DRAIN = false;
    const float* ssx; bf16* UZ; bf16* V; float* vss;
    __device__ __forceinline__ void operator()(const f32x4 (&acc)[2][2][4][2], const pg8::Unit& u, int wr, int wc, int fr, int fq) const {
        const int row0 = u.pm * 256 + wr * 64 + fr; float rr[8]; rows_r8(ssx, row0, fq, 1.0f / D, rr);
#pragma unroll
        for (int ai = 0; ai < 2; ++ai)
#pragma unroll
            for (int m = 0; m < 4; ++m) {
                const int row = row0 + ai * 128 + m * 16; const float r = rr[ai * 4 + m];
                if (u.pn < 16) {
                    float o[8];
#pragma unroll
                    for (int n = 0; n < 2; ++n)
#pragma unroll
                        for (int j = 0; j < 4; ++j) { const float uu = acc[ai][0][m][n][j] * r, zz = acc[ai][1][m][n][j] * r; o[n * 4 + j] = uu * zz * sigm(zz); }
                    v4u w; w.x = cvtpk(o[0], o[1]); w.y = cvtpk(o[2], o[3]); w.z = cvtpk(o[4], o[5]); w.w = cvtpk(o[6], o[7]);
                    *(v4u*)(UZ + (size_t)row * AW + u.pn * 128 + wc * 32 + 8 * fq) = w;
                } else {
                    float q = 0.f;
#pragma unroll
                    for (int bj = 0; bj < 2; ++bj) { const f32x4 a = acc[ai][bj][m][0] * r, b = acc[ai][bj][m][1] * r;
                        q += (a.x * a.x + a.y * a.y) + (a.z * a.z + a.w * a.w) + (b.x * b.x + b.y * b.y) + (b.z * b.z + b.w * b.w);
                        v4u w; w.x = cvtpk(a.x, a.y); w.y = cvtpk(a.z, a.w); w.z = cvtpk(b.x, b.y); w.w = cvtpk(b.z, b.w);
                        *(v4u*)(V + (size_t)row * AW + (u.pn - 16) * 256 + bj * 128 + wc * 32 + 8 * fq) = w; }
                    q += __shfl_xor(q, 16); q += __shfl_xor(q, 32);
                    if (fq == 0) vss[(size_t)row * 32 + (u.pn - 16) * 4 + wc] = q;
                }
            }
    }
};
struct EpiBf16S {
    static constexpr bool PERM = true, AFTER_DRAIN = false;
    bf16* O; int ldc;
    __device__ __forceinline__ void operator()(const f32x4 (&acc)[2][2][4][2], const pg8::Unit& u, int wr, int wc, int fr, int fq) const {
        bf16* base = O + (size_t)(u.pm * 256 + wr * 64) * ldc + u.pn * 256 + wc * 32; const unsigned lo = (unsigned)fr * (unsigned)ldc + 8u * fq;
#pragma unroll
        for (int ai = 0; ai < 2; ++ai)
#pragma unroll
            for (int m = 0; m < 4; ++m)
#pragma unroll
                for (int bj = 0; bj < 2; ++bj) { const f32x4 a = acc[ai][bj][m][0], b = acc[ai][bj][m][1];
                    v4u w; w.x = cvtpk(a.x, a.y); w.y = cvtpk(a.z, a.w); w.z = cvtpk(b.x, b.y); w.w = cvtpk(b.z, b.w);
                    *(v4u*)(base + (lo + (unsigned)((ai * 128 + m * 16) * ldc + bj * 128))) = w; }
    }
};
struct EpiNull {
    static constexpr bool PERM = true, AFTER_DRAIN = false;
    float* O;
    __device__ __forceinline__ void operator()(const f32x4 (&acc)[2][2][4][2], const pg8::Unit& u, int wr, int wc, int fr, int fq) const {
        float s = 0.f;
#pragma unroll
        for (int ai = 0; ai < 2; ++ai)
#pragma unroll
            for (int bj = 0; bj < 2; ++bj)
#pragma unroll
                for (int m = 0; m < 4; ++m)
#pragma unroll
                    for (int n = 0; n < 2; ++n) s += (acc[ai][bj][m][n].x + acc[ai][bj][m][n].y) + (acc[ai][bj][m][n].z + acc[ai][bj][m][n].w);
        if (s == 12345.678f) O[threadIdx.x] = s;
    }
};
__device__ __forceinline__ void ld8f(const float* xf, const bf16* xb, size_t off, f32x4& a, f32x4& b) {
    if (xf) { a = *(const f32x4*)(xf + off); b = *(const f32x4*)(xf + off + 4); }
    else { const v4u w = *(const v4u*)(xb + off); a = (f32x4){bflo(w.x), bfhi(w.x), bflo(w.y), bfhi(w.y)}; b = (f32x4){bflo(w.z), bfhi(w.z), bflo(w.w), bfhi(w.w)}; } }
template <bool F32IN> struct EpiRes {
    static constexpr bool PERM = true, AFTER_DRAIN = false;
    const float* xf; const bf16* xbin; bf16* x1b; float* ss1;
    __device__ __forceinline__ void operator()(const f32x4 (&acc)[2][2][4][2], const pg8::Unit& u, int wr, int wc, int fr, int fq) const {
        const int row0 = u.pm * 256 + wr * 64 + fr;
#pragma unroll
        for (int ai = 0; ai < 2; ++ai)
#pragma unroll
            for (int m = 0; m < 4; ++m) {
                const int row = row0 + ai * 128 + m * 16; float q = 0.f;
#pragma unroll
                for (int bj = 0; bj < 2; ++bj) { const size_t off = (size_t)row * D + u.pn * 256 + bj * 128 + wc * 32 + 8 * fq;
                    f32x4 a, b; if (F32IN) ld8f(xf, nullptr, off, a, b); else ld8f(nullptr, xbin, off, a, b); a += acc[ai][bj][m][0]; b += acc[ai][bj][m][1];
                    q += (a.x * a.x + a.y * a.y) + (a.z * a.z + a.w * a.w) + (b.x * b.x + b.y * b.y) + (b.z * b.z + b.w * b.w);
                    v4u w; w.x = cvtpk(a.x, a.y); w.y = cvtpk(a.z, a.w); w.z = cvtpk(b.x, b.y); w.w = cvtpk(b.z, b.w);
                    *(v4u*)(x1b + off) = w; }
                q += __shfl_xor(q, 16); q += __shfl_xor(q, 32);
                if (fq == 0) ss1[(size_t)row * 16 + u.pn * 4 + wc] = q;
            }
    }
};
struct EpiGate {
    static constexpr bool PERM = true, AFTER_DRAIN = false;
    const float* ss1; const bf16* x1b; const bf16* pe; float* xout; bf16* xb; float* ssx;
    __device__ __forceinline__ void operator()(const f32x4 (&acc)[2][2][4][2], const pg8::Unit& u, int wr, int wc, int fr, int fq) const {
        const int row0 = u.pm * 256 + wr * 64 + fr; float rr[8]; rows_r8(ss1, row0, fq, 1.0f / D, rr);
#pragma unroll
        for (int ai = 0; ai < 2; ++ai)
#pragma unroll
            for (int m = 0; m < 4; ++m) {
                const int row = row0 + ai * 128 + m * 16; const float r1 = rr[ai * 4 + m]; float q = 0.f;
#pragma unroll
                for (int bj = 0; bj < 2; ++bj) { const size_t off = (size_t)row * D + u.pn * 256 + bj * 128 + wc * 32 + 8 * fq;
                    const v4u pw = *(const v4u*)(pe + off); f32x4 xa, xc; ld8f(nullptr, x1b, off, xa, xc);
                    const f32x4 ga = acc[ai][bj][m][0] * r1, gb = acc[ai][bj][m][1] * r1;
                    f32x4 a, b;
                    a.x = xa.x + sigm(ga.x) * bflo(pw.x); a.y = xa.y + sigm(ga.y) * bfhi(pw.x); a.z = xa.z + sigm(ga.z) * bflo(pw.y); a.w = xa.w + sigm(ga.w) * bfhi(pw.y);
                    b.x = xc.x + sigm(gb.x) * bflo(pw.z); b.y = xc.y + sigm(gb.y) * bfhi(pw.z); b.z = xc.z + sigm(gb.z) * bflo(pw.w); b.w = xc.w + sigm(gb.w) * bfhi(pw.w);
                    q += (a.x * a.x + a.y * a.y) + (a.z * a.z + a.w * a.w) + (b.x * b.x + b.y * b.y) + (b.z * b.z + b.w * b.w);
                    if (xout) { *(f32x4*)(xout + off) = a; *(f32x4*)(xout + off + 4) = b; }
                    v4u w; w.x = cvtpk(a.x, a.y); w.y = cvtpk(a.z, a.w); w.z = cvtpk(b.x, b.y); w.w = cvtpk(b.z, b.w);
                    *(v4u*)(xb + off) = w; }
                q += __shfl_xor(q, 16); q += __shfl_xor(q, 32);
                if (fq == 0) ssx[(size_t)row * 16 + u.pn * 4 + wc] = q;
            }
    }
};

struct Args { const void* in[22]; float* out; unsigned char* ws; int ph_lo, ph_hi; };
#define CAS __attribute__((address_space(4)))
__device__ __forceinline__ const unsigned char CAS* kargs() { const unsigned char CAS* p = (const unsigned char CAS*)__builtin_amdgcn_kernarg_segment_ptr(); asm volatile("" : "+s"(p)); return p; }
#define KIN(T_, i) (*(T_* const CAS*)(kargs() + 8 * (i)))
struct Ctx {
    LAS unsigned char* lds; int tid, lane, wave, G, bid;
    float* out; unsigned char* ws;
};
#define WSP(T_, off) ((T_*)(C.ws + (off)))

__device__ __forceinline__ int srcA(int n) { if (n < 4096) { const int t = n >> 8, r = n & 255; return r < 128 ? 128 * t + r : 4096 + 128 * t + (r - 128); } return 2048 + (n - 4096); }
__device__ __forceinline__ int srcB(int n) {
    const int tile = n >> 8, P = n & 255, bj = P >> 7, p = P & 127;
    if (tile < 5) { const int act = (p >> 3) * 4 + (p & 3) + ((p >> 2) & 1) * 64; return (tile < 4 ? (2 * tile + bj) * 128 : 1024 + bj * 128) + act; }
    if (tile == 5) return 1280 + P;
    if (tile < 8) { const int ih = 4 * (tile - 6) + 2 * bj + (p >> 6), pp = p & 63, act = (pp >> 3) * 4 + (pp & 3) + ((pp >> 2) & 1) * 32; return 1536 + ih * 64 + act; }
    if (tile < 12) return 2120 + (n - 2048);
    if (P < 32) return 2048 + P; if (P < 40) return 2112 + (P - 32); if (P >= 128 && P < 160) return 2048 + 32 + (P - 128); return -1;
}
template <int MAP> __device__ __forceinline__ void tr_job(const float* W, int K, int Nsrc, const float* gs, bf16* WT, int Ndst, int& base, int gw, int NGW, int lane) {
    const int nblk = Ndst / 256, nitems = (K / 64) * nblk;
    int first = (gw - base) % NGW; if (first < 0) first += NGW;
    for (int it = first; it < nitems; it += NGW) {
        const int kb = it / nblk, nb = it - kb * nblk, k0 = 64 * kb, n = 256 * nb + 4 * lane;
        const int src = MAP == 0 ? n : (MAP == 1 ? srcA(n) : srcB(n));
#pragma unroll
        for (int h = 0; h < 2; ++h) { f32x4 v[32];
#pragma unroll
            for (int i = 0; i < 32; ++i) v[i] = src >= 0 ? *(const f32x4*)(W + (size_t)(k0 + 32 * h + i) * Nsrc + src) : (f32x4){0.f, 0.f, 0.f, 0.f};
            if (gs) {
#pragma unroll
                for (int i = 0; i < 32; ++i) v[i] *= gs[k0 + 32 * h + i]; }
#pragma unroll
            for (int j = 0; j < 4; ++j) { bf16* dst = WT + (size_t)(n + j) * K + k0 + 32 * h;
#pragma unroll
                for (int q = 0; q < 4; ++q) { v4u o; o.x = cvtpk(v[8 * q][j], v[8 * q + 1][j]); o.y = cvtpk(v[8 * q + 2][j], v[8 * q + 3][j]); o.z = cvtpk(v[8 * q + 4][j], v[8 * q + 5][j]); o.w = cvtpk(v[8 * q + 6][j], v[8 * q + 7][j]);
                    *(v4u*)(dst + 8 * q) = o; } } }
    }
    base = (base + nitems) % NGW;
}
__device__ __forceinline__ void sincos_d(double a, double& s, double& c) {
    const double k = rint(a * 0.63661977236758134308);
    double r = fma(-k, 1.5707963267948966192, a); r = fma(-k, 6.123233995736766e-17, r);
    const double r2 = r * r;
    double sp = -7.647163731819816e-13; sp = fma(sp, r2, 1.605904383682161e-10); sp = fma(sp, r2, -2.505210838544172e-08); sp = fma(sp, r2, 2.755731922398589e-06); sp = fma(sp, r2, -1.984126984126984e-04);
    sp = fma(sp, r2, 8.333333333333333e-03); sp = fma(sp, r2, -1.666666666666667e-01); const double sn = fma(sp * r2, r, r);
    double cp = 4.779477332387385e-14; cp = fma(cp, r2, -1.147074559772972e-11); cp = fma(cp, r2, 2.087675698786810e-09); cp = fma(cp, r2, -2.755731922398589e-07); cp = fma(cp, r2, 2.480158730158730e-05);
    cp = fma(cp, r2, -1.388888888888889e-03); cp = fma(cp, r2, 4.166666666666666e-02); cp = fma(cp, r2, -0.5); const double cs = fma(cp, r2, 1.0);
    const int q = (int)((long long)k & 3);
    s = (q == 0) ? sn : (q == 1) ? cs : (q == 2) ? -sn : -cs;
    c = (q == 0) ? cs : (q == 1) ? -sn : (q == 2) ? -cs : sn;
}
__device__ __forceinline__ void prologue_part(Ctx& C, int part, bool split, int gw, int NGW) {
    const int lane = C.lane; int base = 0;
    const int j0 = split ? (part == 1 ? 1 : 0) : 0, j1 = split ? (part == 0 ? 1 : (part == 1 ? 2 : 0)) : 2;
    for (int j = j0; j < j1; ++j) {
        tr_job<1>(KIN(const float, 9) + (size_t)j * D * NA_IN, D, NA_IN, KIN(const float, 8) + (2 * j) * D, WSP(bf16, WS_WINA + j * SZ_WINA), NA_IN, base, gw, NGW, lane);
        tr_job<0>(KIN(const float, 13) + (size_t)j * AW * D, AW, D, nullptr, WSP(bf16, WS_WOUTA + j * SZ_WOUTA), D, base, gw, NGW, lane);
        tr_job<2>(KIN(const float, 14) + (size_t)j * D * NB_SRC, D, NB_SRC, KIN(const float, 8) + (2 * j + 1) * D, WSP(bf16, WS_WINB + j * SZ_WINB), NB_IN, base, gw, NGW, lane);
        tr_job<0>(KIN(const float, 18) + (size_t)j * D * D, D, D, nullptr, WSP(bf16, WS_WOUTB + j * SZ_WSQ), D, base, gw, NGW, lane);
        for (int i = 2 * j; i < 2 * j + 2; ++i) {
            tr_job<0>(KIN(const float, 20) + (size_t)i * D * D, D, D, KIN(const float, 19) + i * D, WSP(bf16, WS_WGATE + i * SZ_WSQ), D, base, gw, NGW, lane);
            tr_job<0>(KIN(const float, 21) + (size_t)i * PD * D, PD, D, nullptr, WSP(bf16, WS_WPE + i * SZ_WPE), D, base, gw, NGW, lane); }
    }
    const int pr0 = split ? (part == 2 ? T : 0) : 0, pr1 = split ? (part == 0 ? T : (part == 2 ? 4 * T : 0)) : 4 * T;
    for (int r0 = pr0 + gw * 4; r0 < pr1; r0 += NGW * 4) { f32x4 v[4];
#pragma unroll
        for (int e = 0; e < 4; ++e) { const int r = r0 + e, i = r / T, m = r - i * T;
            const float* src = m < TP ? KIN(const float, 6) + ((size_t)i * TP + m) * PD : KIN(const float, 7) + ((size_t)i * TS + (m - TP)) * PD; v[e] = ((const f32x4*)src)[lane]; }
#pragma unroll
        for (int e = 0; e < 4; ++e) { u32x2v w; w.x = cvtpk(v[e].x, v[e].y); w.y = cvtpk(v[e].z, v[e].w); ((u32x2v*)(WSP(bf16, WS_PB) + (size_t)(r0 + e) * PD))[lane] = w; } }
    if (part != 0) return;
    for (int m0 = gw * 2; m0 < T; m0 += NGW * 2) { f32x4 v[2][4];
#pragma unroll
        for (int e = 0; e < 2; ++e) { const int m = m0 + e; const float* src = m < TP ? KIN(const float, 0) + (size_t)m * D : KIN(const float, 1) + (size_t)(m - TP) * D;
#pragma unroll
            for (int j = 0; j < 4; ++j) v[e][j] = ((const f32x4*)src)[lane + 64 * j]; }
#pragma unroll
        for (int e = 0; e < 2; ++e) { const int m = m0 + e; bf16* dst = WSP(bf16, WS_XB0) + (size_t)m * D; float s = 0.f;
#pragma unroll
            for (int j = 0; j < 4; ++j) { const f32x4 x = v[e][j]; s += (x.x * x.x + x.y * x.y) + (x.z * x.z + x.w * x.w); u32x2v w; w.x = cvtpk(x.x, x.y); w.y = cvtpk(x.z, x.w); ((u32x2v*)dst)[lane + 64 * j] = w; }
            s = wave_sum(s); if (lane < 16) WSP(float, WS_SSX)[(size_t)m * 16 + lane] = lane == 0 ? s : 0.f; } }
    for (int e = gw * 64 + lane; e < NPOS * 64; e += NGW * 64) { const int pos = e >> 6, i = e & 63; double inv = 1.0; for (int k = 0; k < i; ++k) inv *= 0.8659643233600653;
        double s, c; sincos_d((double)pos * inv, s, c); const f32x2v v = (f32x2v){(float)c, (float)s}; WSP(f32x2v, WS_ROPE)[e] = v; if ((i & 1) == 0) WSP(f32x2v, WS_ROPE32)[pos * 32 + (i >> 1)] = v; }
}

__device__ __forceinline__ s16x4 tr_read(LAS unsigned char* p) { return __builtin_bit_cast(s16x4, __builtin_amdgcn_ds_read_tr16_b64_v4i16((LAS s16x4*)p)); }
__device__ __forceinline__ int crow(int r, int hi) { return (r & 3) + 8 * (r >> 2) + 4 * hi; }
constexpr int GT_WM = 0, GT_WMS = 272, GT_V = 34816, GT_VS = 576;
__device__ __forceinline__ void gate_build_wm(LAS unsigned char* lds, const float* wsg, bool samp, int tid) {
    const int t = tid >> 2, s0 = (tid & 3) * 32;
#pragma unroll 4
    for (int i = 0; i < 32; i += 2) { float v[2];
#pragma unroll
        for (int e = 0; e < 2; ++e) { const int s = s0 + i + e; bool ok; float wv;
            if (!samp) { ok = s <= t; wv = wsg[t * 128 + s]; } else { ok = ((s >> 3) == (t >> 3)) && ((s & 7) <= (t & 7)); wv = wsg[(t & 7) * 128 + (s & 7)]; }
            v[e] = ok ? wv : 0.f; }
        *(LAS unsigned*)(lds + GT_WM + t * GT_WMS + (s0 + i) * 2) = cvtpk(v[0], v[1]); }
}
__device__ __forceinline__ void gate_phase(Ctx& C, int j) {
    int tid = C.tid; asm volatile("" : "+v"(tid));
    const int lane = tid & 63, w = __builtin_amdgcn_readfirstlane(tid >> 6), r32 = lane & 31, hi = lane >> 5;
    LAS unsigned char* lds = C.lds;
    const bf16* Vr = WSP(bf16, WS_VR); const bf16* UZ = WSP(bf16, WS_UZ); bf16* Y = WSP(bf16, WS_Y); const float* vss = WSP(float, WS_VSS);
    int wm_state = -1;
#define GATE_DECODE(item_, samp_, tile_, g_, t0_, nit_) const bool samp_ = (item_) >= 1024; int tile_, g_, t0_, nit_; \
        if (!samp_) { tile_ = (item_) >> 3; g_ = (item_) & 7; t0_ = 0; nit_ = 8; } else { const int s_ = (item_) - 1024; g_ = s_ & 7; tile_ = 128 + ((s_ >> 3) & 7); t0_ = 32 * (s_ >> 6); nit_ = 2; }
#define GATE_LOAD(V_, Q_, tile_, g_, t0_, nit_) do { _Pragma("unroll") for (int i = 0; i < 8; ++i) if (i < (nit_)) { const int idx = tid + 512 * i, t = (t0_) + (idx >> 5), c = (idx & 31) * 8; \
        const size_t off = (size_t)((tile_) * 128 + t) * AW + (g_) * 256 + c; V_[i] = *(const v4u*)(Vr + off); Q_[i] = vss[(size_t)((tile_) * 128 + t) * 32 + (lane & 31)]; } } while (0)
    v4u vn[8]; float qn[8];
    if (C.bid < 1024 + 256) { GATE_DECODE(C.bid, s0_, ti0_, g0_, t00_, n0_); GATE_LOAD(vn, qn, ti0_, g0_, t00_, n0_); }
    for (int item = C.bid; item < 1024 + 256; item += C.G) {
        GATE_DECODE(item, samp, tile, g, t0, nit);
        const int row0 = tile * 128;
        if (wm_state != g * 2 + (samp ? 1 : 0)) { __syncthreads(); gate_build_wm(lds, KIN(const float, 10) + (size_t)(j * 8 + g) * 128 * 128, samp, tid); wm_state = g * 2 + (samp ? 1 : 0); }
        v4u uzr[8], vr[8]; float qr_[8];
#pragma unroll
        for (int i = 0; i < 8; ++i) { vr[i] = vn[i]; qr_[i] = qn[i]; }
#pragma unroll
        for (int i = 0; i < 8; ++i) if (i < nit) { const int idx = tid + 512 * i, t = t0 + (idx >> 5), c = (idx & 31) * 8; uzr[i] = *(const v4u*)(UZ + (size_t)(row0 + t) * AW + g * 256 + c); }
#pragma unroll
        for (int i = 0; i < 8; ++i) if (i < nit) { const int idx = tid + 512 * i, s = t0 + (idx >> 5), c = (idx & 31) * 8; const v4u v = vr[i]; float q = qr_[i];
#pragma unroll
            for (int o = 1; o < 32; o <<= 1) q += __shfl_xor(q, o);
            const float rv = rsq(q * (1.0f / AW) + EPS);
            f32x4 a = (f32x4){bflo(v.x), bfhi(v.x), bflo(v.y), bfhi(v.y)} * rv, b = (f32x4){bflo(v.z), bfhi(v.z), bflo(v.w), bfhi(v.w)} * rv;
            v4u wv; wv.x = cvtpk(a.x, a.y); wv.y = cvtpk(a.z, a.w); wv.z = cvtpk(b.x, b.y); wv.w = cvtpk(b.z, b.w);
            *(LAS v4u*)(lds + GT_V + s * GT_VS + c * 2) = wv;
            if (samp) { const int ms = row0 + s - TP, db = ms >> 3, tt = ms & 7; const float* gv = KIN(const float, 12) + j * AW + g * 256 + c;
                float* o = C.out + O_CV + ((size_t)(db * 2 + j) * DSEQ + tt) * AW + g * 256 + c;
                *(f32x4*)o = a * *(const f32x4*)gv; *(f32x4*)(o + 4) = b * *(const f32x4*)(gv + 4); } }
        __syncthreads();
        { LAS unsigned char* vb = lds + GT_V + (8 * hi + ((lane & 15) >> 2)) * GT_VS + (32 * w + 16 * ((lane >> 4) & 1) + 4 * (lane & 3)) * 2;
          const int tb0 = t0 >> 5, tb1 = samp ? tb0 + 1 : 4;
          bf16x8 Bf[8];
#pragma unroll
          for (int ks = 0; ks < 8; ++ks) if (!samp || (ks >> 1) == tb0) { const s16x4 l = tr_read(vb + (16 * ks) * GT_VS), h = tr_read(vb + (16 * ks + 4) * GT_VS);
              Bf[ks] = (bf16x8){l[0], l[1], l[2], l[3], h[0], h[1], h[2], h[3]}; }
          __syncthreads();
          if (item + C.G < 1024 + 256) { GATE_DECODE(item + C.G, sn_, tin_, gn_, t0n_, nn_); GATE_LOAD(vn, qn, tin_, gn_, t0n_, nn_); }
          const float gv = KIN(const float, 12)[j * AW + g * 256 + 32 * w + r32]; const float* bs = KIN(const float, 11) + (size_t)(j * 8 + g) * 128;
#pragma unroll
          for (int tb = 0; tb < 4; ++tb) if (tb >= tb0 && tb < tb1) { f32x16 acc = {};
#pragma unroll
              for (int ks = 0; ks < 8; ++ks) if (ks <= 2 * tb + 1 && (!samp || (ks >> 1) == tb)) {
                  const bf16x8 af = *(LAS bf16x8*)(lds + GT_WM + (32 * tb + r32) * GT_WMS + (16 * ks + 8 * hi) * 2);
                  acc = __builtin_amdgcn_mfma_f32_32x32x16_bf16(af, Bf[ks], acc, 0, 0, 0); }
#pragma unroll
              for (int i = 0; i < 16; ++i) { const int t = 32 * tb + crow(i, hi); *(LAS bf16*)(lds + GT_V + t * GT_VS + (32 * w + r32) * 2) = (bf16)f2bf(gv * acc[i] + bs[samp ? (t & 7) : t]); } } }
        __syncthreads();
#pragma unroll
        for (int i = 0; i < 8; ++i) if (i < nit) { const int idx = tid + 512 * i, t = t0 + (idx >> 5), c = (idx & 31) * 8; const size_t off = (size_t)(row0 + t) * AW + g * 256 + c;
            const v4u mx = *(const LAS v4u*)(lds + GT_V + t * GT_VS + c * 2), uz = uzr[i]; v4u y;
            y.x = cvtpk(bflo(uz.x) * bflo(mx.x), bfhi(uz.x) * bfhi(mx.x)); y.y = cvtpk(bflo(uz.y) * bflo(mx.y), bfhi(uz.y) * bfhi(mx.y));
            y.z = cvtpk(bflo(uz.z) * bflo(mx.z), bfhi(uz.z) * bfhi(mx.z)); y.w = cvtpk(bflo(uz.w) * bflo(mx.w), bfhi(uz.w) * bfhi(mx.w));
            *(v4u*)(Y + off) = y; }
        __syncthreads();
    }
}

struct EpiB1 {
    static constexpr bool PERM = true, AFTER_DRAIN = false;
    unsigned char* ws; const float *gq, *gk, *gik; float* out; int j; LAS float* xch;
#define EB1(T_, off) ((T_*)(ws + (off)))
    __device__ __forceinline__ static void rot4(const f32x4& a, const f32x4& b, const f32x4& cs01, const f32x4& cs23, f32x4& oa, f32x4& ob) {
        oa.x = a.x * cs01.x - b.x * cs01.y; ob.x = b.x * cs01.x + a.x * cs01.y; oa.y = a.y * cs01.z - b.y * cs01.w; ob.y = b.y * cs01.z + a.y * cs01.w;
        oa.z = a.z * cs23.x - b.z * cs23.y; ob.z = b.z * cs23.x + a.z * cs23.y; oa.w = a.w * cs23.z - b.w * cs23.w; ob.w = b.w * cs23.z + a.w * cs23.w; }
    __device__ __forceinline__ static u32x2v pk4(const f32x4& a) { u32x2v w; w.x = cvtpk(a.x, a.y); w.y = cvtpk(a.z, a.w); return w; }
    __device__ __forceinline__ void operator()(const f32x4 (&acc)[2][2][4][2], const pg8::Unit& u, int wr, int wc, int fr_, int fq_) const {
        int fr = fr_, fq = fq_; asm volatile("" : "+v"(fr), "+v"(fq));
        const int row0 = u.pm * 256 + wr * 64 + fr, pn = u.pn; float rr[8]; rows_r8(EB1(const float, WS_SSX), row0, fq, 1.0f / D, rr);
        if (pn < 5) {
            const bool isk = pn == 4; const int c = 16 * wc + 4 * fq; const float* gg = isk ? gk : gq;
            const f32x4 g0 = *(const f32x4*)(gg + c), g1 = *(const f32x4*)(gg + 64 + c);
            if (isk) {
#pragma unroll
                for (int ai = 0; ai < 2; ++ai)
#pragma unroll
                    for (int m = 0; m < 4; ++m) { const int row = row0 + ai * 128 + m * 16; const float r = rr[ai * 4 + m];
#pragma unroll
                        for (int bj = 0; bj < 2; ++bj) { const f32x4 a = acc[ai][bj][m][0] * r, b = acc[ai][bj][m][1] * r;
                            float q = (a.x * a.x + a.y * a.y) + (a.z * a.z + a.w * a.w) + (b.x * b.x + b.y * b.y) + (b.z * b.z + b.w * b.w);
                            q += __shfl_xor(q, 16); q += __shfl_xor(q, 32);
                            if (fq == 0) xch[((wr * 64 + ai * 128 + m * 16 + fr) * 2 + bj) * 4 + wc] = q; } }
                asm volatile("s_waitcnt lgkmcnt(0)" ::: "memory"); __builtin_amdgcn_s_barrier(); asm volatile("" ::: "memory");
            }
#pragma unroll
            for (int ai = 0; ai < 2; ++ai)
#pragma unroll
                for (int m = 0; m < 4; ++m) {
                    const int row = row0 + ai * 128 + m * 16; const float r = rr[ai * 4 + m];
                    const int pos = row < TP ? (row & (SEQ - 1)) : SEQ + ((row - TP) & (DSEQ - 1));
                    const f32x4 cs01 = *(const f32x4*)(EB1(const f32x2v, WS_ROPE) + pos * 64 + c), cs23 = *(const f32x4*)(EB1(const f32x2v, WS_ROPE) + pos * 64 + c + 2);
                    float* ko = nullptr;
                    if (isk) { if (row < TP) ko = out + O_KP + ((size_t)((row >> 11) * 2 + j) * SEQ + (row & (SEQ - 1))) * KVW; else { const int ms = row - TP; ko = out + O_KS + ((size_t)((ms >> 3) * 2 + j) * DSEQ + (ms & 7)) * KVW; } }
#pragma unroll
                    for (int bj = 0; bj < 2; ++bj) { const f32x4 a = acc[ai][bj][m][0] * r, b = acc[ai][bj][m][1] * r;
                        f32x4 ra, rb; rot4(a * g0, b * g1, cs01, cs23, ra, rb);
                        if (!isk) { const int hd = 2 * pn + bj;
                            float q = (a.x * a.x + a.y * a.y) + (a.z * a.z + a.w * a.w) + (b.x * b.x + b.y * b.y) + (b.z * b.z + b.w * b.w);
                            q += __shfl_xor(q, 16); q += __shfl_xor(q, 32);
                            if (fq == 0) EB1(float, WS_QSS)[((size_t)row * NH + hd) * 4 + wc] = q;
                            bf16* qp = EB1(bf16, WS_Q) + (size_t)row * D + hd * HD + c; *(u32x2v*)qp = pk4(ra); *(u32x2v*)(qp + 64) = pk4(rb); }
                        else { const f32x4 pq = *(const LAS f32x4*)(xch + ((wr * 64 + ai * 128 + m * 16 + fr) * 2 + bj) * 4);
                            const float rk = rsq(((pq.x + pq.y) + (pq.z + pq.w)) * (1.0f / HD) + EPS); const f32x4 ka = ra * rk, kb = rb * rk;
                            *(f32x4*)(ko + bj * HD + c) = ka; *(f32x4*)(ko + bj * HD + 64 + c) = kb;
                            bf16* kp = EB1(bf16, WS_KB) + (size_t)row * KVW + bj * HD + c; *(u32x2v*)kp = pk4(ka); *(u32x2v*)(kp + 64) = pk4(kb); } }
                }
        } else if (pn == 5) {
#pragma unroll
            for (int ai = 0; ai < 2; ++ai)
#pragma unroll
                for (int m = 0; m < 4; ++m) { const int row = row0 + ai * 128 + m * 16; const float r = rr[ai * 4 + m]; float* vo;
                    if (row < TP) vo = out + O_VP + ((size_t)((row >> 11) * 2 + j) * SEQ + (row & (SEQ - 1))) * KVW; else { const int ms = row - TP; vo = out + O_VS + ((size_t)((ms >> 3) * 2 + j) * DSEQ + (ms & 7)) * KVW; }
#pragma unroll
                    for (int bj = 0; bj < 2; ++bj) { const int cc = bj * 128 + wc * 32 + 8 * fq; const f32x4 a = acc[ai][bj][m][0] * r, b = acc[ai][bj][m][1] * r;
                        *(f32x4*)(vo + cc) = a; *(f32x4*)(vo + cc + 4) = b; v4u w; w.x = cvtpk(a.x, a.y); w.y = cvtpk(a.z, a.w); w.z = cvtpk(b.x, b.y); w.w = cvtpk(b.z, b.w);
                        *(v4u*)(EB1(bf16, WS_VB) + (size_t)row * KVW + cc) = w; } }
        } else if (pn < 8) {
            const int c = 16 * (wc & 1) + 4 * fq;
#pragma unroll
            for (int ai = 0; ai < 2; ++ai)
#pragma unroll
                for (int m = 0; m < 4; ++m) { const int row = row0 + ai * 128 + m * 16; const float r = rr[ai * 4 + m];
                    const int pos = row < TP ? (row & (SEQ - 1)) : SEQ + ((row - TP) & (DSEQ - 1));
                    const f32x4 cs01 = *(const f32x4*)(EB1(const f32x2v, WS_ROPE32) + pos * 32 + c), cs23 = *(const f32x4*)(EB1(const f32x2v, WS_ROPE32) + pos * 32 + c + 2);
#pragma unroll
                    for (int bj = 0; bj < 2; ++bj) { f32x4 ra, rb; rot4(acc[ai][bj][m][0] * r, acc[ai][bj][m][1] * r, cs01, cs23, ra, rb);
                        bf16* ip = EB1(bf16, WS_IQ) + (size_t)row * 512 + (4 * (pn - 6) + 2 * bj + (wc >> 1)) * IDXD + c; *(u32x2v*)ip = pk4(ra); *(u32x2v*)(ip + 32) = pk4(rb); } }
        } else if (pn < 12) {
#pragma unroll
            for (int ai = 0; ai < 2; ++ai)
#pragma unroll
                for (int m = 0; m < 4; ++m) { const int row = row0 + ai * 128 + m * 16; const float r = rr[ai * 4 + m];
#pragma unroll
                    for (int bj = 0; bj < 2; ++bj) { const f32x4 a = acc[ai][bj][m][0] * r, b = acc[ai][bj][m][1] * r; v4u w;
                        w.x = cvtpk(a.x * sigm(a.x), a.y * sigm(a.y)); w.y = cvtpk(a.z * sigm(a.z), a.w * sigm(a.w)); w.z = cvtpk(b.x * sigm(b.x), b.y * sigm(b.y)); w.w = cvtpk(b.z * sigm(b.z), b.w * sigm(b.w));
                        *(v4u*)(EB1(bf16, WS_SZ) + (size_t)row * D + (pn - 8) * 256 + bj * 128 + wc * 32 + 8 * fq) = w; } }
        } else if (wc == 0) {
            const int c = 8 * fq; const f32x4 g0a = *(const f32x4*)(gik + c), g0b = *(const f32x4*)(gik + c + 4), g1a = *(const f32x4*)(gik + 32 + c), g1b = *(const f32x4*)(gik + 32 + c + 4);
#pragma unroll
            for (int ai = 0; ai < 2; ++ai)
#pragma unroll
                for (int m = 0; m < 4; ++m) { const int row = row0 + ai * 128 + m * 16; const float r = rr[ai * 4 + m];
                    const int pos = row < TP ? (row & (SEQ - 1)) : SEQ + ((row - TP) & (DSEQ - 1)); float* iko;
                    if (row < TP) iko = out + O_IKP + ((size_t)((row >> 11) * 2 + j) * SEQ + (row & (SEQ - 1))) * IDXD; else { const int ms = row - TP; iko = out + O_IKS + ((size_t)((ms >> 3) * 2 + j) * DSEQ + (ms & 7)) * IDXD; }
                    const f32x4 a0 = acc[ai][0][m][0] * r, a1 = acc[ai][0][m][1] * r, b0 = acc[ai][1][m][0] * r, b1 = acc[ai][1][m][1] * r;
                    float q = ((a0.x * a0.x + a0.y * a0.y) + (a0.z * a0.z + a0.w * a0.w)) + ((a1.x * a1.x + a1.y * a1.y) + (a1.z * a1.z + a1.w * a1.w))
                            + ((b0.x * b0.x + b0.y * b0.y) + (b0.z * b0.z + b0.w * b0.w)) + ((b1.x * b1.x + b1.y * b1.y) + (b1.z * b1.z + b1.w * b1.w));
                    q += __shfl_xor(q, 16); q += __shfl_xor(q, 32); const float rk = rsq(q * (1.0f / IDXD) + EPS);
                    const f32x4 c01 = *(const f32x4*)(EB1(const f32x2v, WS_ROPE32) + pos * 32 + c), c23 = *(const f32x4*)(EB1(const f32x2v, WS_ROPE32) + pos * 32 + c + 2), c45 = *(const f32x4*)(EB1(const f32x2v, WS_ROPE32) + pos * 32 + c + 4), c67 = *(const f32x4*)(EB1(const f32x2v, WS_ROPE32) + pos * 32 + c + 6);
                    f32x4 ra0, rb0, ra1, rb1; rot4(a0 * g0a * rk, b0 * g1a * rk, c01, c23, ra0, rb0); rot4(a1 * g0b * rk, b1 * g1b * rk, c45, c67, ra1, rb1);
                    *(f32x4*)(iko + c) = ra0; *(f32x4*)(iko + c + 4) = ra1; *(f32x4*)(iko + 32 + c) = rb0; *(f32x4*)(iko + 32 + c + 4) = rb1;
                    bf16* kp = EB1(bf16, WS_IK) + (size_t)row * IDXD + c; v4u w0, w1; w0.x = cvtpk(ra0.x, ra0.y); w0.y = cvtpk(ra0.z, ra0.w); w0.z = cvtpk(ra1.x, ra1.y); w0.w = cvtpk(ra1.z, ra1.w);
                    w1.x = cvtpk(rb0.x, rb0.y); w1.y = cvtpk(rb0.z, rb0.w); w1.z = cvtpk(rb1.x, rb1.y); w1.w = cvtpk(rb1.z, rb1.w); *(v4u*)kp = w0; *(v4u*)(kp + 32) = w1; }
        } else if (wc == 1 && fq == 0) {
#pragma unroll
            for (int ai = 0; ai < 2; ++ai)
#pragma unroll
                for (int m = 0; m < 4; ++m) { const int row = row0 + ai * 128 + m * 16; const float r = rr[ai * 4 + m];
                    *(f32x4*)(EB1(float, WS_IW) + (size_t)row * 8) = acc[ai][0][m][0] * r; *(f32x4*)(EB1(float, WS_IW) + (size_t)row * 8 + 4) = acc[ai][0][m][1] * r; }
        }
    }
};
#undef EB1

constexpr int SC_STRIDE = 2068;
__device__ __forceinline__ unsigned fkey(float x) { const unsigned b = __builtin_bit_cast(unsigned, x + 0.0f); return b ^ ((unsigned)((int)b >> 31) | 0x80000000u); }
__device__ __forceinline__ bf16x8 cvt8(const float* p) { const f32x4 a = *(const f32x4*)p, b = *(const f32x4*)(p + 4); v4u w; w.x = cvtpk(a.x, a.y); w.y = cvtpk(a.z, a.w); w.z = cvtpk(b.x, b.y); w.w = cvtpk(b.z, b.w); return __builtin_bit_cast(bf16x8, w); }
template <int LN> __device__ __forceinline__ unsigned wrlane(unsigned sval, unsigned old) { asm volatile("s_nop 1\n\tv_writelane_b32 %0, %1, %2" : "+v"(old) : "s"(sval), "n"(LN)); return old; }
__device__ __forceinline__ int wave_total6(int c) { int t = 0;
#pragma unroll
    for (int b = 0; b < 6; ++b) t += __popcll(__ballot((c >> b) & 1)) << b;
    return t; }
__device__ __forceinline__ int cnt_ge(const unsigned (&u)[33], unsigned cand, int nq) {
    int c0 = 0, c1 = 0;
#pragma unroll
    for (int i = 0; i < 8; i += 2) { c0 += u[i] >= cand; c1 += u[i + 1] >= cand; }
    if (nq > 1) {
#pragma unroll
        for (int i = 8; i < 16; i += 2) { c0 += u[i] >= cand; c1 += u[i + 1] >= cand; } }
    if (nq > 2) {
#pragma unroll
        for (int i = 16; i < 24; i += 2) { c0 += u[i] >= cand; c1 += u[i + 1] >= cand; } }
    if (nq > 3) {
#pragma unroll
        for (int i = 24; i < 32; i += 2) { c0 += u[i] >= cand; c1 += u[i + 1] >= cand; }
        c0 += u[32] >= cand; }
    return c0 + c1;
}
__device__ __forceinline__ void hist_find(const LAS unsigned* hist, int K, int lane, int& bin, int& above) {
    const v4u a = *(const LAS v4u*)(hist + 8 * lane), b = *(const LAS v4u*)(hist + 8 * lane + 4);
    const int h0 = a.x, h1 = a.y, h2 = a.z, h3 = a.w, h4 = b.x, h5 = b.y, h6 = b.z, h7 = b.w;
    const int s = ((h0 + h1) + (h2 + h3)) + ((h4 + h5) + (h6 + h7)); int S = s;
#pragma unroll
    for (int o = 1; o < 64; o <<= 1) { const int t = __shfl_down(S, o); if (lane + o < 64) S += t; }
    const u64 m = __ballot(S >= K); const int L = 63 - __builtin_clzll(m);
    int acc = S - s, lb = 0, la = 0; bool done = false;
#define HF_(hh, i) if (!done) { if (acc + (hh) >= K) { lb = 8 * lane + (i); la = acc; done = true; } else acc += (hh); }
    HF_(h7, 7) HF_(h6, 6) HF_(h5, 5) HF_(h4, 4) HF_(h3, 3) HF_(h2, 2) HF_(h1, 1) HF_(h0, 0)
#undef HF_
    bin = __builtin_amdgcn_readlane(lb, L); above = __builtin_amdgcn_readlane(la, L);
}
__device__ __forceinline__ void idx_phase(Ctx& C, int j) {
    int tid_ = C.tid; asm volatile("" : "+v"(tid_));
    const int lane = tid_ & 63, wave = __builtin_amdgcn_readfirstlane(tid_ >> 6), fr = lane & 15, fq = lane >> 4;
    LAS float* sc = (LAS float*)C.lds; LAS unsigned* tbuf = (LAS unsigned*)(C.lds + 16 * SC_STRIDE * 4) + wave * 64; LAS unsigned* hist = (LAS unsigned*)(C.lds + 16 * SC_STRIDE * 4 + 2048) + wave * 576;
    const bf16* IQ = WSP(bf16, WS_IQ); const bf16* IKb = WSP(bf16, WS_IK); const float* IW = WSP(float, WS_IW); u64* MASK = WSP(u64, WS_MASK);
    constexpr int NUNITS = 1024 + DBATCH;
    for (int rowi = 0; rowi * C.G < NUNITS; ++rowi) {
#ifndef DUP_IDX_SAMPLE
#define DUP_IDX_SAMPLE 1
#endif
#ifndef DUP_IDX_PROMPT
#define DUP_IDX_PROMPT 1
#endif
        for (int rep_ = 0; rep_ < ((rowi * C.G + ((rowi & 1) ? C.G - 1 - C.bid : C.bid)) < DBATCH ? DUP_IDX_SAMPLE : DUP_IDX_PROMPT); ++rep_)
        { const int unit = rowi * C.G + ((rowi & 1) ? C.G - 1 - C.bid : C.bid);
        if (unit >= NUNITS) continue;
        const bool samp = unit < DBATCH; int b = 0, qg = 0, db = 0, mq0, nkt;
        if (!samp) { const int r = unit - DBATCH; b = r & 7; qg = 127 - (r >> 3); mq0 = b * SEQ + 16 * qg; nkt = qg + 1; } else { db = unit; mq0 = TP + db * DSEQ; nkt = 129; }
        bf16x8 Af[8][2]; { const bf16* qp = IQ + (size_t)(mq0 + (samp ? (fr & 7) : fr)) * 512 + 8 * fq;
#pragma unroll
            for (int h = 0; h < 8; ++h) { Af[h][0] = *(const bf16x8*)(qp + h * 64); Af[h][1] = *(const bf16x8*)(qp + h * 64 + 32); } }
        float iwv[4][8];
#pragma unroll
        for (int r = 0; r < 4; ++r) { const int qi = 4 * fq + r; const float* ip = IW + (size_t)(mq0 + (samp ? (qi & 7) : qi)) * 8; const f32x4 a = *(const f32x4*)ip, c = *(const f32x4*)(ip + 4);
            iwv[r][0] = a.x; iwv[r][1] = a.y; iwv[r][2] = a.z; iwv[r][3] = a.w; iwv[r][4] = c.x; iwv[r][5] = c.y; iwv[r][6] = c.z; iwv[r][7] = c.w; }
        f32x4 raw[4]; const int pgv = samp ? KIN(const int, 5)[db * NPAGES + (lane & 15)] : 0;
#define IDX_LOAD(kt_) do { const int key_ = 16 * (kt_) + fr; \
            if (!samp) { const bf16* kp = IKb + (size_t)(b * SEQ + key_) * 64 + 8 * fq; raw[0] = *(const f32x4*)kp; raw[1] = *(const f32x4*)(kp + 32); } \
            else if (key_ < SEQ) { const int page = __builtin_amdgcn_readlane(pgv, (kt_) >> 3);     const float* kp = KIN(const float, 4) + ((size_t)(page * 2 + j) * PAGE + (key_ & 127)) * IDXD + 8 * fq; \
                raw[0] = *(const f32x4*)kp; raw[1] = *(const f32x4*)(kp + 4); raw[2] = *(const f32x4*)(kp + 32); raw[3] = *(const f32x4*)(kp + 36); } \
            else { const int t_ = key_ - SEQ; const bf16* kp = IKb + (size_t)(TP + db * DSEQ + (t_ < DSEQ ? t_ : 0)) * 64 + 8 * fq; raw[0] = *(const f32x4*)kp; raw[1] = *(const f32x4*)(kp + 32); \
                if (t_ >= DSEQ) { raw[0] = (f32x4){0.f, 0.f, 0.f, 0.f}; raw[1] = raw[0]; } } } while (0)
        if (wave < nkt) IDX_LOAD(wave);
#ifndef PROBE_IDX
#define PROBE_IDX 0
#endif
        const int pmode = rep_ > 0 ? PROBE_IDX : 0;
        for (int kt = wave; kt < ((pmode & 2) ? 0 : nkt); kt += 8) {
            const int key = 16 * kt + fr; bf16x8 B0, B1;
            if (samp && key < SEQ) { v4u w0, w1; w0.x = cvtpk(raw[0].x, raw[0].y); w0.y = cvtpk(raw[0].z, raw[0].w); w0.z = cvtpk(raw[1].x, raw[1].y); w0.w = cvtpk(raw[1].z, raw[1].w);
                w1.x = cvtpk(raw[2].x, raw[2].y); w1.y = cvtpk(raw[2].z, raw[2].w); w1.z = cvtpk(raw[3].x, raw[3].y); w1.w = cvtpk(raw[3].z, raw[3].w); B0 = __builtin_bit_cast(bf16x8, w0); B1 = __builtin_bit_cast(bf16x8, w1); }
            else { B0 = __builtin_bit_cast(bf16x8, raw[0]); B1 = __builtin_bit_cast(bf16x8, raw[1]); }
            if (kt + 8 < nkt) IDX_LOAD(kt + 8);
            f32x4 score = {0.f, 0.f, 0.f, 0.f};
#pragma unroll
            for (int h = 0; h < 8; ++h) { f32x4 acc = {0.f, 0.f, 0.f, 0.f};
                acc = __builtin_amdgcn_mfma_f32_16x16x32_bf16(Af[h][0], B0, acc, 0, 0, 0); acc = __builtin_amdgcn_mfma_f32_16x16x32_bf16(Af[h][1], B1, acc, 0, 0, 0);
#pragma unroll
                for (int r = 0; r < 4; ++r) score[r] = fmaf(iwv[r][h], fmaxf(acc[r], 0.f), score[r]); }
#pragma unroll
            for (int r = 0; r < 4; ++r) { const int qrow = 4 * fq + r, qp_ = samp ? SEQ + (qrow & 7) : 16 * qg + qrow;
                ((LAS unsigned*)sc)[qrow * SC_STRIDE + key] = key <= qp_ ? fkey(score[r]) : 0u; }
        }
#undef IDX_LOAD
        { const int k0 = 16 * nkt, nmax = samp ? SEQ + DSEQ : 16 * qg + 16, k1r = ((nmax + 511) >> 9) << 9, k1 = k1r < SC_STRIDE ? k1r : SC_STRIDE;
          for (int e = tid_; e < 16 * (k1 - k0); e += 512) { const int rw = e / (k1 - k0), kk = k0 + (e - rw * (k1 - k0)); ((LAS unsigned*)sc)[rw * SC_STRIDE + kk] = 0u; } }
        __syncthreads();
        for (int qq = 0; qq < ((pmode & 1) ? 0 : (samp ? 1 : 2)); ++qq) {
            const int qi = samp ? wave : 2 * wave + qq, qpos = samp ? SEQ + qi : 16 * qg + qi, n = qpos + 1;
            u64* mw = (pmode ? WSP(u64, WS_RAW) : MASK) + (size_t)(mq0 + qi) * MASKW; u64 myword = 0ull;
            if (n <= TOPK) { const int lo = 64 * lane; myword = (n >= lo + 64) ? ~0ull : (n > lo ? ((1ull << (n - lo)) - 1ull) : 0ull); }
            else {
                const int nq = (n + 511) >> 9;
                unsigned u[33];
#define R8_(B, o) B((o) + 0) B((o) + 1) B((o) + 2) B((o) + 3) B((o) + 4) B((o) + 5) B((o) + 6) B((o) + 7)
#define FOR_NQ(B) do { R8_(B, 0) if (nq > 1) { R8_(B, 8) } if (nq > 2) { R8_(B, 16) } if (nq > 3) { R8_(B, 24) B(32) } } while (0)
#pragma unroll
                for (int i = 0; i < 33; ++i) u[i] = 0u;
#define B_LOAD(i) { const int s = lane + 64 * (i); if ((i) < 32) u[i] = ((const LAS unsigned*)sc)[qi * SC_STRIDE + s]; else if (s < n) u[i] = ((const LAS unsigned*)sc)[qi * SC_STRIDE + (s < SC_STRIDE ? s : 0)]; }
                FOR_NQ(B_LOAD);
                unsigned thr; int need2, mt = 0;
                { *(LAS v4u*)(hist + 8 * lane) = (v4u){0u, 0u, 0u, 0u}; *(LAS v4u*)(hist + 8 * lane + 4) = (v4u){0u, 0u, 0u, 0u};
#define B_H1(i) { __hip_atomic_fetch_add(hist + (u[i] != 0u ? (u[i] >> 23) : 512u + lane), 1u, __ATOMIC_RELAXED, __HIP_MEMORY_SCOPE_WAVEFRONT); }
                  FOR_NQ(B_H1);
#undef B_H1
                  int b1, ab1; hist_find(hist, TOPK, lane, b1, ab1); const unsigned pre1 = (unsigned)b1 << 23;
                  *(LAS v4u*)(hist + 8 * lane) = (v4u){0u, 0u, 0u, 0u}; *(LAS v4u*)(hist + 8 * lane + 4) = (v4u){0u, 0u, 0u, 0u};
#define B_H2(i) { const unsigned t_ = (u[i] - pre1) >> 14; __hip_atomic_fetch_add(hist + (t_ < 512u ? t_ : 512u + lane), 1u, __ATOMIC_RELAXED, __HIP_MEMORY_SCOPE_WAVEFRONT); }
                  FOR_NQ(B_H2);
#undef B_H2
                  int b2, ab2; hist_find(hist, TOPK - ab1, lane, b2, ab2);
                  thr = ((unsigned)b1 << 23) | ((unsigned)b2 << 14); need2 = TOPK - ab1 - ab2; }
#define B_TIE(i) { const u64 eb = __ballot(((u[i] ^ thr) >> 14) == 0u); if (eb != 0ull) { const int pos = mt + __popcll(eb & ((1ull << lane) - 1ull)); \
                    if (((eb >> lane) & 1ull) && pos < 64) tbuf[pos] = u[i] & 0x3fffu; mt += __popcll(eb); } }
                FOR_NQ(B_TIE);
                int cge;
                if (mt <= 64) { asm volatile("s_waitcnt lgkmcnt(0)" ::: "memory"); const unsigned my = lane < mt ? tbuf[lane] : 0u; unsigned lo = 0u; const bool in = lane < mt;
                    for (int bit = 13; bit >= 0; --bit) { const unsigned cand = lo | (1u << bit); if (__popcll(__ballot(in && my >= cand)) >= need2) lo = cand; }
                    thr |= lo; cge = (TOPK - need2) + __popcll(__ballot(in && my >= lo)); }
                else { for (int bit = 13; bit >= 0; --bit) { const unsigned cand = thr | (1u << bit); if (wave_total6(cnt_ge(u, cand, nq)) >= TOPK) thr = cand; }
                    cge = wave_total6(cnt_ge(u, thr, nq)); }
                unsigned wlo = 0u, whi = 0u;
#define B_FAST(i) { const u64 word = __ballot(u[i] >= thr); wlo = wrlane<(i)>((unsigned)word, wlo); whi = wrlane<(i)>((unsigned)(word >> 32), whi); }
#define B_SLOW(i) { const bool eq = u[i] == thr; const u64 eb = __ballot(eq); const int rank = running + __popcll(eb & ltmask); \
                    const u64 word = __ballot(u[i] > thr || (eq && rank < need)); running += __popcll(eb); wlo = wrlane<(i)>((unsigned)word, wlo); whi = wrlane<(i)>((unsigned)(word >> 32), whi); }
                if (cge == TOPK) { FOR_NQ(B_FAST); }
                else { const int cgt = (thr == 0xffffffffu) ? 0 : wave_total6(cnt_ge(u, thr + 1u, nq)); const int need = TOPK - cgt; int running = 0; const u64 ltmask = (1ull << lane) - 1ull;
                    FOR_NQ(B_SLOW); }
                myword = ((u64)whi << 32) | wlo;
#undef B_LOAD
#undef B_TIE
#undef B_FAST
#undef B_SLOW
#undef FOR_NQ
#undef R8_
            }
            if (lane < MASKW) mw[lane] = myword;
        }
        __syncthreads();
        }
    }
}


namespace att {
#ifndef ATT_SDEPTH
#define ATT_SDEPTH 1
#endif
constexpr float SCALE = 0.088388347648318440f, THR = 8.f, NEG = -3.0e38f;
constexpr int SHM_V = 16384, SHM_K = 16384;
#define KSWZ(row, colB) ((row) * 256 + ((colB) ^ (((row) & 7) << 4)))
#define SBAR() __builtin_amdgcn_sched_barrier(0)
__device__ __forceinline__ int v_st(int k, int c) { const int kk = (k & ~0xC) | ((k & 4) << 1) | ((k & 8) >> 1); return ((kk >> 3) * 4 + (c >> 5)) * 512 + ((kk & 7) * 32 + (c & 31)) * 2; }
__device__ __forceinline__ int v_rd_base(int lane) { return ((lane & 3) << 3) | (((lane >> 2) & 3) << 6) | (((lane >> 4) & 1) << 5) | (((lane >> 5) & 1) << 8); }
constexpr int v_rd_off(int d0, int ks, int half) { return d0 * 512 + ks * 4096 + half * 2048; }
template <int OFF> __device__ __forceinline__ s16x4 tr_read_i(int vb) { s16x4 r; asm volatile("ds_read_b64_tr_b16 %0, %1 offset:%2" : "=&v"(r) : "v"(vb), "i"(OFF) : "memory"); return r; }
#define MASK16(P, W) do { const unsigned nw_ = ~(W); _Pragma("unroll") for (int r = 0; r < 16; ++r) { \
    const unsigned sel_ = ((nw_ << (31 - ((r & 3) + 8 * (r >> 2)))) & 0x80000000u) | selc; P[r] = __builtin_amdgcn_fmed3f(P[r], __builtin_bit_cast(float, sel_), NEG); } } while (0)
template <bool TWO> __device__ __forceinline__ void partialSM(f32x16& p0, f32x16& p1, float& m_reg, float& mn, float& alpha) {
    constexpr float Cc = SCALE * 1.4426950408889634f;
    float pmax = p0[0];
#pragma unroll
    for (int r = 1; r < 16; ++r) pmax = fmaxf(pmax, p0[r]);
    if (TWO) {
#pragma unroll
        for (int r = 0; r < 16; ++r) pmax = fmaxf(pmax, p1[r]); }
    { auto rr = __builtin_amdgcn_permlane32_swap(__float_as_uint(pmax), __float_as_uint(pmax), false, false); pmax = fmaxf(__uint_as_float(rr[0]), __uint_as_float(rr[1])); }
    if (__builtin_expect(__all(pmax - m_reg <= THR / SCALE), 1)) { mn = m_reg; alpha = 1.f; }
    else { mn = fmaxf(m_reg, pmax); alpha = __builtin_amdgcn_exp2f((m_reg - mn) * Cc); m_reg = mn; }
    const float mnC = -mn * Cc;
#pragma unroll
    for (int r = 0; r < 16; ++r) p0[r] = fmaf(p0[r], Cc, mnC);
    if (TWO) {
#pragma unroll
        for (int r = 0; r < 16; ++r) p1[r] = fmaf(p1[r], Cc, mnC); }
#pragma unroll
    for (int r = 0; r < 16; ++r) p0[r] = __builtin_amdgcn_exp2f(p0[r]);
}
#define PK4(P, BASE, OUT) do { unsigned a0 = cvtpk(P[BASE + 0], P[BASE + 1]), a1 = cvtpk(P[BASE + 2], P[BASE + 3]);   \
    unsigned b0 = cvtpk(P[BASE + 4], P[BASE + 5]), b1 = cvtpk(P[BASE + 6], P[BASE + 7]);                              \
    auto r0 = __builtin_amdgcn_permlane32_swap(a0, b0, false, false); auto r1 = __builtin_amdgcn_permlane32_swap(a1, b1, false, false); \
    v4u w_ = {r0[0], r1[0], r0[1], r1[1]}; OUT = __builtin_bit_cast(bf16x8, w_); } while (0)
__device__ __forceinline__ void finishSM(f32x16& p0, f32x16& p1, float alpha, float& l_reg, bf16x8& pa0, bf16x8& pa1, bf16x8& pa2, bf16x8& pa3) {
#pragma unroll
    for (int r = 0; r < 16; ++r) p1[r] = __builtin_amdgcn_exp2f(p1[r]);
    float ps = 0;
#pragma unroll
    for (int r = 0; r < 16; ++r) ps += p0[r];
#pragma unroll
    for (int r = 0; r < 16; ++r) ps += p1[r];
    { auto rr = __builtin_amdgcn_permlane32_swap(__float_as_uint(ps), __float_as_uint(ps), false, false); ps = __uint_as_float(rr[0]) + __uint_as_float(rr[1]); }
    l_reg = l_reg * alpha + ps;
    PK4(p0, 0, pa0); PK4(p0, 8, pa1); PK4(p1, 0, pa2); PK4(p1, 8, pa3);
}
__device__ __forceinline__ void qkt(f32x16& p0, f32x16& p1, int Ks, const bf16x8* qr, int r32, int hi) {
    p0 = f32x16{}; p1 = f32x16{};
#pragma unroll
    for (int d0 = 0; d0 < 8; ++d0) { const int cb = (d0 * 16 + hi * 8) * 2;
        const bf16x8 b0 = *(const LAS bf16x8*)(uintptr_t)(Ks + KSWZ(r32, cb)); const bf16x8 b1 = *(const LAS bf16x8*)(uintptr_t)(Ks + KSWZ(32 + r32, cb));
        p0 = __builtin_amdgcn_mfma_f32_32x32x16_bf16(b0, qr[d0], p0, 0, 0, 0); p1 = __builtin_amdgcn_mfma_f32_32x32x16_bf16(b1, qr[d0], p1, 0, 0, 0); }
}
#define PKLH(L, H) (bf16x8){L[0], L[1], L[2], L[3], H[0], H[1], H[2], H[3]}
template <int D0> __device__ __forceinline__ void pv_one(f32x16& od, int vb, bf16x8 pa0, bf16x8 pa1, bf16x8 pa2, bf16x8 pa3) {
    const s16x4 l0 = tr_read_i<v_rd_off(D0, 0, 0)>(vb), h0 = tr_read_i<v_rd_off(D0, 0, 1)>(vb), l1 = tr_read_i<v_rd_off(D0, 1, 0)>(vb), h1 = tr_read_i<v_rd_off(D0, 1, 1)>(vb);
    const s16x4 l2 = tr_read_i<v_rd_off(D0, 2, 0)>(vb), h2 = tr_read_i<v_rd_off(D0, 2, 1)>(vb), l3 = tr_read_i<v_rd_off(D0, 3, 0)>(vb), h3 = tr_read_i<v_rd_off(D0, 3, 1)>(vb);
    asm volatile("s_waitcnt lgkmcnt(0)" ::: "memory"); SBAR();
    od = __builtin_amdgcn_mfma_f32_32x32x16_bf16(pa0, PKLH(l0, h0), od, 0, 0, 0); od = __builtin_amdgcn_mfma_f32_32x32x16_bf16(pa1, PKLH(l1, h1), od, 0, 0, 0);
    od = __builtin_amdgcn_mfma_f32_32x32x16_bf16(pa2, PKLH(l2, h2), od, 0, 0, 0); od = __builtin_amdgcn_mfma_f32_32x32x16_bf16(pa3, PKLH(l3, h3), od, 0, 0, 0);
}
__device__ __forceinline__ void pv_d0(f32x16* o, int vb, bf16x8 pa0, bf16x8 pa1, bf16x8 pa2, bf16x8 pa3) {
    pv_one<0>(o[0], vb, pa0, pa1, pa2, pa3); pv_one<1>(o[1], vb, pa0, pa1, pa2, pa3); pv_one<2>(o[2], vb, pa0, pa1, pa2, pa3); pv_one<3>(o[3], vb, pa0, pa1, pa2, pa3);
}
template <int D0> __device__ __forceinline__ void pv_one32(f32x16& od, int vb, bf16x8 pa0, bf16x8 pa1) {
    const s16x4 l0 = tr_read_i<v_rd_off(D0, 0, 0)>(vb), h0 = tr_read_i<v_rd_off(D0, 0, 1)>(vb), l1 = tr_read_i<v_rd_off(D0, 1, 0)>(vb), h1 = tr_read_i<v_rd_off(D0, 1, 1)>(vb);
    asm volatile("s_waitcnt lgkmcnt(0)" ::: "memory"); SBAR();
    od = __builtin_amdgcn_mfma_f32_32x32x16_bf16(pa0, PKLH(l0, h0), od, 0, 0, 0); od = __builtin_amdgcn_mfma_f32_32x32x16_bf16(pa1, PKLH(l1, h1), od, 0, 0, 0);
}

__device__ __forceinline__ bf16x8 scale8(bf16x8 x, float s) { const v4u w = __builtin_bit_cast(v4u, x); v4u o;
    o.x = cvtpk(bflo(w.x) * s, bfhi(w.x) * s); o.y = cvtpk(bflo(w.y) * s, bfhi(w.y) * s); o.z = cvtpk(bflo(w.z) * s, bfhi(w.z) * s); o.w = cvtpk(bflo(w.w) * s, bfhi(w.w) * s); return __builtin_bit_cast(bf16x8, o); }
constexpr int PR_V = 0, PR_K = 3 * SHM_V, PR_WS = PR_K + 3 * SHM_K, PR_MKL = PR_WS + 2048;
#ifndef PROBE_ATT
#define PROBE_ATT 0
#endif
template <int PM> __device__ __forceinline__ void prompt_unit(Ctx& C, int b, int qblk, int g) {
    int tid = C.tid; asm volatile("" : "+v"(tid));
    const int wid = __builtin_amdgcn_readfirstlane(tid >> 6), lane = tid & 63, r32 = lane & 31, hi = lane >> 5, hh = wid >> 1, qs = wid & 1;
    unsigned selc = 0x7f61b1e6u; asm volatile("" : "+v"(selc));
    const int V_lds = (int)(uintptr_t)C.lds + PR_V, K_lds = (int)(uintptr_t)C.lds + PR_K; LAS float* wsm = (LAS float*)(C.lds + PR_WS) + wid * 64; LAS float* li_l = wsm; LAS float* al_l = wsm + 32;
    const bf16* Q = WSP(bf16, WS_Q); const bf16* Kh = WSP(bf16, WS_KB) + (size_t)b * SEQ * KVW + g * HD; const bf16* Vh = WSP(bf16, WS_VB) + (size_t)b * SEQ * KVW + g * HD;
    const int mq = b * SEQ + 64 * qblk + 32 * qs + r32; const u64* MK = WSP(u64, WS_MASK); const unsigned mo = (unsigned)mq * MASKW;
    float m_reg = -1e30f, l_reg = 0; f32x16 o[4] = {}; bf16x8 qr[8];
    { const unsigned qo = (unsigned)mq * D + (4 * g + hh) * HD + hi * 8;
#pragma unroll
      for (int d0 = 0; d0 < 8; ++d0) qr[d0] = *(const bf16x8*)(Q + (qo + d0 * 16));
      const f32x4 pq = *(const f32x4*)(WSP(float, WS_QSS) + ((size_t)mq * NH + (4 * g + hh)) * 4); const float rq = rsq(((pq.x + pq.y) + (pq.z + pq.w)) * (1.0f / HD) + EPS);
#pragma unroll
      for (int d0 = 0; d0 < 8; ++d0) qr[d0] = scale8(qr[d0], rq); }
    unsigned koff[2], voff[2];
#pragma unroll
    for (int i = 0; i < 2; ++i) { const int s = tid + 512 * i; { const int row = s >> 4, chunk = (s & 15) ^ (row & 7); koff[i] = (unsigned)(row * KVW + chunk * 8); }
        { const int blk = s >> 5, kk = ((blk >> 2) << 3) | ((s & 31) >> 2), k = (kk & ~0xC) | ((kk & 4) << 1) | ((kk & 8) >> 1), c = (blk & 3) * 32 + (s & 3) * 8; voff[i] = (unsigned)(k * KVW + c); } }
    const int vb0 = V_lds + v_rd_base(lane);
#define GLDS(t_) do { const int sl_ = (t_) % 3; const bf16* Kt_ = Kh + (size_t)(t_) * 64 * KVW; const bf16* Vt_ = Vh + (size_t)(t_) * 64 * KVW; _Pragma("unroll") for (int i_ = 0; i_ < 2; ++i_) { \
    __builtin_amdgcn_global_load_lds((const unsigned*)(Kt_ + koff[i_]), (LAS unsigned*)(uintptr_t)(K_lds + sl_ * SHM_K + wid * 1024 + i_ * 8192), 16, 0, 0); \
    __builtin_amdgcn_global_load_lds((const unsigned*)(Vt_ + voff[i_]), (LAS unsigned*)(uintptr_t)(V_lds + sl_ * SHM_V + wid * 1024 + i_ * 8192), 16, 0, 0); } } while (0)
#define STEP_SYNC() do { asm volatile("s_waitcnt vmcnt(0)" ::: "memory"); __builtin_amdgcn_s_barrier(); asm volatile("" ::: "memory"); } while (0)
#define RESC(a) do { if (__any((a) < 1.f)) { if (hi == 0) al_l[r32] = (a); asm volatile("s_waitcnt lgkmcnt(0)" ::: "memory"); \
    _Pragma("unroll") for (int d = 0; d < 4; ++d) _Pragma("unroll") for (int r = 0; r < 16; ++r) o[d][r] *= al_l[crow(r, hi)]; } } while (0)
#define APPLYMASK(P0, P1, MK_) do { if (PM & 1) break; const unsigned w0_ = (unsigned)(MK_) >> (4 * hi), w1_ = (unsigned)((MK_) >> 32) >> (4 * hi); MASK16(P0, w0_); MASK16(P1, w1_); } while (0)
    const int NT = qblk + 1;
    f32x16 p0 = {}, p1 = {}; float mn, al; bf16x8 pa0 = {}, pa1 = {}, pa2 = {}, pa3 = {};
#define BARX() do { asm volatile("" ::: "memory"); __builtin_amdgcn_s_barrier(); asm volatile("" ::: "memory"); } while (0)
#define VM0() asm volatile("s_waitcnt vmcnt(0)" ::: "memory")
#define MBLK(r_) do { if ((r_) < NT) qkt(p0, p1, K_lds + ((r_) % 3) * SHM_K, qr, r32, hi); if ((r_) >= 1) pv_d0(o, vb0 + (((r_) - 1) % 3) * SHM_V, pa0, pa1, pa2, pa3); } while (0)
#define SBLK(r_) do { const u64 mk_ = mkq[(r_)]; APPLYMASK(p0, p1, mk_); partialSM<true>(p0, p1, m_reg, mn, al); finishSM(p0, p1, al, l_reg, pa0, pa1, pa2, pa3); RESC(al); } while (0)
    LAS u64* mkl = (LAS u64*)(C.lds + PR_MKL);
    { const int q_ = tid >> 3, w4_ = (tid & 7) * 4; const u64* src_ = MK + (size_t)(b * SEQ + 64 * qblk + q_) * MASKW + w4_;
      const v4u m0_ = *(const v4u*)src_, m1_ = *(const v4u*)(src_ + 2); *(LAS v4u*)(mkl + q_ * MASKW + w4_) = m0_; *(LAS v4u*)(mkl + q_ * MASKW + w4_ + 2) = m1_; }
    const LAS u64* mkq = mkl + (32 * qs + r32) * MASKW;
    GLDS(0); if (NT > 1) GLDS(1);
    asm volatile("s_waitcnt lgkmcnt(0)" ::: "memory"); VM0(); BARX();
    if (wid < 4) {
        for (int r = 0; r < NT; ++r) {
            if (r >= 1 && r + 1 < NT) { const int t_ = r + 1; GLDS(t_); }
            MBLK(r); BARX();
            SBLK(r); VM0(); BARX();
        }
        MBLK(NT); BARX();
    } else {
        BARX();
        for (int r = 0; r < NT; ++r) {
            MBLK(r); VM0(); BARX();
            if (r + 2 < NT) { const int t_ = r + 2; GLDS(t_); }
            SBLK(r); BARX();
        }
        MBLK(NT);
    }
#undef BARX
#undef VM0
#undef MBLK
#undef SBLK
    if (hi == 0) li_l[r32] = l_reg; asm volatile("s_waitcnt lgkmcnt(0)" ::: "memory");
    __syncthreads();
    { const int ot = (int)(uintptr_t)C.lds + wid * 8704;
#pragma unroll
      for (int r = 0; r < 16; ++r) { const int orow = crow(r, hi); const float rl = __builtin_amdgcn_rcpf(li_l[orow]);
#pragma unroll
          for (int d0 = 0; d0 < 4; ++d0) *(LAS bf16*)(uintptr_t)(ot + orow * 272 + (d0 * 32 + r32) * 2) = (bf16)f2bf(o[d0][r] * rl); }
      asm volatile("s_waitcnt lgkmcnt(0)" ::: "memory");
      const bf16* SZ = WSP(bf16, WS_SZ); bf16* AO = PM ? WSP(bf16, WS_RAW) : WSP(bf16, WS_AO);
#pragma unroll
      for (int e = 0; e < 8; ++e) { const int idx = lane + 64 * e, row = idx >> 4, ch = idx & 15; const unsigned off = (unsigned)(b * SEQ + 64 * qblk + 32 * qs + row) * D + (4 * g + hh) * HD + ch * 8;
          const v4u ov = *(const LAS v4u*)(uintptr_t)(ot + row * 272 + ch * 16), sz = *(const v4u*)(SZ + off); v4u y;
          y.x = cvtpk(bflo(ov.x) * bflo(sz.x), bfhi(ov.x) * bfhi(sz.x)); y.y = cvtpk(bflo(ov.y) * bflo(sz.y), bfhi(ov.y) * bfhi(sz.y));
          y.z = cvtpk(bflo(ov.z) * bflo(sz.z), bfhi(ov.z) * bfhi(sz.z)); y.w = cvtpk(bflo(ov.w) * bflo(sz.w), bfhi(ov.w) * bfhi(sz.w));
          *(v4u*)(AO + off) = y; } }
    __syncthreads();
#undef GLDS
#undef STEP_SYNC
}

constexpr int SU_ROFF = 65536, SU_QB = SU_ROFF + 2112 * 4, SU_CM = SU_QB + 2112, SU_ML = 131072, SU_N = SU_ML + 2048 + 1024, SU_MQ = SU_CM + 8 * 68 * 4, SU_PFX = SU_MQ + 9 * 34 * 8;
__device__ __forceinline__ void sample_unit(Ctx& C, int j, int db, int g) {
    int tid = C.tid; asm volatile("" : "+v"(tid));
    const int wid = __builtin_amdgcn_readfirstlane(tid >> 6), lane = tid & 63, r32 = lane & 31, hi = lane >> 5;
    unsigned selc = 0x7f61b1e6u; asm volatile("" : "+v"(selc));
    LAS unsigned char* lds = C.lds; LAS unsigned* roff = (LAS unsigned*)(lds + SU_ROFF); LAS unsigned char* qb = lds + SU_QB; LAS unsigned* cm = (LAS unsigned*)(lds + SU_CM);
    LAS float* ml = (LAS float*)(lds + SU_ML); LAS int* nUp = (LAS int*)(lds + SU_N);
    const int m0 = TP + db * DSEQ; const u64* mp = WSP(u64, WS_MASK) + (size_t)m0 * MASKW;
    LAS u64* mq = (LAS u64*)(lds + SU_MQ); LAS int* pfx = (LAS int*)(lds + SU_PFX);
    if (lane < 33) mq[wid * 34 + lane] = mp[wid * MASKW + lane];
    __syncthreads();
    if (wid == 0) { u64 uw = 0ull; if (lane < 33) {
#pragma unroll
            for (int t = 0; t < 8; ++t) uw |= mq[t * 34 + lane]; }
        const int cnt = __popcll(uw); int inc = cnt;
#pragma unroll
        for (int o = 1; o < 64; o <<= 1) { const int v = __shfl_up(inc, o); if (lane >= o) inc += v; }
        if (lane < 34) { pfx[lane] = inc - cnt; mq[8 * 34 + lane] = uw; }
        if (lane == 63) nUp[0] = inc; }
    __syncthreads();
    const int nU = nUp[0], nT = (nU + 31) >> 5;
    for (int s = tid; s < 33 * 64; s += 512) { const int i = s >> 6, bt = s & 63; const u64 uw = mq[8 * 34 + i];
        if ((uw >> bt) & 1ull) { const int pos = pfx[i] + __popcll(uw & ((1ull << bt) - 1ull)); unsigned off;
            if (s < SEQ) { const int page = KIN(const int, 5)[db * NPAGES + (s >> 7)]; off = (unsigned)(((page * 2 + j) * PAGE + (s & 127)) * KVW); } else off = 0x80000000u | (unsigned)((s - SEQ) * KVW);
            roff[pos] = off; unsigned qq = 0;
#pragma unroll
            for (int t = 0; t < 8; ++t) qq |= (unsigned)((mq[t * 34 + i] >> bt) & 1ull) << t;
            qb[pos] = (unsigned char)qq; } }
    __syncthreads();
    { const unsigned off0 = roff[0]; for (int c = nU + tid; c < nT * 32; c += 512) { roff[c] = off0; qb[c] = 0; } }
    __syncthreads();
    for (int c0 = wid * 64; c0 < nT * 32; c0 += 512) { const unsigned qq = (c0 + lane < nT * 32) ? qb[c0 + lane] : 0u;
#pragma unroll
        for (int t = 0; t < 8; ++t) { const u64 bw = __ballot((qq >> t) & 1u); if (lane == 0) { cm[t * 68 + (c0 >> 5)] = (unsigned)bw; cm[t * 68 + (c0 >> 5) + 1] = (unsigned)(bw >> 32); } } }
    __syncthreads();
    const float* kc = KIN(const float, 2) + g * HD; const float* vc = KIN(const float, 3) + g * HD;
    const float* kn = C.out + O_KS + (size_t)(db * 2 + j) * DSEQ * KVW + g * HD; const float* vn = C.out + O_VS + (size_t)(db * 2 + j) * DSEQ * KVW + g * HD;
    const int hh = r32 >> 3, t = r32 & 7;
    bf16x8 qr[8]; { const bf16* Qw = WSP(bf16, WS_Q) + (size_t)(m0 + t) * D + (4 * g + hh) * HD + hi * 8;
#pragma unroll
        for (int d0 = 0; d0 < 8; ++d0) qr[d0] = *(const bf16x8*)(Qw + d0 * 16);
        const f32x4 pq = *(const f32x4*)(WSP(float, WS_QSS) + ((size_t)(m0 + t) * NH + (4 * g + hh)) * 4); const float rq = rsq(((pq.x + pq.y) + (pq.z + pq.w)) * (1.0f / HD) + EPS);
#pragma unroll
        for (int d0 = 0; d0 < 8; ++d0) qr[d0] = scale8(qr[d0], rq); }
    const int kt = (int)(uintptr_t)lds + wid * 8192, vt = kt, vbr = vt + v_rd_base(lane); const int cc = lane & 31;
    LAS float* al_l = ml + 512 + wid * 32;
    float m_reg = -1e30f, l_reg = 0.f; f32x16 o[4] = {};
    for (int ti = wid; ti < nT; ti += 8) {
        { f32x4 st[16];
#pragma unroll
          for (int k = 0; k < 16; ++k) { const unsigned ro = roff[ti * 32 + 2 * k + hi]; st[k] = *(const f32x4*)(((ro >> 31) ? kn : kc) + (ro & 0x7fffffffu) + 4 * cc); }
#pragma unroll
          for (int k = 0; k < 16; ++k) { const int i = 2 * k + hi; u32x2v w; w.x = cvtpk(st[k].x, st[k].y); w.y = cvtpk(st[k].z, st[k].w); *(LAS u32x2v*)(uintptr_t)(kt + KSWZ(i, cc * 8)) = w; } }
        f32x4 sv[16];
#pragma unroll
        for (int k = 0; k < 16; ++k) { const unsigned ro = roff[ti * 32 + 2 * k + hi]; sv[k] = *(const f32x4*)(((ro >> 31) ? vn : vc) + (ro & 0x7fffffffu) + 4 * cc); }
        f32x16 p0 = {}, pdummy = {};
#pragma unroll
        for (int d0 = 0; d0 < 8; ++d0) { const bf16x8 kf = *(const LAS bf16x8*)(uintptr_t)(kt + KSWZ(r32, (d0 * 16 + hi * 8) * 2)); p0 = __builtin_amdgcn_mfma_f32_32x32x16_bf16(kf, qr[d0], p0, 0, 0, 0); }
        const unsigned cw = cm[t * 68 + ti] >> (4 * hi); MASK16(p0, cw);
        float mn, alpha; partialSM<false>(p0, pdummy, m_reg, mn, alpha);
        float ps = 0;
#pragma unroll
        for (int r = 0; r < 16; ++r) ps += p0[r];
        { auto rr = __builtin_amdgcn_permlane32_swap(__float_as_uint(ps), __float_as_uint(ps), false, false); ps = __uint_as_float(rr[0]) + __uint_as_float(rr[1]); }
        l_reg = l_reg * alpha + ps;
        bf16x8 pa0, pa1; PK4(p0, 0, pa0); PK4(p0, 8, pa1);
        if (__any(alpha < 1.f)) { if (hi == 0) al_l[r32] = alpha; asm volatile("s_waitcnt lgkmcnt(0)" ::: "memory");
#pragma unroll
            for (int d = 0; d < 4; ++d)
#pragma unroll
                for (int r = 0; r < 16; ++r) o[d][r] *= al_l[crow(r, hi)]; }
        asm volatile("s_waitcnt lgkmcnt(0)" ::: "memory");
#pragma unroll
        for (int k = 0; k < 16; ++k) { const int i = 2 * k + hi; u32x2v w; w.x = cvtpk(sv[k].x, sv[k].y); w.y = cvtpk(sv[k].z, sv[k].w); *(LAS u32x2v*)(uintptr_t)(vt + v_st(i, 4 * cc)) = w; }
        asm volatile("s_waitcnt lgkmcnt(0)" ::: "memory");
        pv_one32<0>(o[0], vbr, pa0, pa1); pv_one32<1>(o[1], vbr, pa0, pa1); pv_one32<2>(o[2], vbr, pa0, pa1); pv_one32<3>(o[3], vbr, pa0, pa1);
    }
    if (hi == 0) { ml[(wid * 32 + r32) * 2] = m_reg; ml[(wid * 32 + r32) * 2 + 1] = l_reg; }
    __syncthreads();
    { constexpr float Cc = SCALE * 1.4426950408889634f;
      float fac[16];
#pragma unroll
      for (int r = 0; r < 16; ++r) { const int row = crow(r, hi); float M = -1e30f;
#pragma unroll
          for (int w = 0; w < 8; ++w) M = fmaxf(M, ml[(w * 32 + row) * 2]);
          float L = 0.f;
#pragma unroll
          for (int w = 0; w < 8; ++w) L += ml[(w * 32 + row) * 2 + 1] * __builtin_amdgcn_exp2f((ml[(w * 32 + row) * 2] - M) * Cc);
          fac[r] = __builtin_amdgcn_exp2f((ml[(wid * 32 + row) * 2] - M) * Cc) * __builtin_amdgcn_rcpf(L); }
      LAS float* part = (LAS float*)lds + wid * 4096;
#pragma unroll
      for (int d0 = 0; d0 < 4; ++d0)
#pragma unroll
          for (int r = 0; r < 16; ++r) part[crow(r, hi) * 128 + d0 * 32 + r32] = o[d0][r] * fac[r]; }
    __syncthreads();
    { const bf16* SZ = WSP(bf16, WS_SZ); bf16* AO = WSP(bf16, WS_AO); const LAS float* part = (const LAS float*)lds;
#pragma unroll
      for (int e = 0; e < 8; ++e) { const int idx = tid + 512 * e, row = idx >> 7, d = idx & 127; float s = 0.f;
#pragma unroll
          for (int w = 0; w < 8; ++w) s += part[w * 4096 + idx];
          const size_t off = (size_t)(m0 + (row & 7)) * D + (4 * g + (row >> 3)) * HD + d; AO[off] = (bf16)f2bf(s * bf2f(SZ[off])); } }
    __syncthreads();
}
#undef RESC
#undef APPLYMASK
}

__device__ __forceinline__ void attn_phase(Ctx& C, int j) {
    const int c = C.bid;
    for (int pass = 0; pass < 2; ++pass) {
        if ((pass == 0) == ((c & 1) == 0)) { for (int u = c; u < DBATCH * NKV; u += C.G) att::sample_unit(C, j, u >> 1, u & 1); }
        else {
            for (int u = c; u < 256; u += C.G) { const int x = u & 7, y = u >> 3, bg = 2 * x + (y >> 4), qp = y & 15;
#pragma clang loop unroll(disable)
                for (int k = 0; k < 2; ++k) att::prompt_unit<0>(C, bg >> 1, k ? 31 - qp : qp, bg & 1); }
#if PROBE_ATT
            for (int u = c; u < 256; u += C.G) { const int x = u & 7, y = u >> 3, bg = 2 * x + (y >> 4), qp = y & 15;
#pragma clang loop unroll(disable)
                for (int k = 0; k < 2; ++k) att::prompt_unit<PROBE_ATT>(C, bg >> 1, k ? 31 - qp : qp, bg & 1); }
#endif
        }
    }
}

template <class F> __device__ __forceinline__ void small_gemm(Ctx& C, const bf16* A, const bf16* Bt, int N, int K, const F& f) {
    int tid = C.tid; asm volatile("" : "+v"(tid));
    const int lane = tid & 63, wave = __builtin_amdgcn_readfirstlane(tid >> 6), fr = lane & 15, fq = lane >> 4;
    LAS float* part = (LAS float*)C.lds;
    const int ntn = N / 64, ntiles = (TS / 64) * ntn, kw = K / 8;
#ifdef NO_SMALL
    if (true) return;
#endif
    for (int tile = C.bid; tile < ntiles; tile += C.G) {
        const int tm = tile / ntn, tn = tile - tm * ntn;
        f32x4 acc[4][4];
#pragma unroll
        for (int m = 0; m < 4; ++m)
#pragma unroll
            for (int n = 0; n < 4; ++n) acc[m][n] = (f32x4){0.f, 0.f, 0.f, 0.f};
        const bf16* ap = A + (size_t)(TP + 64 * tm + fr) * K + wave * kw + 8 * fq; const bf16* bp = Bt + (size_t)(64 * tn + fr) * K + wave * kw + 8 * fq;
        for (int kc = 0; kc < kw; kc += 128) { bf16x8 af[4][4], bfr[4][4];
#pragma unroll
            for (int q = 0; q < 4; ++q) if (kc + 32 * q < kw) {
#pragma unroll
                for (int m = 0; m < 4; ++m) { af[q][m] = *(const bf16x8*)(ap + (size_t)(16 * m) * K + kc + 32 * q); bfr[q][m] = *(const bf16x8*)(bp + (size_t)(16 * m) * K + kc + 32 * q); } }
#pragma unroll
            for (int q = 0; q < 4; ++q) if (kc + 32 * q < kw) {
#pragma unroll
                for (int m = 0; m < 4; ++m)
#pragma unroll
                    for (int n = 0; n < 4; ++n) acc[m][n] = __builtin_amdgcn_mfma_f32_16x16x32_bf16(bfr[q][n], af[q][m], acc[m][n], 0, 0, 0); } }
#pragma unroll
        for (int m = 0; m < 4; ++m)
#pragma unroll
            for (int n = 0; n < 4; ++n)
                *(LAS f32x4*)(part + (wave * 64 + 16 * m + fr) * 68 + 16 * n + 4 * fq) = acc[m][n];
        __syncthreads();
        { const int row = tid >> 3, c8 = (tid & 7) * 8; f32x4 s0 = {0.f, 0.f, 0.f, 0.f}, s1 = s0;
#pragma unroll
          for (int w = 0; w < 8; ++w) { s0 += *(const LAS f32x4*)(part + (w * 64 + row) * 68 + c8); s1 += *(const LAS f32x4*)(part + (w * 64 + row) * 68 + c8 + 4); }
          f(TP + 64 * tm + row, 64 * tn + c8, s0, s1, tid); }
        __syncthreads();
    }
}
__device__ __forceinline__ float sq8(const f32x4& a, const f32x4& b) { return (a.x * a.x + a.y * a.y) + (a.z * a.z + a.w * a.w) + (b.x * b.x + b.y * b.y) + (b.z * b.z + b.w * b.w); }
__device__ __forceinline__ v4u pack8(const f32x4& a, const f32x4& b) { v4u w; w.x = cvtpk(a.x, a.y); w.y = cvtpk(a.z, a.w); w.z = cvtpk(b.x, b.y); w.w = cvtpk(b.z, b.w); return w; }
__device__ __forceinline__ float sum8lanes(float q) { q += __shfl_xor(q, 1); q += __shfl_xor(q, 2); q += __shfl_xor(q, 4); return q; }
struct SEpiBf16 { bf16* O; int ldc;
    __device__ __forceinline__ void operator()(int row, int col, const f32x4& a, const f32x4& b, int) const { *(v4u*)(O + (size_t)row * ldc + col) = pack8(a, b); } };
struct SEpiRes { const float* xf; const bf16* xbin; bf16* x1b; float* ss1;
    __device__ __forceinline__ void operator()(int row, int col, const f32x4& sa, const f32x4& sb, int tid) const { const size_t off = (size_t)row * D + col;
        f32x4 a, b; ld8f(xf, xbin, off, a, b); a += sa; b += sb;
        *(v4u*)(x1b + off) = pack8(a, b);
        const float q = sum8lanes(sq8(a, b)); if ((tid & 7) == 0) ss1[(size_t)row * 16 + (col >> 6)] = q; } };
struct SEpiGate { const float* ss1; const bf16* x1b; const bf16* pe; float* xout; bf16* xb; float* ssx;
    __device__ __forceinline__ void operator()(int row, int col, const f32x4& sa, const f32x4& sb, int tid) const { const size_t off = (size_t)row * D + col; const float r1 = row_r16(ss1, row, 1.0f / D);
        const v4u pw = *(const v4u*)(pe + off); f32x4 xa, xc; ld8f(nullptr, x1b, off, xa, xc); const f32x4 ga = sa * r1, gb = sb * r1; f32x4 a, b;
        a.x = xa.x + sigm(ga.x) * bflo(pw.x); a.y = xa.y + sigm(ga.y) * bfhi(pw.x); a.z = xa.z + sigm(ga.z) * bflo(pw.y); a.w = xa.w + sigm(ga.w) * bfhi(pw.y);
        b.x = xc.x + sigm(gb.x) * bflo(pw.z); b.y = xc.y + sigm(gb.y) * bfhi(pw.z); b.z = xc.z + sigm(gb.z) * bflo(pw.w); b.w = xc.w + sigm(gb.w) * bfhi(pw.w);
        if (xout) { *(f32x4*)(xout + off) = a; *(f32x4*)(xout + off + 4) = b; } *(v4u*)(xb + off) = pack8(a, b);
        const float q = sum8lanes(sq8(a, b)); if ((tid & 7) == 0) ssx[(size_t)row * 16 + (col >> 6)] = q; } };
#ifndef ONLY_PHASE
#define PHASE_ON(k) true
#else
#define PHASE_ON(k) ((k) == ONLY_PHASE)
#endif
#define IN(k) (PHASE_ON(k) && lo <= (k) && (k) < hi)
#ifndef DUP_PHASE
#define DUP_PHASE (-1)
#endif
#define RUN(k, ...) do { if (IN(k)) { __VA_ARGS__; if ((k) == DUP_PHASE) { xcd_barrier(bar); __VA_ARGS__; } } } while (0)
#ifndef SEAM_REPS
#define SEAM_REPS 1
#endif
#define SEAM(k) do { if (lo <= (k) && (k) + 1 < hi) { for (int r_ = 0; r_ < SEAM_REPS; ++r_) xcd_barrier(bar); } } while (0)
template <int jj> __device__ __forceinline__ void layer_pair(Ctx& C, const XcdBarrier& bar, const int lo, const int hi) {
    LAS unsigned char* ring = C.lds;
        const int ia = 2 * jj, ib = 2 * jj + 1, pb = 1 + 9 * jj;
        RUN(pb, { pg8::Gemm g{WSP(bf16, WS_XB0), WSP(bf16, WS_WINA + jj * SZ_WINA), T, NA_IN, D}; pg8::StaticOrder S; S.init(T, NA_IN, C.G, C.bid);
            EpiA1 E{WSP(float, WS_SSX), WSP(bf16, WS_UZ), WSP(bf16, WS_VR), WSP(float, WS_VSS)}; pg8::gemm_phase<EpiA1, pg8::StaticOrder, true, true>(ring, g, S, E);
            if (jj == 0 && C.G == 256 && C.bid >= 96) prologue_part(C, 1, true, (C.bid - 96) * 8 + C.wave, 160 * 8); });
#ifdef PROBE_PLAIN_A1
        if (IN(pb)) { xcd_barrier(bar); pg8::Gemm g{WSP(bf16, WS_XB0), WSP(bf16, WS_WINA + jj * SZ_WINA), T, NA_IN, D}; pg8::StaticOrder S; S.init(T, NA_IN, C.G, C.bid);
#if PROBE_PLAIN_A1 == 2
            EpiNull E{WSP(float, WS_RAW)}; pg8::gemm_phase<EpiNull, pg8::StaticOrder, true, true>(ring, g, S, E); }
#else
            EpiBf16S E{WSP(bf16, WS_RAW), NA_IN}; pg8::gemm_phase<EpiBf16S, pg8::StaticOrder, true, true>(ring, g, S, E); }
#endif
#endif
        SEAM(pb);
        RUN(pb + 1, gate_phase(C, jj));
        SEAM(pb + 1);
        RUN(pb + 2, {
            { pg8::Gemm g{WSP(bf16, WS_Y), WSP(bf16, WS_WOUTA + jj * SZ_WOUTA), TP, D, AW}; pg8::StaticOrder S; S.init(TP, D, C.G, C.bid);
              EpiRes<jj == 0> E{KIN(const float, 0), WSP(bf16, WS_XB0), WSP(bf16, WS_XB1), WSP(float, WS_SS1)};
              pg8::gemm_phase<EpiRes<jj == 0>, pg8::StaticOrder, true, true>(ring, g, S, E); }
            { SEpiRes E{jj == 0 ? KIN(const float, 1) - (size_t)TP * D : nullptr, WSP(bf16, WS_XB0), WSP(bf16, WS_XB1), WSP(float, WS_SS1)};
              small_gemm(C, WSP(bf16, WS_Y), WSP(bf16, WS_WOUTA + jj * SZ_WOUTA), D, AW, E); }
            { pg8::Gemm g{WSP(bf16, WS_PB + ia * SZ_PB), WSP(bf16, WS_WPE + ia * SZ_WPE), TP, D, PD}; pg8::StaticOrder S; S.init(TP, D, C.G, C.bid);
              EpiBf16S E{WSP(bf16, WS_PE), D}; pg8::gemm_phase<EpiBf16S, pg8::StaticOrder, true, true>(ring, g, S, E); }
            { SEpiBf16 E{WSP(bf16, WS_PE), D}; small_gemm(C, WSP(bf16, WS_PB + ia * SZ_PB), WSP(bf16, WS_WPE + ia * SZ_WPE), D, PD, E); } });
        SEAM(pb + 2);
        RUN(pb + 3, { { pg8::Gemm g{WSP(bf16, WS_XB1), WSP(bf16, WS_WGATE + ia * SZ_WSQ), TP, D, D}; pg8::StaticOrder S; S.init(TP, D, C.G, C.bid);
            EpiGate E{WSP(float, WS_SS1), WSP(bf16, WS_XB1), WSP(bf16, WS_PE), nullptr, WSP(bf16, WS_XB0), WSP(float, WS_SSX)}; pg8::gemm_phase<EpiGate, pg8::StaticOrder, true, true>(ring, g, S, E); }
            { SEpiGate E{WSP(float, WS_SS1), WSP(bf16, WS_XB1), WSP(bf16, WS_PE), nullptr, WSP(bf16, WS_XB0), WSP(float, WS_SSX)}; small_gemm(C, WSP(bf16, WS_XB1), WSP(bf16, WS_WGATE + ia * SZ_WSQ), D, D, E); } });
        SEAM(pb + 3);
        RUN(pb + 4, { pg8::Gemm g{WSP(bf16, WS_XB0), WSP(bf16, WS_WINB + jj * SZ_WINB), T, NB_IN, D}; pg8::StaticOrder S; S.init(T, NB_IN, C.G, C.bid);
            EpiB1 E{C.ws, KIN(const float, 15) + jj * HD, KIN(const float, 16) + jj * HD, KIN(const float, 17) + jj * IDXD, C.out, jj, (LAS float*)(C.lds + 131072)};
            pg8::gemm_phase<EpiB1, pg8::StaticOrder, true, true>(ring, g, S, E);
            if (jj == 0 && C.G == 256 && C.bid >= 116) prologue_part(C, 2, true, (C.bid - 116) * 8 + C.wave, 140 * 8); });
#ifdef PROBE_PLAIN_B1
        if (IN(pb + 4)) { xcd_barrier(bar); pg8::Gemm g{WSP(bf16, WS_XB0), WSP(bf16, WS_WINB + jj * SZ_WINB), T, NB_IN, D}; pg8::StaticOrder S; S.init(T, NB_IN, C.G, C.bid);
            EpiBf16S E{WSP(bf16, WS_RAW), NB_IN}; pg8::gemm_phase<EpiBf16S, pg8::StaticOrder, true, true>(ring, g, S, E); }
#endif
        SEAM(pb + 4);
        RUN(pb + 5, idx_phase(C, jj));
        SEAM(pb + 5);
        RUN(pb + 6, attn_phase(C, jj));
        SEAM(pb + 6);
        RUN(pb + 7, {
            { pg8::Gemm g{WSP(bf16, WS_AO), WSP(bf16, WS_WOUTB + jj * SZ_WSQ), TP, D, D}; pg8::StaticOrder S; S.init(TP, D, C.G, C.bid);
              EpiRes<false> E{nullptr, WSP(bf16, WS_XB0), WSP(bf16, WS_XB1), WSP(float, WS_SS1)};
              pg8::gemm_phase<EpiRes<false>, pg8::StaticOrder, true, true>(ring, g, S, E); }
            { SEpiRes E{nullptr, WSP(bf16, WS_XB0), WSP(bf16, WS_XB1), WSP(float, WS_SS1)}; small_gemm(C, WSP(bf16, WS_AO), WSP(bf16, WS_WOUTB + jj * SZ_WSQ), D, D, E); }
            { pg8::Gemm g{WSP(bf16, WS_PB + ib * SZ_PB), WSP(bf16, WS_WPE + ib * SZ_WPE), TP, D, PD}; pg8::StaticOrder S; S.init(TP, D, C.G, C.bid);
              EpiBf16S E{WSP(bf16, WS_PE), D}; pg8::gemm_phase<EpiBf16S, pg8::StaticOrder, true, true>(ring, g, S, E); }
            { SEpiBf16 E{WSP(bf16, WS_PE), D}; small_gemm(C, WSP(bf16, WS_PB + ib * SZ_PB), WSP(bf16, WS_WPE + ib * SZ_WPE), D, PD, E); } });
        SEAM(pb + 7);
        RUN(pb + 8, { { pg8::Gemm g{WSP(bf16, WS_XB1), WSP(bf16, WS_WGATE + ib * SZ_WSQ), TP, D, D}; pg8::StaticOrder S; S.init(TP, D, C.G, C.bid);
            EpiGate E{WSP(float, WS_SS1), WSP(bf16, WS_XB1), WSP(bf16, WS_PE), jj == 1 ? C.out + O_Y : nullptr, WSP(bf16, WS_XB0), WSP(float, WS_SSX)}; pg8::gemm_phase<EpiGate, pg8::StaticOrder, true, true>(ring, g, S, E); }
            { SEpiGate E{WSP(float, WS_SS1), WSP(bf16, WS_XB1), WSP(bf16, WS_PE), jj == 1 ? C.out + O_Y : nullptr, WSP(bf16, WS_XB0), WSP(float, WS_SSX)}; small_gemm(C, WSP(bf16, WS_XB1), WSP(bf16, WS_WGATE + ib * SZ_WSQ), D, D, E); } });
        SEAM(pb + 8);
    }
constexpr int N_PHASES = 19;
__global__ void __launch_bounds__(512, 2) fwd(Args args) {
    extern __shared__ __attribute__((aligned(16))) unsigned char lds_raw[];
    Ctx C; C.lds = (LAS unsigned char*)lds_raw; C.tid = threadIdx.x; C.lane = C.tid & 63; C.wave = __builtin_amdgcn_readfirstlane(C.tid >> 6); C.G = gridDim.x; C.bid = blockIdx.x;
    C.out = args.out; C.ws = args.ws;
    volatile LAS unsigned* MISC = (volatile LAS unsigned*)(C.lds + MISC_OFF);
    if (C.tid < 64) MISC[C.tid] = 0u;
    __syncthreads();
    const int lo = args.ph_lo, hi = args.ph_hi;
    XcdBarrier bar; bar.bar = (unsigned*)(C.ws + WS_CTL) + CW_BAR; bar.x = 0; bar.st = nullptr;
    if (hi - lo > 1) bar = xcd_barrier_post((unsigned*)(C.ws + WS_CTL) + CW_BAR, MISC + 8);
    LAS unsigned char* ring = C.lds;
    RUN(0, prologue_part(C, 0, C.G == 256, C.bid * 8 + C.wave, C.G * 8));
    SEAM(0);
    layer_pair<0>(C, bar, lo, hi);
    layer_pair<1>(C, bar, lo, hi);
#undef IN
#undef SEAM
}

#ifndef MK_FUSED
#define MK_FUSED 1
#endif
extern "C" void kernel_launch(void* const* d_in, const int* in_sizes, int n_in, void* d_out, int out_size, void* d_ws, size_t ws_size, hipStream_t stream) {
    static int grid = 0;
    if (grid == 0) {
        if (n_in != 22 || out_size != (int)O_END || ws_size < WS_END) { fprintf(stderr, "kernel_launch: shape mismatch n_in %d out %d ws %zu (need %zu)\n", n_in, out_size, ws_size, (size_t)WS_END); grid = -1; return; }
        int dev = 0, cus = 0, per_cu = 0;
        if (hipGetDevice(&dev) != hipSuccess || hipDeviceGetAttribute(&cus, hipDeviceAttributeMultiprocessorCount, dev) != hipSuccess) { grid = -1; return; }
        if (hipFuncSetAttribute((const void*)fwd, hipFuncAttributeMaxDynamicSharedMemorySize, LDS_BYTES) != hipSuccess) { fprintf(stderr, "kernel_launch: hipFuncSetAttribute failed\n"); grid = -1; return; }
        if (hipOccupancyMaxActiveBlocksPerMultiprocessor(&per_cu, (const void*)fwd, 512, LDS_BYTES) != hipSuccess || per_cu < 1) fprintf(stderr, "kernel_launch: occupancy query says %d\n", per_cu);
        (void)hipGetLastError();
        grid = cus;
    }
    if (grid < 0) return;
    if (hipMemsetAsync((char*)d_ws + WS_CTL, 0, CTL_BYTES, stream) != hipSuccess) return;
    Args a{};
    for (int i = 0; i < 22; ++i) a.in[i] = d_in[i];
    a.out = (float*)d_out; a.ws = (unsigned char*)d_ws;
#if MK_FUSED
    a.ph_lo = 0; a.ph_hi = N_PHASES;
    hipLaunchKernelGGL(fwd, dim3(grid), dim3(512), LDS_BYTES, stream, a);
#else
    for (int p = 0; p < N_PHASES; ++p) { a.ph_lo = p; a.ph_hi = p + 1; hipLaunchKernelGGL(fwd, dim3(grid), dim3(512), LDS_BYTES, stream, a); }
#endif
    const hipError_t le = hipPeekAtLastError();
    if (le != hipSuccess) fprintf(stderr, "kernel_launch: launch failed: %s\n", hipGetErrorName(le));
}
```

```cpp
#include <hip/hip_runtime.h>
#include <cstdio>
#include <cstdint>
namespace pg8 {
#define PG8_LAS __attribute__((address_space(3)))
typedef unsigned short bf16_t;
typedef short bf16x8 __attribute__((ext_vector_type(8)));
typedef float f32x4 __attribute__((ext_vector_type(4)));
typedef unsigned u32x4 __attribute__((ext_vector_type(4)));
constexpr int BM = 256, BK = 64, HALF = 128, HTB = HALF * BK * 2  , STAGE_BYTES = 8 * HTB, NXCD = 8, WGM = 4;

__host__ __device__ __forceinline__ int lds_byte(int r, int c) { const int st = (r >> 4) * 2 + (c >> 5), rr = r & 15, cc = c & 31, ob = rr * 64 + cc * 2; return st * 1024 + (ob ^ (((ob >> 9) & 1) << 5)); }
__host__ __device__ __forceinline__ void stage_rc(int b, int& R, int& C) { const int st = b / 1024, sb = b % 1024, swz = sb ^ (((sb >> 9) & 1) << 5); R = (st >> 1) * 16 + swz / 64; C = (st & 1) * 32 + (swz % 64) / 2; }
__host__ __device__ __forceinline__ int perm32(int rho) { const int n = rho >> 4, i = rho & 15; return 8 * (i >> 2) + 4 * n + (i & 3); }

struct Unit { int pm, pn; };
struct Gemm { const bf16_t* A; const bf16_t* Bt; int M, N, K; };

struct StaticOrder {
    int nM, nN, nwg, G, c;
    __host__ __device__ void init(int M, int N, int G_, int c_) { nM = M / BM; nN = N / BM; nwg = nM * nN; G = G_; c = c_; }
    __host__ __device__ bool next(int i, Unit& u) const {
        const long L = (long)i * G + c; if (L >= nwg) return false;
        int wgid = (int)L; { const int q = nwg / NXCD, r = nwg % NXCD, xcd = wgid % NXCD, off = wgid / NXCD; wgid = (xcd < r ? xcd * (q + 1) : r * (q + 1) + (xcd - r) * q) + off; }
        const int nig = WGM * nN, gid = wgid / nig, fm = gid * WGM, gsz = (nM - fm) < WGM ? (nM - fm) : WGM;
        u.pm = fm + ((wgid % nig) % gsz); u.pn = (wgid % nig) / gsz; return true;
    }
    __device__ __forceinline__ void a_ready(const Unit&) const {}
    __device__ __forceinline__ void done(const Unit&) const {}
};
__device__ __forceinline__ unsigned cvt_pk_bf16(float lo, float hi) { unsigned r; asm volatile("v_cvt_pk_bf16_f32 %0, %1, %2" : "=v"(r) : "v"(lo), "v"(hi)); return r; }
typedef float f32x2 __attribute__((ext_vector_type(2)));
template <class Epi, class Sched, bool ALIGN_EPI = false, bool SP2 = false>
__device__ __forceinline__ void gemm_phase(PG8_LAS unsigned char* lds, const Gemm g, const Sched& S, const Epi& E) {
    const int tid = threadIdx.x, wid = __builtin_amdgcn_readfirstlane(tid >> 6), lane = tid & 63, wr = wid >> 2, wc = wid & 3, fr = lane & 15, fq = lane >> 4;
    const int K = g.K, nt = K / BK;
    unsigned voffA[2], voffB[2];
#pragma unroll
    for (int i = 0; i < 2; ++i) { int R, C; stage_rc(tid * 16 + i * 8192, R, C); const int Rb = Epi::PERM ? ((R & ~31) + perm32(R & 31)) : R;
        voffA[i] = (unsigned)(R * K + C) * 2u; voffB[i] = (unsigned)(Rb * K + C) * 2u; }
    const size_t kstep = (size_t)(BK * 2);
    const size_t hstep = (size_t)HALF * K * 2;
    const size_t tstep = 2 * hstep;
    const unsigned ldsw = (unsigned)wid * 1024u;
    const int aoff = lds_byte(wr * 64 + fr, fq * 8), boff = lds_byte(wc * 32 + fr, fq * 8);
#define PG8_SA(b, h) (((b) * 2 + (h)) * HTB)
#define PG8_SB(b, h) ((4 + (b) * 2 + (h)) * HTB)
#define PG8_STAGE(bufoff, gbase, voff) do { _Pragma("unroll") for (int _i = 0; _i < 2; ++_i) \
        __builtin_amdgcn_global_load_lds((const unsigned*)((const char*)(gbase) + (voff)[_i]), (PG8_LAS unsigned*)(lds + (bufoff) + ldsw + _i * 8192), 16, 0, 0); } while (0)
#define PG8_LDA(dst, b, h) do { _Pragma("unroll") for (int m = 0; m < 4; ++m) _Pragma("unroll") for (int k = 0; k < 2; ++k) dst[m][k] = *(const PG8_LAS bf16x8*)(lds + PG8_SA(b, h) + aoff + m * 2048 + k * 1024); } while (0)
#define PG8_LDB(dst, b, h) do { _Pragma("unroll") for (int n = 0; n < 2; ++n) _Pragma("unroll") for (int k = 0; k < 2; ++k) dst[n][k] = *(const PG8_LAS bf16x8*)(lds + PG8_SB(b, h) + boff + n * 2048 + k * 1024); } while (0)
#define PG8_MMA(ai, bj, At, Bt) do { __builtin_amdgcn_s_setprio(1); _Pragma("unroll") for (int m = 0; m < 4; ++m) _Pragma("unroll") for (int n = 0; n < 2; ++n) _Pragma("unroll") for (int k = 0; k < 2; ++k) \
        acc[ai][bj][m][n] = __builtin_amdgcn_mfma_f32_16x16x32_bf16(Bt[n][k], At[m][k], acc[ai][bj][m][n], 0, 0, 0); __builtin_amdgcn_s_setprio(0); } while (0)
#define PG8_WAIT_V(n) asm volatile("s_waitcnt vmcnt(" #n ")" ::: "memory")
#define PG8_WAIT_L(n) asm volatile("s_waitcnt lgkmcnt(" #n ")" ::: "memory")
#define PG8_BAR __builtin_amdgcn_s_barrier()
#define PG8_SCHED __builtin_amdgcn_sched_barrier(0)
    Unit cur, nxt; int ui = 0;
    if (!S.next(0, cur)) return;
    f32x4 acc[2][2][4][2];
#pragma unroll
    for (int a = 0; a < 2; ++a)
#pragma unroll
        for (int b = 0; b < 2; ++b)
#pragma unroll
            for (int m = 0; m < 4; ++m)
#pragma unroll
                for (int n = 0; n < 2; ++n) acc[a][b][m][n] = (f32x4){0.f, 0.f, 0.f, 0.f};
    bf16x8 At[4][2], B0[2][2], B1[2][2];
    const char* cA = (const char*)g.A + (size_t)cur.pm * tstep; const char* cB = (const char*)g.Bt + (size_t)cur.pn * tstep;
    S.a_ready(cur);
    if constexpr (SP2) {
        PG8_STAGE(PG8_SB(0, 0), cB, voffB); PG8_STAGE(PG8_SB(0, 1), cB + hstep, voffB); PG8_STAGE(PG8_SA(0, 0), cA, voffA); PG8_STAGE(PG8_SA(0, 1), cA + hstep, voffA);
        if (wr == 1) PG8_BAR;
        PG8_WAIT_V(2); PG8_BAR;
        PG8_STAGE(PG8_SB(1, 0), cB + kstep, voffB); PG8_STAGE(PG8_SA(1, 0), cA + kstep, voffA); PG8_STAGE(PG8_SB(1, 1), cB + hstep + kstep, voffB);
        PG8_WAIT_V(6); PG8_BAR;
    } else {
        PG8_STAGE(PG8_SB(0, 0), cB, voffB); PG8_STAGE(PG8_SA(0, 0), cA, voffA); PG8_STAGE(PG8_SB(0, 1), cB + hstep, voffB); PG8_STAGE(PG8_SA(0, 1), cA + hstep, voffA);
        if (wr == 1) PG8_BAR;
        PG8_WAIT_V(4); PG8_BAR;
        PG8_STAGE(PG8_SB(1, 0), cB + kstep, voffB); PG8_STAGE(PG8_SA(1, 0), cA + kstep, voffA); PG8_STAGE(PG8_SB(1, 1), cB + hstep + kstep, voffB);
        PG8_WAIT_V(6); PG8_BAR;
    }
    for (;;) {
        const bool has_next = S.next(ui + 1, nxt);
        const char* nA = has_next ? (const char*)g.A + (size_t)nxt.pm * tstep : cA; const char* nB = has_next ? (const char*)g.Bt + (size_t)nxt.pn * tstep : cB;
#pragma clang loop unroll(disable)
        for (int t = 0; t < nt; t += 2) {
            const bool last = (t == nt - 2);
            const char* a1 = cA + (size_t)(t + 1) * kstep;
            const char* a2 = last ? nA : cA + (size_t)(t + 2) * kstep; const char* b2 = last ? nB : cB + (size_t)(t + 2) * kstep;
            const char* a3 = a2 + kstep; const char* b3 = b2 + kstep;
            if (last && has_next) S.a_ready(nxt);
            if constexpr (SP2) {
            PG8_LDB(B0, 0, 0); PG8_LDB(B1, 0, 1); PG8_SCHED; PG8_LDA(At, 0, 0); PG8_STAGE(PG8_SA(1, 1), a1 + hstep, voffA);
            PG8_WAIT_V(8); PG8_WAIT_L(0); PG8_BAR; PG8_MMA(0, 0, At, B0); PG8_MMA(0, 1, At, B1); PG8_BAR; PG8_SCHED;
            PG8_LDA(At, 0, 1); PG8_STAGE(PG8_SB(0, 0), b2, voffB); PG8_STAGE(PG8_SB(0, 1), b2 + hstep, voffB); PG8_STAGE(PG8_SA(0, 0), a2, voffA);
            PG8_WAIT_V(8); PG8_WAIT_L(0); PG8_BAR; PG8_MMA(1, 0, At, B0); PG8_MMA(1, 1, At, B1); PG8_BAR; PG8_SCHED;
            PG8_LDB(B0, 1, 0); PG8_LDB(B1, 1, 1); PG8_SCHED; PG8_LDA(At, 1, 0); PG8_STAGE(PG8_SA(0, 1), a2 + hstep, voffA);
            PG8_WAIT_V(8); PG8_WAIT_L(0); PG8_BAR; PG8_MMA(0, 0, At, B0); PG8_MMA(0, 1, At, B1); PG8_BAR; PG8_SCHED;
            PG8_LDA(At, 1, 1); PG8_STAGE(PG8_SB(1, 0), b3, voffB); PG8_STAGE(PG8_SB(1, 1), b3 + hstep, voffB); PG8_STAGE(PG8_SA(1, 0), a3, voffA);
            PG8_WAIT_V(8); PG8_WAIT_L(0); PG8_BAR; PG8_MMA(1, 0, At, B0); PG8_MMA(1, 1, At, B1); PG8_BAR; PG8_SCHED;
            } else {
            PG8_LDB(B0, 0, 0); PG8_SCHED; PG8_LDA(At, 0, 0); PG8_STAGE(PG8_SA(1, 1), a1 + hstep, voffA);
            PG8_WAIT_L(8); PG8_BAR; PG8_WAIT_L(0); PG8_MMA(0, 0, At, B0); PG8_BAR; PG8_SCHED;
            PG8_LDB(B1, 0, 1); PG8_STAGE(PG8_SB(0, 0), b2, voffB);
            PG8_BAR; PG8_WAIT_L(0); PG8_MMA(0, 1, At, B1); PG8_BAR;
            PG8_LDA(At, 0, 1); PG8_STAGE(PG8_SA(0, 0), a2, voffA);
            PG8_BAR; PG8_WAIT_L(0); PG8_MMA(1, 0, At, B0); PG8_BAR; PG8_SCHED;
            PG8_STAGE(PG8_SB(0, 1), b2 + hstep, voffB);
            PG8_WAIT_V(6); PG8_BAR; PG8_MMA(1, 1, At, B1); PG8_BAR;
            PG8_LDB(B0, 1, 0); PG8_SCHED; PG8_LDA(At, 1, 0); PG8_STAGE(PG8_SA(0, 1), a2 + hstep, voffA);
            PG8_WAIT_L(8); PG8_BAR; PG8_WAIT_L(0); PG8_MMA(0, 0, At, B0); PG8_BAR; PG8_SCHED;
            PG8_LDB(B1, 1, 1); PG8_STAGE(PG8_SB(1, 0), b3, voffB);
            PG8_BAR; PG8_WAIT_L(0); PG8_MMA(0, 1, At, B1); PG8_BAR;
            PG8_LDA(At, 1, 1); PG8_STAGE(PG8_SA(1, 0), a3, voffA);
            PG8_BAR; PG8_WAIT_L(0); PG8_MMA(1, 0, At, B0); PG8_BAR; PG8_SCHED;
            PG8_STAGE(PG8_SB(1, 1), b3 + hstep, voffB);
            PG8_WAIT_V(6); PG8_BAR; PG8_MMA(1, 1, At, B1); PG8_BAR;
            }
        }
        if constexpr (ALIGN_EPI) { if (wr == 0) PG8_BAR; }
        if constexpr (!Epi::AFTER_DRAIN) { E(acc, cur, wr, wc, fr, fq); S.done(cur); }
        if (!has_next) break;
#pragma unroll
        for (int a = 0; a < 2; ++a)
#pragma unroll
            for (int b = 0; b < 2; ++b)
#pragma unroll
                for (int m = 0; m < 4; ++m)
#pragma unroll
                    for (int n = 0; n < 2; ++n) acc[a][b][m][n] = (f32x4){0.f, 0.f, 0.f, 0.f};
        cur = nxt; cA = nA; cB = nB; ++ui;
        if constexpr (ALIGN_EPI) { if (wr == 1) PG8_BAR; }
    }
    PG8_WAIT_V(0);
    if constexpr (!ALIGN_EPI) { if (wr == 0) PG8_BAR; }
    PG8_BAR;
    if constexpr (Epi::AFTER_DRAIN) { E.fused(acc, cur, wr, wc, fr, fq, lds, wid, lane); S.done(cur); }
#undef PG8_SA
#undef PG8_SB
#undef PG8_STAGE
#undef PG8_LDA
#undef PG8_LDB
#undef PG8_MMA
#undef PG8_WAIT_V
#undef PG8_WAIT_L
#undef PG8_BAR
#undef PG8_SCHED
}
}
#define GAS __attribute__((address_space(1)))
#define LAS __attribute__((address_space(3)))
typedef unsigned short bf16;
typedef unsigned v4u __attribute__((ext_vector_type(4)));
typedef float f32x4 __attribute__((ext_vector_type(4)));
typedef short bf16x8 __attribute__((ext_vector_type(8)));
typedef GAS unsigned gu32;
typedef GAS unsigned long long gu64;
#define RLX_AGENT __ATOMIC_RELAXED, __HIP_MEMORY_SCOPE_AGENT
#define LDS_WAIT() asm volatile("s_waitcnt lgkmcnt(0)" ::: "memory")
#define VM_WAIT() asm volatile("s_waitcnt vmcnt(0)" ::: "memory")
__device__ __forceinline__ unsigned long long rt() { return __builtin_amdgcn_s_memrealtime(); }
__device__ __forceinline__ unsigned f2bf(float f) { unsigned u = __builtin_bit_cast(unsigned, f); return (u + 0x7fffu + ((u >> 16) & 1u)) >> 16; }
__device__ __forceinline__ unsigned pk2(float lo, float hi) { return f2bf(lo) | (f2bf(hi) << 16); }

#define XB_TMO      128
#define XB_XCNT(j)  (256  + 64 * (j))
#define XB_XSUB(j)  (1280 + 64 * (j))
#define XB_XGEN(j)  (2304 + 64 * (j))
#define XB_TOP      3328
#define XB_TOPGEN   3392
#define XCD_BAR_WORDS 3456
#define XB_SPIN_CAP (1u << 18)

__device__ __forceinline__ unsigned xb_ld(unsigned* p)              { return __hip_atomic_load(p, __ATOMIC_RELAXED, __HIP_MEMORY_SCOPE_AGENT); }
__device__ __forceinline__ unsigned xb_add(unsigned* p, unsigned v) { return __hip_atomic_fetch_add(p, v, __ATOMIC_RELAXED, __HIP_MEMORY_SCOPE_AGENT); }
__device__ __forceinline__ unsigned xb_xcc_id() { return (unsigned)__builtin_amdgcn_s_getreg((3 << 11) | 20) & 0xFu; }
#define XB_SPIN(cond, bar) do { unsigned _sp = 0; while (cond) { __builtin_amdgcn_s_sleep(1); \
    if ((++_sp & 255u) == 0u) { if (xb_ld(&(bar)[XB_TMO])) break; if (_sp > XB_SPIN_CAP) { atomicAdd(&(bar)[XB_TMO], 1u); break; } } } } while (0)

struct XcdBarrier {
    unsigned* bar; unsigned x;
    volatile LAS unsigned* st;
};

__device__ __forceinline__ XcdBarrier xcd_barrier_post(unsigned* bar, volatile LAS unsigned* st) {
    XcdBarrier b; b.bar = bar; b.x = xb_xcc_id(); b.st = st;
    if (threadIdx.x == 0) (void)xb_add(&bar[XB_XCNT(b.x)], 1u);
    return b;
}
__device__ __forceinline__ void xcd_barrier_complete(unsigned* bar, unsigned x, unsigned& nloc, unsigned& nx) {
    const unsigned G = gridDim.x * gridDim.y * gridDim.z;
    unsigned sum, cnt, mine, sp = 0u;
    for (;;) {
        sum = 0u; cnt = 0u; mine = 0u;
#pragma unroll
        for (unsigned j = 0; j < 16; ++j) { const unsigned c = xb_ld(&bar[XB_XCNT(j)]); sum += c; cnt += (c > 0u) ? 1u : 0u; mine = (j == x) ? c : mine; }
        if (sum == G) break;
        __builtin_amdgcn_s_sleep(1);
        if ((++sp & 255u) == 0u) { if (xb_ld(&bar[XB_TMO])) break; if (sp > XB_SPIN_CAP) { atomicAdd(&bar[XB_TMO], 1u); break; } }
    }
    nloc = mine > 0u ? mine : 1u; nx = cnt > 0u ? cnt : 1u;
}

__device__ __forceinline__ void xcd_barrier(const XcdBarrier& b) {
    asm volatile("s_waitcnt vmcnt(0)" ::: "memory");
    __syncthreads();
    if (threadIdx.x == 0) {
        unsigned* bar = b.bar;
        __builtin_amdgcn_s_waitcnt(0);
        unsigned nloc = b.st[0], nx = b.st[1];
        if (nloc == 0u) { xcd_barrier_complete(bar, b.x, nloc, nx); b.st[0] = nloc; b.st[1] = nx; }
        const unsigned old = xb_add(&bar[XB_XSUB(b.x)], 1u);
        const unsigned gen = old / nloc;
        if (old + 1u == (gen + 1u) * nloc) {
            __builtin_amdgcn_fence(__ATOMIC_RELEASE, "agent");
            asm volatile("s_waitcnt vmcnt(0)" ::: "memory");
            const unsigned og = xb_add(&bar[XB_TOP], 1u);
            const unsigned tg = og / nx;
            if (og + 1u == (tg + 1u) * nx) xb_add(&bar[XB_TOPGEN], 1u);
            else XB_SPIN(xb_ld(&bar[XB_TOPGEN]) == tg, bar);
            __builtin_amdgcn_fence(__ATOMIC_ACQUIRE, "agent");
            xb_add(&bar[XB_XGEN(b.x)], 1u);
            asm volatile("s_waitcnt vmcnt(0)" ::: "memory");
        } else {
            XB_SPIN(xb_ld(&bar[XB_XGEN(b.x)]) == gen, bar);
            __builtin_amdgcn_fence(__ATOMIC_ACQUIRE, "agent");
            asm volatile("s_waitcnt vmcnt(0)" ::: "memory");
        }
    }
    __syncthreads();
}

constexpr int D = 1024, TP = 16384, TS = 1024, T = TP + TS, SEQ = 2048, NBATCH = 8, DBATCH = 128, DSEQ = 8;
constexpr int AW = 2048, NA_IN = 6144, NB_IN = 3328, NB_SRC = 3144, PD = 256, NPAGES = 16, PAGE = 128;
constexpr int HD = 128, NH = 8, NKV = 2, KVW = 256, IDXH = 8, IDXD = 64, TOPK = 256;
constexpr int NPOS = SEQ + DSEQ;
constexpr int MASKW = 34;
constexpr float EPS = 1e-6f;
constexpr size_t O_Y = 0, O_KP = (size_t)T * D, O_VP = O_KP + (size_t)NBATCH * 2 * SEQ * KVW, O_IKP = O_VP + (size_t)NBATCH * 2 * SEQ * KVW,
                 O_KS = O_IKP + (size_t)NBATCH * 2 * SEQ * IDXD, O_VS = O_KS + (size_t)DBATCH * 2 * DSEQ * KVW, O_IKS = O_VS + (size_t)DBATCH * 2 * DSEQ * KVW,
                 O_CV = O_IKS + (size_t)DBATCH * 2 * DSEQ * IDXD, O_END = O_CV + (size_t)DBATCH * 2 * DSEQ * AW;
static_assert(O_END == 42074112, "output size");
constexpr size_t al256(size_t x) { return (x + 255) & ~(size_t)255; }
constexpr size_t WS_CTL = 0, CTL_BYTES = 1u << 20;
constexpr size_t SZ_WINA = (size_t)NA_IN * D * 2, SZ_WOUTA = (size_t)D * AW * 2, SZ_WINB = (size_t)NB_IN * D * 2, SZ_WSQ = (size_t)D * D * 2, SZ_WPE = (size_t)D * PD * 2;
constexpr size_t WS_WINA = CTL_BYTES, WS_WOUTA = WS_WINA + 2 * SZ_WINA, WS_WINB = WS_WOUTA + 2 * SZ_WOUTA, WS_WOUTB = WS_WINB + 2 * SZ_WINB,
                 WS_WGATE = WS_WOUTB + 2 * SZ_WSQ, WS_WPE = WS_WGATE + 4 * SZ_WSQ, WS_ROPE = WS_WPE + 4 * SZ_WPE;
constexpr size_t SZ_ROPE = al256((size_t)NPOS * 64 * 8), SZ_PB = (size_t)T * PD * 2, SZ_XB = (size_t)T * D * 2, SZ_XF = (size_t)T * D * 4, SZ_SS = (size_t)T * 16 * 4;
constexpr size_t WS_PB = WS_ROPE + SZ_ROPE, WS_XB0 = WS_PB + 4 * SZ_PB, WS_XB1 = WS_XB0 + SZ_XB, WS_XF0 = WS_XB1 + SZ_XB, WS_XF1 = WS_XF0 + SZ_XF,
                 WS_SSX = WS_XF1 + SZ_XF, WS_SS1 = WS_SSX + SZ_SS, WS_UZ = WS_SS1 + SZ_SS;
constexpr size_t SZ_AW = (size_t)T * AW * 2;
constexpr size_t WS_VR = WS_UZ + SZ_AW, WS_Y = WS_VR + SZ_AW, WS_VSS = WS_Y + SZ_AW, WS_PE = WS_VSS + (size_t)T * 32 * 4, WS_RAW = WS_PE + SZ_XB;
constexpr size_t WS_Q = WS_RAW + (size_t)T * NB_IN * 2, WS_KB = WS_Q + SZ_XB, WS_VB = WS_KB + (size_t)T * KVW * 2, WS_IQ = WS_VB + (size_t)T * KVW * 2,
                 WS_IK = WS_IQ + (size_t)T * 512 * 2, WS_IW = WS_IK + (size_t)T * 64 * 2, WS_SZ = WS_IW + (size_t)T * 8 * 4, WS_AO = WS_SZ + SZ_XB,
                 WS_MASK = WS_AO + SZ_XB, WS_QSS = WS_MASK + (size_t)T * MASKW * 8, WS_ROPE32 = WS_QSS + (size_t)T * NH * 4 * 4, WS_END = WS_ROPE32 + al256((size_t)NPOS * 32 * 8);
constexpr int SCR_BYTES = 153600, MISC_OFF = SCR_BYTES, LDS_BYTES = SCR_BYTES + 256;
constexpr int CW_BAR = 4096, CW_QUEUE = 16384;

typedef short s16x4 __attribute__((ext_vector_type(4)));
typedef float f32x16 __attribute__((ext_vector_type(16)));
typedef float f32x2v __attribute__((ext_vector_type(2)));
typedef unsigned u32x2v __attribute__((ext_vector_type(2)));
typedef unsigned long long u64;

__device__ __forceinline__ float bf2f(unsigned short b) { return __builtin_bit_cast(float, (unsigned)b << 16); }
__device__ __forceinline__ float bflo(unsigned w) { return __builtin_bit_cast(float, w << 16); }
__device__ __forceinline__ float bfhi(unsigned w) { return __builtin_bit_cast(float, w & 0xffff0000u); }
__device__ __forceinline__ unsigned cvtpk(float lo, float hi) { return pg8::cvt_pk_bf16(lo, hi); }
__device__ __forceinline__ float wave_sum(float v) {
#pragma unroll
    for (int o = 1; o < 64; o <<= 1) v += __shfl_xor(v, o);
    return v;
}
__device__ __forceinline__ float wave_max(float v) {
#pragma unroll
    for (int o = 1; o < 64; o <<= 1) v = fmaxf(v, __shfl_xor(v, o));
    return v;
}
__device__ __forceinline__ float rsq(float x) { return __builtin_amdgcn_rsqf(x); }
__device__ __forceinline__ float sigm(float x) { return __builtin_amdgcn_rcpf(1.0f + __builtin_amdgcn_exp2f(x * -1.4426950408889634f)); }
__device__ __forceinline__ float row_r16(const float* ss, int row, float inv_n) {
    const f32x4* p = (const f32x4*)(ss + (size_t)row * 16); const f32x4 a = p[0], b = p[1], c = p[2], d = p[3];
    const float s = (((a.x + a.y) + (a.z + a.w)) + ((b.x + b.y) + (b.z + b.w))) + (((c.x + c.y) + (c.z + c.w)) + ((d.x + d.y) + (d.z + d.w)));
    return rsq(s * inv_n + EPS);
}

__device__ __forceinline__ void rows_r8(const float* ss, int row0, int fq, float inv_n, float (&rr)[8]) {
    f32x4 v[8];
#pragma unroll
    for (int k = 0; k < 8; ++k) v[k] = *(const f32x4*)(ss + (size_t)(row0 + (k >> 2) * 128 + (k & 3) * 16) * 16 + 4 * fq);
#pragma unroll
    for (int k = 0; k < 8; ++k) { float t = (v[k].x + v[k].y) + (v[k].z + v[k].w); t += __shfl_xor(t, 16); t += __shfl_xor(t, 32); rr[k] = rsq(t * inv_n + EPS); }
}

struct EpiA1 {
    static constexpr bool PERM = true, AFTER_DRAIN = false;
    const float* ssx; bf16* UZ; bf16* V; float* vss;
    __device__ __forceinline__ void operator()(const f32x4 (&acc)[2][2][4][2], const pg8::Unit& u, int wr, int wc, int fr, int fq) const {
        const int row0 = u.pm * 256 + wr * 64 + fr; float rr[8]; rows_r8(ssx, row0, fq, 1.0f / D, rr);
#pragma unroll
        for (int ai = 0; ai < 2; ++ai)
#pragma unroll
            for (int m = 0; m < 4; ++m) {
                const int row = row0 + ai * 128 + m * 16; const float r = rr[ai * 4 + m];
                if (u.pn < 16) {
                    float o[8];
#pragma unroll
                    for (int n = 0; n < 2; ++n)
#pragma unroll
                        for (int j = 0; j < 4; ++j) { const float uu = acc[ai][0][m][n][j] * r, zz = acc[ai][1][m][n][j] * r; o[n * 4 + j] = uu * zz * sigm(zz); }
                    v4u w; w.x = cvtpk(o[0], o[1]); w.y = cvtpk(o[2], o[3]); w.z = cvtpk(o[4], o[5]); w.w = cvtpk(o[6], o[7]);
                    *(v4u*)(UZ + (size_t)row * AW + u.pn * 128 + wc * 32 + 8 * fq) = w;
                } else {
                    float q = 0.f;
#pragma unroll
                    for (int bj = 0; bj < 2; ++bj) { const f32x4 a = acc[ai][bj][m][0] * r, b = acc[ai][bj][m][1] * r;
                        q += (a.x * a.x + a.y * a.y) + (a.z * a.z + a.w * a.w) + (b.x * b.x + b.y * b.y) + (b.z * b.z + b.w * b.w);
                        v4u w; w.x = cvtpk(a.x, a.y); w.y = cvtpk(a.z, a.w); w.z = cvtpk(b.x, b.y); w.w = cvtpk(b.z, b.w);
                        *(v4u*)(V + (size_t)row * AW + (u.pn - 16) * 256 + bj * 128 + wc * 32 + 8 * fq) = w; }
                    q += __shfl_xor(q, 16); q += __shfl_xor(q, 32);
                    if (fq == 0) vss[(size_t)row * 32 + (u.pn - 16) * 4 + wc] = q;
                }
            }
    }
};
struct EpiBf16S {
    static constexpr bool PERM = true, AFTER_DRAIN = false;
    bf16* O; int ldc;
    __device__ __forceinline__ void operator()(const f32x4 (&acc)[2][2][4][2], const pg8::Unit& u, int wr, int wc, int fr, int fq) const {
        bf16* base = O + (size_t)(u.pm * 256 + wr * 64) * ldc + u.pn * 256 + wc * 32; const unsigned lo = (unsigned)fr * (unsigned)ldc + 8u * fq;
#pragma unroll
        for (int ai = 0; ai < 2; ++ai)
#pragma unroll
            for (int m = 0; m < 4; ++m)
#pragma unroll
                for (int bj = 0; bj < 2; ++bj) { const f32x4 a = acc[ai][bj][m][0], b = acc[ai][bj][m][1];
                    v4u w; w.x = cvtpk(a.x, a.y); w.y = cvtpk(a.z, a.w); w.z = cvtpk(b.x, b.y); w.w = cvtpk(b.z, b.w);
                    *(v4u*)(base + (lo + (unsigned)((ai * 128 + m * 16) * ldc + bj * 128))) = w; }
    }
};
struct EpiNull {
    static constexpr bool PERM = true, AFTER_DRAIN = false;
    float* O;
    __device__ __forceinline__ void operator()(const f32x4 (&acc)[2][2][4][2], const pg8::Unit& u, int wr, int wc, int fr, int fq) const {
        float s = 0.f;
#pragma unroll
        for (int ai = 0; ai < 2; ++ai)
#pragma unroll
            for (int bj = 0; bj < 2; ++bj)
#pragma unroll
                for (int m = 0; m < 4; ++m)
#pragma unroll
                    for (int n = 0; n < 2; ++n) s += (acc[ai][bj][m][n].x + acc[ai][bj][m][n].y) + (acc[ai][bj][m][n].z + acc[ai][bj][m][n].w);
        if (s == 12345.678f) O[threadIdx.x] = s;
    }
};
__device__ __forceinline__ void ld8f(const float* xf, const bf16* xb, size_t off, f32x4& a, f32x4& b) {
    if (xf) { a = *(const f32x4*)(xf + off); b = *(const f32x4*)(xf + off + 4); }
    else { const v4u w = *(const v4u*)(xb + off); a = (f32x4){bflo(w.x), bfhi(w.x), bflo(w.y), bfhi(w.y)}; b = (f32x4){bflo(w.z), bfhi(w.z), bflo(w.w), bfhi(w.w)}; } }
template <bool F32IN> struct EpiRes {
    static constexpr bool PERM = true, AFTER_DRAIN = false;
    const float* xf; const bf16* xbin; bf16* x1b; float* ss1;
    __device__ __forceinline__ void operator()(const f32x4 (&acc)[2][2][4][2], const pg8::Unit& u, int wr, int wc, int fr, int fq) const {
        const int row0 = u.pm * 256 + wr * 64 + fr;
#pragma unroll
        for (int ai = 0; ai < 2; ++ai)
#pragma unroll
            for (int m = 0; m < 4; ++m) {
                const int row = row0 + ai * 128 + m * 16; float q = 0.f;
#pragma unroll
                for (int bj = 0; bj < 2; ++bj) { const size_t off = (size_t)row * D + u.pn * 256 + bj * 128 + wc * 32 + 8 * fq;
                    f32x4 a, b; if (F32IN) ld8f(xf, nullptr, off, a, b); else ld8f(nullptr, xbin, off, a, b); a += acc[ai][bj][m][0]; b += acc[ai][bj][m][1];
                    q += (a.x * a.x + a.y * a.y) + (a.z * a.z + a.w * a.w) + (b.x * b.x + b.y * b.y) + (b.z * b.z + b.w * b.w);
                    v4u w; w.x = cvtpk(a.x, a.y); w.y = cvtpk(a.z, a.w); w.z = cvtpk(b.x, b.y); w.w = cvtpk(b.z, b.w);
                    *(v4u*)(x1b + off) = w; }
                q += __shfl_xor(q, 16); q += __shfl_xor(q, 32);
                if (fq == 0) ss1[(size_t)row * 16 + u.pn * 4 + wc] = q;
            }
    }
};
struct EpiGate {
    static constexpr bool PERM = true, AFTER_DRAIN = false;
    const float* ss1; const bf16* x1b; const bf16* pe; float* xout; bf16* xb; float* ssx;
    __device__ __forceinline__ void operator()(const f32x4 (&acc)[2][2][4][2], const pg8::Unit& u, int wr, int wc, int fr, int fq) const {
        const int row0 = u.pm * 256 + wr * 64 + fr; float rr[8]; rows_r8(ss1, row0, fq, 1.0f / D, rr);
#pragma unroll
        for (int ai = 0; ai < 2; ++ai)
#pragma unroll
            for (int m = 0; m < 4; ++m) {
                const int row = row0 + ai * 128 + m * 16; const float r1 = rr[ai * 4 + m]; float q = 0.f;
#pragma unroll
                for (int bj = 0; bj < 2; ++bj) { const size_t off = (size_t)row * D + u.pn * 256 + bj * 128 + wc * 32 + 8 * fq;
                    const v4u pw = *(const v4u*)(pe + off); f32x4 xa, xc; ld8f(nullptr, x1b, off, xa, xc);
                    const f32x4 ga = acc[ai][bj][m][0] * r1, gb = acc[ai][bj][m][1] * r1;
                    f32x4 a, b;
                    a.x = xa.x + sigm(ga.x) * bflo(pw.x); a.y = xa.y + sigm(ga.y) * bfhi(pw.x); a.z = xa.z + sigm(ga.z) * bflo(pw.y); a.w = xa.w + sigm(ga.w) * bfhi(pw.y);
                    b.x = xc.x + sigm(gb.x) * bflo(pw.z); b.y = xc.y + sigm(gb.y) * bfhi(pw.z); b.z = xc.z + sigm(gb.z) * bflo(pw.w); b.w = xc.w + sigm(gb.w) * bfhi(pw.w);
                    q += (a.x * a.x + a.y * a.y) + (a.z * a.z + a.w * a.w) + (b.x * b.x + b.y * b.y) + (b.z * b.z + b.w * b.w);
                    if (xout) { *(f32x4*)(xout + off) = a; *(f32x4*)(xout + off + 4) = b; }
                    v4u w; w.x = cvtpk(a.x, a.y); w.y = cvtpk(a.z, a.w); w.z = cvtpk(b.x, b.y); w.w = cvtpk(b.z, b.w);
                    *(v4u*)(xb + off) = w; }
                q += __shfl_xor(q, 16); q += __shfl_xor(q, 32);
                if (fq == 0) ssx[(size_t)row * 16 + u.pn * 4 + wc] = q;
            }
    }
};

struct Args { const void* in[22]; float* out; unsigned char* ws; int ph_lo, ph_hi; };
#define CAS __attribute__((address_space(4)))
__device__ __forceinline__ const unsigned char CAS* kargs() { const unsigned char CAS* p = (const unsigned char CAS*)__builtin_amdgcn_kernarg_segment_ptr(); asm volatile("" : "+s"(p)); return p; }
#define KIN(T_, i) (*(T_* const CAS*)(kargs() + 8 * (i)))
struct Ctx {
    LAS unsigned char* lds; int tid, lane, wave, G, bid;
    float* out; unsigned char* ws;
};
#define WSP(T_, off) ((T_*)(C.ws + (off)))

__device__ __forceinline__ int srcA(int n) { if (n < 4096) { const int t = n >> 8, r = n & 255; return r < 128 ? 128 * t + r : 4096 + 128 * t + (r - 128); } return 2048 + (n - 4096); }
__device__ __forceinline__ int srcB(int n) {
    const int tile = n >> 8, P = n & 255, bj = P >> 7, p = P & 127;
    if (tile < 5) { const int act = (p >> 3) * 4 + (p & 3) + ((p >> 2) & 1) * 64; return (tile < 4 ? (2 * tile + bj) * 128 : 1024 + bj * 128) + act; }
    if (tile == 5) return 1280 + P;
    if (tile < 8) { const int ih = 4 * (tile - 6) + 2 * bj + (p >> 6), pp = p & 63, act = (pp >> 3) * 4 + (pp & 3) + ((pp >> 2) & 1) * 32; return 1536 + ih * 64 + act; }
    if (tile < 12) return 2120 + (n - 2048);
    if (P < 32) return 2048 + P; if (P < 40) return 2112 + (P - 32); if (P >= 128 && P < 160) return 2048 + 32 + (P - 128); return -1;
}
template <int MAP> __device__ __forceinline__ void tr_job(const float* W, int K, int Nsrc, const float* gs, bf16* WT, int Ndst, int& base, int gw, int NGW, int lane) {
    const int nblk = Ndst / 256, nitems = (K / 64) * nblk;
    int first = (gw - base) % NGW; if (first < 0) first += NGW;
    for (int it = first; it < nitems; it += NGW) {
        const int kb = it / nblk, nb = it - kb * nblk, k0 = 64 * kb, n = 256 * nb + 4 * lane;
        const int src = MAP == 0 ? n : (MAP == 1 ? srcA(n) : srcB(n));
#pragma unroll
        for (int h = 0; h < 2; ++h) { f32x4 v[32];
#pragma unroll
            for (int i = 0; i < 32; ++i) v[i] = src >= 0 ? *(const f32x4*)(W + (size_t)(k0 + 32 * h + i) * Nsrc + src) : (f32x4){0.f, 0.f, 0.f, 0.f};
            if (gs) {
#pragma unroll
                for (int i = 0; i < 32; ++i) v[i] *= gs[k0 + 32 * h + i]; }
#pragma unroll
            for (int j = 0; j < 4; ++j) { bf16* dst = WT + (size_t)(n + j) * K + k0 + 32 * h;
#pragma unroll
                for (int q = 0; q < 4; ++q) { v4u o; o.x = cvtpk(v[8 * q][j], v[8 * q + 1][j]); o.y = cvtpk(v[8 * q + 2][j], v[8 * q + 3][j]); o.z = cvtpk(v[8 * q + 4][j], v[8 * q + 5][j]); o.w = cvtpk(v[8 * q + 6][j], v[8 * q + 7][j]);
                    *(v4u*)(dst + 8 * q) = o; } } }
    }
    base = (base + nitems) % NGW;
}
__device__ __forceinline__ void sincos_d(double a, double& s, double& c) {
    const double k = rint(a * 0.63661977236758134308);
    double r = fma(-k, 1.5707963267948966192, a); r = fma(-k, 6.123233995736766e-17, r);
    const double r2 = r * r;
    double sp = -7.647163731819816e-13; sp = fma(sp, r2, 1.605904383682161e-10); sp = fma(sp, r2, -2.505210838544172e-08); sp = fma(sp, r2, 2.755731922398589e-06); sp = fma(sp, r2, -1.984126984126984e-04);
    sp = fma(sp, r2, 8.333333333333333e-03); sp = fma(sp, r2, -1.666666666666667e-01); const double sn = fma(sp * r2, r, r);
    double cp = 4.779477332387385e-14; cp = fma(cp, r2, -1.147074559772972e-11); cp = fma(cp, r2, 2.087675698786810e-09); cp = fma(cp, r2, -2.755731922398589e-07); cp = fma(cp, r2, 2.480158730158730e-05);
    cp = fma(cp, r2, -1.388888888888889e-03); cp = fma(cp, r2, 4.166666666666666e-02); cp = fma(cp, r2, -0.5); const double cs = fma(cp, r2, 1.0);
    const int q = (int)((long long)k & 3);
    s = (q == 0) ? sn : (q == 1) ? cs : (q == 2) ? -sn : -cs;
    c = (q == 0) ? cs : (q == 1) ? -sn : (q == 2) ? -cs : sn;
}
__device__ __forceinline__ void prologue_part(Ctx& C, int part, bool split, int gw, int NGW) {
    const int lane = C.lane; int base = 0;
    const int j0 = split ? (part == 1 ? 1 : 0) : 0, j1 = split ? (part == 0 ? 1 : (part == 1 ? 2 : 0)) : 2;
    for (int j = j0; j < j1; ++j) {
        tr_job<1>(KIN(const float, 9) + (size_t)j * D * NA_IN, D, NA_IN, KIN(const float, 8) + (2 * j) * D, WSP(bf16, WS_WINA + j * SZ_WINA), NA_IN, base, gw, NGW, lane);
        tr_job<0>(KIN(const float, 13) + (size_t)j * AW * D, AW, D, nullptr, WSP(bf16, WS_WOUTA + j * SZ_WOUTA), D, base, gw, NGW, lane);
        tr_job<2>(KIN(const float, 14) + (size_t)j * D * NB_SRC, D, NB_SRC, KIN(const float, 8) + (2 * j + 1) * D, WSP(bf16, WS_WINB + j * SZ_WINB), NB_IN, base, gw, NGW, lane);
        tr_job<0>(KIN(const float, 18) + (size_t)j * D * D, D, D, nullptr, WSP(bf16, WS_WOUTB + j * SZ_WSQ), D, base, gw, NGW, lane);
        for (int i = 2 * j; i < 2 * j + 2; ++i) {
            tr_job<0>(KIN(const float, 20) + (size_t)i * D * D, D, D, KIN(const float, 19) + i * D, WSP(bf16, WS_WGATE + i * SZ_WSQ), D, base, gw, NGW, lane);
            tr_job<0>(KIN(const float, 21) + (size_t)i * PD * D, PD, D, nullptr, WSP(bf16, WS_WPE + i * SZ_WPE), D, base, gw, NGW, lane); }
    }
    const int pr0 = split ? (part == 2 ? T : 0) : 0, pr1 = split ? (part == 0 ? T : (part == 2 ? 4 * T : 0)) : 4 * T;
    for (int r0 = pr0 + gw * 4; r0 < pr1; r0 += NGW * 4) { f32x4 v[4];
#pragma unroll
        for (int e = 0; e < 4; ++e) { const int r = r0 + e, i = r / T, m = r - i * T;
            const float* src = m < TP ? KIN(const float, 6) + ((size_t)i * TP + m) * PD : KIN(const float, 7) + ((size_t)i * TS + (m - TP)) * PD; v[e] = ((const f32x4*)src)[lane]; }
#pragma unroll
        for (int e = 0; e < 4; ++e) { u32x2v w; w.x = cvtpk(v[e].x, v[e].y); w.y = cvtpk(v[e].z, v[e].w); ((u32x2v*)(WSP(bf16, WS_PB) + (size_t)(r0 + e) * PD))[lane] = w; } }
    if (part != 0) return;
    for (int m0 = gw * 2; m0 < T; m0 += NGW * 2) { f32x4 v[2][4];
#pragma unroll
        for (int e = 0; e < 2; ++e) { const int m = m0 + e; const float* src = m < TP ? KIN(const float, 0) + (size_t)m * D : KIN(const float, 1) + (size_t)(m - TP) * D;
#pragma unroll
            for (int j = 0; j < 4; ++j) v[e][j] = ((const f32x4*)src)[lane + 64 * j]; }
#pragma unroll
        for (int e = 0; e < 2; ++e) { const int m = m0 + e; bf16* dst = WSP(bf16, WS_XB0) + (size_t)m * D; float s = 0.f;
#pragma unroll
            for (int j = 0; j < 4; ++j) { const f32x4 x = v[e][j]; s += (x.x * x.x + x.y * x.y) + (x.z * x.z + x.w * x.w); u32x2v w; w.x = cvtpk(x.x, x.y); w.y = cvtpk(x.z, x.w); ((u32x2v*)dst)[lane + 64 * j] = w; }
            s = wave_sum(s); if (lane < 16) WSP(float, WS_SSX)[(size_t)m * 16 + lane] = lane == 0 ? s : 0.f; } }
    for (int e = gw * 64 + lane; e < NPOS * 64; e += NGW * 64) { const int pos = e >> 6, i = e & 63; double inv = 1.0; for (int k = 0; k < i; ++k) inv *= 0.8659643233600653;
        double s, c; sincos_d((double)pos * inv, s, c); const f32x2v v = (f32x2v){(float)c, (float)s}; WSP(f32x2v, WS_ROPE)[e] = v; if ((i & 1) == 0) WSP(f32x2v, WS_ROPE32)[pos * 32 + (i >> 1)] = v; }
}

__device__ __forceinline__ s16x4 tr_read(LAS unsigned char* p) { return __builtin_bit_cast(s16x4, __builtin_amdgcn_ds_read_tr16_b64_v4i16((LAS s16x4*)p)); }
__device__ __forceinline__ int crow(int r, int hi) { return (r & 3) + 8 * (r >> 2) + 4 * hi; }
constexpr int GT_WM = 0, GT_WMS = 272, GT_V = 34816, GT_VS = 576;
__device__ __forceinline__ void gate_build_wm(LAS unsigned char* lds, const float* wsg, bool samp, int tid) {
    const int t = tid >> 2, s0 = (tid & 3) * 32;
#pragma unroll 4
    for (int i = 0; i < 32; i += 2) { float v[2];
#pragma unroll
        for (int e = 0; e < 2; ++e) { const int s = s0 + i + e; bool ok; float wv;
            if (!samp) { ok = s <= t; wv = wsg[t * 128 + s]; } else { ok = ((s >> 3) == (t >> 3)) && ((s & 7) <= (t & 7)); wv = wsg[(t & 7) * 128 + (s & 7)]; }
            v[e] = ok ? wv : 0.f; }
        *(LAS unsigned*)(lds + GT_WM + t * GT_WMS + (s0 + i) * 2) = cvtpk(v[0], v[1]); }
}
__device__ __forceinline__ void gate_phase(Ctx& C, int j) {
    int tid = C.tid; asm volatile("" : "+v"(tid));
    const int lane = tid & 63, w = __builtin_amdgcn_readfirstlane(tid >> 6), r32 = lane & 31, hi = lane >> 5;
    LAS unsigned char* lds = C.lds;
    const bf16* Vr = WSP(bf16, WS_VR); const bf16* UZ = WSP(bf16, WS_UZ); bf16* Y = WSP(bf16, WS_Y); const float* vss = WSP(float, WS_VSS);
    int wm_state = -1;
#define GATE_DECODE(item_, samp_, tile_, g_, t0_, nit_) const bool samp_ = (item_) >= 1024; int tile_, g_, t0_, nit_; \
        if (!samp_) { tile_ = (item_) >> 3; g_ = (item_) & 7; t0_ = 0; nit_ = 8; } else { const int s_ = (item_) - 1024; g_ = s_ & 7; tile_ = 128 + ((s_ >> 3) & 7); t0_ = 32 * (s_ >> 6); nit_ = 2; }
#define GATE_LOAD(V_, Q_, tile_, g_, t0_, nit_) do { _Pragma("unroll") for (int i = 0; i < 8; ++i) if (i < (nit_)) { const int idx = tid + 512 * i, t = (t0_) + (idx >> 5), c = (idx & 31) * 8; \
        const size_t off = (size_t)((tile_) * 128 + t) * AW + (g_) * 256 + c; V_[i] = *(const v4u*)(Vr + off); Q_[i] = vss[(size_t)((tile_) * 128 + t) * 32 + (lane & 31)]; } } while (0)
    v4u vn[8]; float qn[8];
    if (C.bid < 1024 + 256) { GATE_DECODE(C.bid, s0_, ti0_, g0_, t00_, n0_); GATE_LOAD(vn, qn, ti0_, g0_, t00_, n0_); }
    for (int item = C.bid; item < 1024 + 256; item += C.G) {
        GATE_DECODE(item, samp, tile, g, t0, nit);
        const int row0 = tile * 128;
        if (wm_state != g * 2 + (samp ? 1 : 0)) { __syncthreads(); gate_build_wm(lds, KIN(const float, 10) + (size_t)(j * 8 + g) * 128 * 128, samp, tid); wm_state = g * 2 + (samp ? 1 : 0); }
        v4u uzr[8], vr[8]; float qr_[8];
#pragma unroll
        for (int i = 0; i < 8; ++i) { vr[i] = vn[i]; qr_[i] = qn[i]; }
#pragma unroll
        for (int i = 0; i < 8; ++i) if (i < nit) { const int idx = tid + 512 * i, t = t0 + (idx >> 5), c = (idx & 31) * 8; uzr[i] = *(const v4u*)(UZ + (size_t)(row0 + t) * AW + g * 256 + c); }
#pragma unroll
        for (int i = 0; i < 8; ++i) if (i < nit) { const int idx = tid + 512 * i, s = t0 + (idx >> 5), c = (idx & 31) * 8; const v4u v = vr[i]; float q = qr_[i];
#pragma unroll
            for (int o = 1; o < 32; o <<= 1) q += __shfl_xor(q, o);
            const float rv = rsq(q * (1.0f / AW) + EPS);
            f32x4 a = (f32x4){bflo(v.x), bfhi(v.x), bflo(v.y), bfhi(v.y)} * rv, b = (f32x4){bflo(v.z), bfhi(v.z), bflo(v.w), bfhi(v.w)} * rv;
            v4u wv; wv.x = cvtpk(a.x, a.y); wv.y = cvtpk(a.z, a.w); wv.z = cvtpk(b.x, b.y); wv.w = cvtpk(b.z, b.w);
            *(LAS v4u*)(lds + GT_V + s * GT_VS + c * 2) = wv;
            if (samp) { const int ms = row0 + s - TP, db = ms >> 3, tt = ms & 7; const float* gv = KIN(const float, 12) + j * AW + g * 256 + c;
                float* o = C.out + O_CV + ((size_t)(db * 2 + j) * DSEQ + tt) * AW + g * 256 + c;
                *(f32x4*)o = a * *(const f32x4*)gv; *(f32x4*)(o + 4) = b * *(const f32x4*)(gv + 4); } }
        __syncthreads();
        { LAS unsigned char* vb = lds + GT_V + (8 * hi + ((lane & 15) >> 2)) * GT_VS + (32 * w + 16 * ((lane >> 4) & 1) + 4 * (lane & 3)) * 2;
          const int tb0 = t0 >> 5, tb1 = samp ? tb0 + 1 : 4;
          bf16x8 Bf[8];
#pragma unroll
          for (int ks = 0; ks < 8; ++ks) if (!samp || (ks >> 1) == tb0) { const s16x4 l = tr_read(vb + (16 * ks) * GT_VS), h = tr_read(vb + (16 * ks + 4) * GT_VS);
              Bf[ks] = (bf16x8){l[0], l[1], l[2], l[3], h[0], h[1], h[2], h[3]}; }
          __syncthreads();
          if (item + C.G < 1024 + 256) { GATE_DECODE(item + C.G, sn_, tin_, gn_, t0n_, nn_); GATE_LOAD(vn, qn, tin_, gn_, t0n_, nn_); }
          const float gv = KIN(const float, 12)[j * AW + g * 256 + 32 * w + r32]; const float* bs = KIN(const float, 11) + (size_t)(j * 8 + g) * 128;
#pragma unroll
          for (int tb = 0; tb < 4; ++tb) if (tb >= tb0 && tb < tb1) { f32x16 acc = {};
#pragma unroll
              for (int ks = 0; ks < 8; ++ks) if (ks <= 2 * tb + 1 && (!samp || (ks >> 1) == tb)) {
                  const bf16x8 af = *(LAS bf16x8*)(lds + GT_WM + (32 * tb + r32) * GT_WMS + (16 * ks + 8 * hi) * 2);
                  acc = __builtin_amdgcn_mfma_f32_32x32x16_bf16(af, Bf[ks], acc, 0, 0, 0); }
#pragma unroll
              for (int i = 0; i < 16; ++i) { const int t = 32 * tb + crow(i, hi); *(LAS bf16*)(lds + GT_V + t * GT_VS + (32 * w + r32) * 2) = (bf16)f2bf(gv * acc[i] + bs[samp ? (t & 7) : t]); } } }
        __syncthreads();
#pragma unroll
        for (int i = 0; i < 8; ++i) if (i < nit) { const int idx = tid + 512 * i, t = t0 + (idx >> 5), c = (idx & 31) * 8; const size_t off = (size_t)(row0 + t) * AW + g * 256 + c;
            const v4u mx = *(const LAS v4u*)(lds + GT_V + t * GT_VS + c * 2), uz = uzr[i]; v4u y;
            y.x = cvtpk(bflo(uz.x) * bflo(mx.x), bfhi(uz.x) * bfhi(mx.x)); y.y = cvtpk(bflo(uz.y) * bflo(mx.y), bfhi(uz.y) * bfhi(mx.y));
            y.z = cvtpk(bflo(uz.z) * bflo(mx.z), bfhi(uz.z) * bfhi(mx.z)); y.w = cvtpk(bflo(uz.w) * bflo(mx.w), bfhi(uz.w) * bfhi(mx.w));
            *(v4u*)(Y + off) = y; }
        __syncthreads();
    }
}

struct EpiB1 {
    static constexpr bool PERM = true, AFTER_DRAIN = false;
    unsigned char* ws; const float *gq, *gk, *gik; float* out; int j; LAS float* xch;
#define EB1(T_, off) ((T_*)(ws + (off)))
    __device__ __forceinline__ static void rot4(const f32x4& a, const f32x4& b, const f32x4& cs01, const f32x4& cs23, f32x4& oa, f32x4& ob) {
        oa.x = a.x * cs01.x - b.x * cs01.y; ob.x = b.x * cs01.x + a.x * cs01.y; oa.y = a.y * cs01.z - b.y * cs01.w; ob.y = b.y * cs01.z + a.y * cs01.w;
        oa.z = a.z * cs23.x - b.z * cs23.y; ob.z = b.z * cs23.x + a.z * cs23.y; oa.w = a.w * cs23.z - b.w * cs23.w; ob.w = b.w * cs23.z + a.w * cs23.w; }
    __device__ __forceinline__ static u32x2v pk4(const f32x4& a) { u32x2v w; w.x = cvtpk(a.x, a.y); w.y = cvtpk(a.z, a.w); return w; }
    __device__ __forceinline__ void operator()(const f32x4 (&acc)[2][2][4][2], const pg8::Unit& u, int wr, int wc, int fr_, int fq_) const {
        int fr = fr_, fq = fq_; asm volatile("" : "+v"(fr), "+v"(fq));
        const int row0 = u.pm * 256 + wr * 64 + fr, pn = u.pn; float rr[8]; rows_r8(EB1(const float, WS_SSX), row0, fq, 1.0f / D, rr);
        if (pn < 5) {
            const bool isk = pn == 4; const int c = 16 * wc + 4 * fq; const float* gg = isk ? gk : gq;
            const f32x4 g0 = *(const f32x4*)(gg + c), g1 = *(const f32x4*)(gg + 64 + c);
            if (isk) {
#pragma unroll
                for (int ai = 0; ai < 2; ++ai)
#pragma unroll
                    for (int m = 0; m < 4; ++m) { const int row = row0 + ai * 128 + m * 16; const float r = rr[ai * 4 + m];
#pragma unroll
                        for (int bj = 0; bj < 2; ++bj) { const f32x4 a = acc[ai][bj][m][0] * r, b = acc[ai][bj][m][1] * r;
                            float q = (a.x * a.x + a.y * a.y) + (a.z * a.z + a.w * a.w) + (b.x * b.x + b.y * b.y) + (b.z * b.z + b.w * b.w);
                            q += __shfl_xor(q, 16); q += __shfl_xor(q, 32);
                            if (fq == 0) xch[((wr * 64 + ai * 128 + m * 16 + fr) * 2 + bj) * 4 + wc] = q; } }
                asm volatile("s_waitcnt lgkmcnt(0)" ::: "memory"); __builtin_amdgcn_s_barrier(); asm volatile("" ::: "memory");
            }
#pragma unroll
            for (int ai = 0; ai < 2; ++ai)
#pragma unroll
                for (int m = 0; m < 4; ++m) {
                    const int row = row0 + ai * 128 + m * 16; const float r = rr[ai * 4 + m];
                    const int pos = row < TP ? (row & (SEQ - 1)) : SEQ + ((row - TP) & (DSEQ - 1));
                    const f32x4 cs01 = *(const f32x4*)(EB1(const f32x2v, WS_ROPE) + pos * 64 + c), cs23 = *(const f32x4*)(EB1(const f32x2v, WS_ROPE) + pos * 64 + c + 2);
                    float* ko = nullptr;
                    if (isk) { if (row < TP) ko = out + O_KP + ((size_t)((row >> 11) * 2 + j) * SEQ + (row & (SEQ - 1))) * KVW; else { const int ms = row - TP; ko = out + O_KS + ((size_t)((ms >> 3) * 2 + j) * DSEQ + (ms & 7)) * KVW; } }
#pragma unroll
                    for (int bj = 0; bj < 2; ++bj) { const f32x4 a = acc[ai][bj][m][0] * r, b = acc[ai][bj][m][1] * r;
                        f32x4 ra, rb; rot4(a * g0, b * g1, cs01, cs23, ra, rb);
                        if (!isk) { const int hd = 2 * pn + bj;
                            float q = (a.x * a.x + a.y * a.y) + (a.z * a.z + a.w * a.w) + (b.x * b.x + b.y * b.y) + (b.z * b.z + b.w * b.w);
                            q += __shfl_xor(q, 16); q += __shfl_xor(q, 32);
                            if (fq == 0) EB1(float, WS_QSS)[((size_t)row * NH + hd) * 4 + wc] = q;
                            bf16* qp = EB1(bf16, WS_Q) + (size_t)row * D + hd * HD + c; *(u32x2v*)qp = pk4(ra); *(u32x2v*)(qp + 64) = pk4(rb); }
                        else { const f32x4 pq = *(const LAS f32x4*)(xch + ((wr * 64 + ai * 128 + m * 16 + fr) * 2 + bj) * 4);
                            const float rk = rsq(((pq.x + pq.y) + (pq.z + pq.w)) * (1.0f / HD) + EPS); const f32x4 ka = ra * rk, kb = rb * rk;
                            *(f32x4*)(ko + bj * HD + c) = ka; *(f32x4*)(ko + bj * HD + 64 + c) = kb;
                            bf16* kp = EB1(bf16, WS_KB) + (size_t)row * KVW + bj * HD + c; *(u32x2v*)kp = pk4(ka); *(u32x2v*)(kp + 64) = pk4(kb); } }
                }
        } else if (pn == 5) {
#pragma unroll
            for (int ai = 0; ai < 2; ++ai)
#pragma unroll
                for (int m = 0; m < 4; ++m) { const int row = row0 + ai * 128 + m * 16; const float r = rr[ai * 4 + m]; float* vo;
                    if (row < TP) vo = out + O_VP + ((size_t)((row >> 11) * 2 + j) * SEQ + (row & (SEQ - 1))) * KVW; else { const int ms = row - TP; vo = out + O_VS + ((size_t)((ms >> 3) * 2 + j) * DSEQ + (ms & 7)) * KVW; }
#pragma unroll
                    for (int bj = 0; bj < 2; ++bj) { const int cc = bj * 128 + wc * 32 + 8 * fq; const f32x4 a = acc[ai][bj][m][0] * r, b = acc[ai][bj][m][1] * r;
                        *(f32x4*)(vo + cc) = a; *(f32x4*)(vo + cc + 4) = b; v4u w; w.x = cvtpk(a.x, a.y); w.y = cvtpk(a.z, a.w); w.z = cvtpk(b.x, b.y); w.w = cvtpk(b.z, b.w);
                        *(v4u*)(EB1(bf16, WS_VB) + (size_t)row * KVW + cc) = w; } }
        } else if (pn < 8) {
            const int c = 16 * (wc & 1) + 4 * fq;
#pragma unroll
            for (int ai = 0; ai < 2; ++ai)
#pragma unroll
                for (int m = 0; m < 4; ++m) { const int row = row0 + ai * 128 + m * 16; const float r = rr[ai * 4 + m];
                    const int pos = row < TP ? (row & (SEQ - 1)) : SEQ + ((row - TP) & (DSEQ - 1));
                    const f32x4 cs01 = *(const f32x4*)(EB1(const f32x2v, WS_ROPE32) + pos * 32 + c), cs23 = *(const f32x4*)(EB1(const f32x2v, WS_ROPE32) + pos * 32 + c + 2);
#pragma unroll
                    for (int bj = 0; bj < 2; ++bj) { f32x4 ra, rb; rot4(acc[ai][bj][m][0] * r, acc[ai][bj][m][1] * r, cs01, cs23, ra, rb);
                        bf16* ip = EB1(bf16, WS_IQ) + (size_t)row * 512 + (4 * (pn - 6) + 2 * bj + (wc >> 1)) * IDXD + c; *(u32x2v*)ip = pk4(ra); *(u32x2v*)(ip + 32) = pk4(rb); } }
        } else if (pn < 12) {
#pragma unroll
            for (int ai = 0; ai < 2; ++ai)
#pragma unroll
                for (int m = 0; m < 4; ++m) { const int row = row0 + ai * 128 + m * 16; const float r = rr[ai * 4 + m];
#pragma unroll
                    for (int bj = 0; bj < 2; ++bj) { const f32x4 a = acc[ai][bj][m][0] * r, b = acc[ai][bj][m][1] * r; v4u w;
                        w.x = cvtpk(a.x * sigm(a.x), a.y * sigm(a.y)); w.y = cvtpk(a.z * sigm(a.z), a.w * sigm(a.w)); w.z = cvtpk(b.x * sigm(b.x), b.y * sigm(b.y)); w.w = cvtpk(b.z * sigm(b.z), b.w * sigm(b.w));
                        *(v4u*)(EB1(bf16, WS_SZ) + (size_t)row * D + (pn - 8) * 256 + bj * 128 + wc * 32 + 8 * fq) = w; } }
        } else if (wc == 0) {
            const int c = 8 * fq; const f32x4 g0a = *(const f32x4*)(gik + c), g0b = *(const f32x4*)(gik + c + 4), g1a = *(const f32x4*)(gik + 32 + c), g1b = *(const f32x4*)(gik + 32 + c + 4);
#pragma unroll
            for (int ai = 0; ai < 2; ++ai)
#pragma unroll
                for (int m = 0; m < 4; ++m) { const int row = row0 + ai * 128 + m * 16; const float r = rr[ai * 4 + m];
                    const int pos = row < TP ? (row & (SEQ - 1)) : SEQ + ((row - TP) & (DSEQ - 1)); float* iko;
                    if (row < TP) iko = out + O_IKP + ((size_t)((row >> 11) * 2 + j) * SEQ + (row & (SEQ - 1))) * IDXD; else { const int ms = row - TP; iko = out + O_IKS + ((size_t)((ms >> 3) * 2 + j) * DSEQ + (ms & 7)) * IDXD; }
                    const f32x4 a0 = acc[ai][0][m][0] * r, a1 = acc[ai][0][m][1] * r, b0 = acc[ai][1][m][0] * r, b1 = acc[ai][1][m][1] * r;
                    float q = ((a0.x * a0.x + a0.y * a0.y) + (a0.z * a0.z + a0.w * a0.w)) + ((a1.x * a1.x + a1.y * a1.y) + (a1.z * a1.z + a1.w * a1.w))
                            + ((b0.x * b0.x + b0.y * b0.y) + (b0.z * b0.z + b0.w * b0.w)) + ((b1.x * b1.x + b1.y * b1.y) + (b1.z * b1.z + b1.w * b1.w));
                    q += __shfl_xor(q, 16); q += __shfl_xor(q, 32); const float rk = rsq(q * (1.0f / IDXD) + EPS);
                    const f32x4 c01 = *(const f32x4*)(EB1(const f32x2v, WS_ROPE32) + pos * 32 + c), c23 = *(const f32x4*)(EB1(const f32x2v, WS_ROPE32) + pos * 32 + c + 2), c45 = *(const f32x4*)(EB1(const f32x2v, WS_ROPE32) + pos * 32 + c + 4), c67 = *(const f32x4*)(EB1(const f32x2v, WS_ROPE32) + pos * 32 + c + 6);
                    f32x4 ra0, rb0, ra1, rb1; rot4(a0 * g0a * rk, b0 * g1a * rk, c01, c23, ra0, rb0); rot4(a1 * g0b * rk, b1 * g1b * rk, c45, c67, ra1, rb1);
                    *(f32x4*)(iko + c) = ra0; *(f32x4*)(iko + c + 4) = ra1; *(f32x4*)(iko + 32 + c) = rb0; *(f32x4*)(iko + 32 + c + 4) = rb1;
                    bf16* kp = EB1(bf16, WS_IK) + (size_t)row * IDXD + c; v4u w0, w1; w0.x = cvtpk(ra0.x, ra0.y); w0.y = cvtpk(ra0.z, ra0.w); w0.z = cvtpk(ra1.x, ra1.y); w0.w = cvtpk(ra1.z, ra1.w);
                    w1.x = cvtpk(rb0.x, rb0.y); w1.y = cvtpk(rb0.z, rb0.w); w1.z = cvtpk(rb1.x, rb1.y); w1.w = cvtpk(rb1.z, rb1.w); *(v4u*)kp = w0; *(v4u*)(kp + 32) = w1; }
        } else if (wc == 1 && fq == 0) {
#pragma unroll
            for (int ai = 0; ai < 2; ++ai)
#pragma unroll
                for (int m = 0; m < 4; ++m) { const int row = row0 + ai * 128 + m * 16; const float r = rr[ai * 4 + m];
                    *(f32x4*)(EB1(float, WS_IW) + (size_t)row * 8) = acc[ai][0][m][0] * r; *(f32x4*)(EB1(float, WS_IW) + (size_t)row * 8 + 4) = acc[ai][0][m][1] * r; }
        }
    }
};
#undef EB1

constexpr int SC_STRIDE = 2068;
__device__ __forceinline__ unsigned fkey(float x) { const unsigned b = __builtin_bit_cast(unsigned, x + 0.0f); return b ^ ((unsigned)((int)b >> 31) | 0x80000000u); }
__device__ __forceinline__ bf16x8 cvt8(const float* p) { const f32x4 a = *(const f32x4*)p, b = *(const f32x4*)(p + 4); v4u w; w.x = cvtpk(a.x, a.y); w.y = cvtpk(a.z, a.w); w.z = cvtpk(b.x, b.y); w.w = cvtpk(b.z, b.w); return __builtin_bit_cast(bf16x8, w); }
template <int LN> __device__ __forceinline__ unsigned wrlane(unsigned sval, unsigned old) { asm volatile("s_nop 1\n\tv_writelane_b32 %0, %1, %2" : "+v"(old) : "s"(sval), "n"(LN)); return old; }
__device__ __forceinline__ int wave_total6(int c) { int t = 0;
#pragma unroll
    for (int b = 0; b < 6; ++b) t += __popcll(__ballot((c >> b) & 1)) << b;
    return t; }
__device__ __forceinline__ int cnt_ge(const unsigned (&u)[33], unsigned cand, int nq) {
    int c0 = 0, c1 = 0;
#pragma unroll
    for (int i = 0; i < 8; i += 2) { c0 += u[i] >= cand; c1 += u[i + 1] >= cand; }
    if (nq > 1) {
#pragma unroll
        for (int i = 8; i < 16; i += 2) { c0 += u[i] >= cand; c1 += u[i + 1] >= cand; } }
    if (nq > 2) {
#pragma unroll
        for (int i = 16; i < 24; i += 2) { c0 += u[i] >= cand; c1 += u[i + 1] >= cand; } }
    if (nq > 3) {
#pragma unroll
        for (int i = 24; i < 32; i += 2) { c0 += u[i] >= cand; c1 += u[i + 1] >= cand; }
        c0 += u[32] >= cand; }
    return c0 + c1;
}
__device__ __forceinline__ void hist_find(const LAS unsigned* hist, int K, int lane, int& bin, int& above) {
    const v4u a = *(const LAS v4u*)(hist + 8 * lane), b = *(const LAS v4u*)(hist + 8 * lane + 4);
    const int h0 = a.x, h1 = a.y, h2 = a.z, h3 = a.w, h4 = b.x, h5 = b.y, h6 = b.z, h7 = b.w;
    const int s = ((h0 + h1) + (h2 + h3)) + ((h4 + h5) + (h6 + h7)); int S = s;
#pragma unroll
    for (int o = 1; o < 64; o <<= 1) { const int t = __shfl_down(S, o); if (lane + o < 64) S += t; }
    const u64 m = __ballot(S >= K); const int L = 63 - __builtin_clzll(m);
    int acc = S - s, lb = 0, la = 0; bool done = false;
#define HF_(hh, i) if (!done) { if (acc + (hh) >= K) { lb = 8 * lane + (i); la = acc; done = true; } else acc += (hh); }
    HF_(h7, 7) HF_(h6, 6) HF_(h5, 5) HF_(h4, 4) HF_(h3, 3) HF_(h2, 2) HF_(h1, 1) HF_(h0, 0)
#undef HF_
    bin = __builtin_amdgcn_readlane(lb, L); above = __builtin_amdgcn_readlane(la, L);
}
__device__ __forceinline__ void idx_phase(Ctx& C, int j) {
    int tid_ = C.tid; asm volatile("" : "+v"(tid_));
    const int lane = tid_ & 63, wave = __builtin_amdgcn_readfirstlane(tid_ >> 6), fr = lane & 15, fq = lane >> 4;
    LAS float* sc = (LAS float*)C.lds; LAS unsigned* tbuf = (LAS unsigned*)(C.lds + 16 * SC_STRIDE * 4) + wave * 64; LAS unsigned* hist = (LAS unsigned*)(C.lds + 16 * SC_STRIDE * 4 + 2048) + wave * 576;
    const bf16* IQ = WSP(bf16, WS_IQ); const bf16* IKb = WSP(bf16, WS_IK); const float* IW = WSP(float, WS_IW); u64* MASK = WSP(u64, WS_MASK);
    constexpr int NUNITS = 1024 + DBATCH;
    for (int rowi = 0; rowi * C.G < NUNITS; ++rowi) {
#ifndef DUP_IDX_SAMPLE
#define DUP_IDX_SAMPLE 1
#endif
#ifndef DUP_IDX_PROMPT
#define DUP_IDX_PROMPT 1
#endif
        for (int rep_ = 0; rep_ < ((rowi * C.G + ((rowi & 1) ? C.G - 1 - C.bid : C.bid)) < DBATCH ? DUP_IDX_SAMPLE : DUP_IDX_PROMPT); ++rep_)
        { const int unit = rowi * C.G + ((rowi & 1) ? C.G - 1 - C.bid : C.bid);
        if (unit >= NUNITS) continue;
        const bool samp = unit < DBATCH; int b = 0, qg = 0, db = 0, mq0, nkt;
        if (!samp) { const int r = unit - DBATCH; b = r & 7; qg = 127 - (r >> 3); mq0 = b * SEQ + 16 * qg; nkt = qg + 1; } else { db = unit; mq0 = TP + db * DSEQ; nkt = 129; }
        bf16x8 Af[8][2]; { const bf16* qp = IQ + (size_t)(mq0 + (samp ? (fr & 7) : fr)) * 512 + 8 * fq;
#pragma unroll
            for (int h = 0; h < 8; ++h) { Af[h][0] = *(const bf16x8*)(qp + h * 64); Af[h][1] = *(const bf16x8*)(qp + h * 64 + 32); } }
        float iwv[4][8];
#pragma unroll
        for (int r = 0; r < 4; ++r) { const int qi = 4 * fq + r; const float* ip = IW + (size_t)(mq0 + (samp ? (qi & 7) : qi)) * 8; const f32x4 a = *(const f32x4*)ip, c = *(const f32x4*)(ip + 4);
            iwv[r][0] = a.x; iwv[r][1] = a.y; iwv[r][2] = a.z; iwv[r][3] = a.w; iwv[r][4] = c.x; iwv[r][5] = c.y; iwv[r][6] = c.z; iwv[r][7] = c.w; }
        f32x4 raw[4]; const int pgv = samp ? KIN(const int, 5)[db * NPAGES + (lane & 15)] : 0;
#define IDX_LOAD(kt_) do { const int key_ = 16 * (kt_) + fr; \
            if (!samp) { const bf16* kp = IKb + (size_t)(b * SEQ + key_) * 64 + 8 * fq; raw[0] = *(const f32x4*)kp; raw[1] = *(const f32x4*)(kp + 32); } \
            else if (key_ < SEQ) { const int page = __builtin_amdgcn_readlane(pgv, (kt_) >> 3);     const float* kp = KIN(const float, 4) + ((size_t)(page * 2 + j) * PAGE + (key_ & 127)) * IDXD + 8 * fq; \
                raw[0] = *(const f32x4*)kp; raw[1] = *(const f32x4*)(kp + 4); raw[2] = *(const f32x4*)(kp + 32); raw[3] = *(const f32x4*)(kp + 36); } \
            else { const int t_ = key_ - SEQ; const bf16* kp = IKb + (size_t)(TP + db * DSEQ + (t_ < DSEQ ? t_ : 0)) * 64 + 8 * fq; raw[0] = *(const f32x4*)kp; raw[1] = *(const f32x4*)(kp + 32); \
                if (t_ >= DSEQ) { raw[0] = (f32x4){0.f, 0.f, 0.f, 0.f}; raw[1] = raw[0]; } } } while (0)
        if (wave < nkt) IDX_LOAD(wave);
#ifndef PROBE_IDX
#define PROBE_IDX 0
#endif
        const int pmode = rep_ > 0 ? PROBE_IDX : 0;
        for (int kt = wave; kt < ((pmode & 2) ? 0 : nkt); kt += 8) {
            const int key = 16 * kt + fr; bf16x8 B0, B1;
            if (samp && key < SEQ) { v4u w0, w1; w0.x = cvtpk(raw[0].x, raw[0].y); w0.y = cvtpk(raw[0].z, raw[0].w); w0.z = cvtpk(raw[1].x, raw[1].y); w0.w = cvtpk(raw[1].z, raw[1].w);
                w1.x = cvtpk(raw[2].x, raw[2].y); w1.y = cvtpk(raw[2].z, raw[2].w); w1.z = cvtpk(raw[3].x, raw[3].y); w1.w = cvtpk(raw[3].z, raw[3].w); B0 = __builtin_bit_cast(bf16x8, w0); B1 = __builtin_bit_cast(bf16x8, w1); }
            else { B0 = __builtin_bit_cast(bf16x8, raw[0]); B1 = __builtin_bit_cast(bf16x8, raw[1]); }
            if (kt + 8 < nkt) IDX_LOAD(kt + 8);
            f32x4 score = {0.f, 0.f, 0.f, 0.f};
#pragma unroll
            for (int h = 0; h < 8; ++h) { f32x4 acc = {0.f, 0.f, 0.f, 0.f};
                acc = __builtin_amdgcn_mfma_f32_16x16x32_bf16(Af[h][0], B0, acc, 0, 0, 0); acc = __builtin_amdgcn_mfma_f32_16x16x32_bf16(Af[h][1], B1, acc, 0, 0, 0);
#pragma unroll
                for (int r = 0; r < 4; ++r) score[r] = fmaf(iwv[r][h], fmaxf(acc[r], 0.f), score[r]); }
#pragma unroll
            for (int r = 0; r < 4; ++r) { const int qrow = 4 * fq + r, qp_ = samp ? SEQ + (qrow & 7) : 16 * qg + qrow;
                ((LAS unsigned*)sc)[qrow * SC_STRIDE + key] = key <= qp_ ? fkey(score[r]) : 0u; }
        }
#undef IDX_LOAD
        { const int k0 = 16 * nkt, nmax = samp ? SEQ + DSEQ : 16 * qg + 16, k1r = ((nmax + 511) >> 9) << 9, k1 = k1r < SC_STRIDE ? k1r : SC_STRIDE;
          for (int e = tid_; e < 16 * (k1 - k0); e += 512) { const int rw = e / (k1 - k0), kk = k0 + (e - rw * (k1 - k0)); ((LAS unsigned*)sc)[rw * SC_STRIDE + kk] = 0u; } }
        __syncthreads();
        for (int qq = 0; qq < ((pmode & 1) ? 0 : (samp ? 1 : 2)); ++qq) {
            const int qi = samp ? wave : 2 * wave + qq, qpos = samp ? SEQ + qi : 16 * qg + qi, n = qpos + 1;
            u64* mw = (pmode ? WSP(u64, WS_RAW) : MASK) + (size_t)(mq0 + qi) * MASKW; u64 myword = 0ull;
            if (n <= TOPK) { const int lo = 64 * lane; myword = (n >= lo + 64) ? ~0ull : (n > lo ? ((1ull << (n - lo)) - 1ull) : 0ull); }
            else {
                const int nq = (n + 511) >> 9;
                unsigned u[33];
#define R8_(B, o) B((o) + 0) B((o) + 1) B((o) + 2) B((o) + 3) B((o) + 4) B((o) + 5) B((o) + 6) B((o) + 7)
#define FOR_NQ(B) do { R8_(B, 0) if (nq > 1) { R8_(B, 8) } if (nq > 2) { R8_(B, 16) } if (nq > 3) { R8_(B, 24) B(32) } } while (0)
#pragma unroll
                for (int i = 0; i < 33; ++i) u[i] = 0u;
#define B_LOAD(i) { const int s = lane + 64 * (i); if ((i) < 32) u[i] = ((const LAS unsigned*)sc)[qi * SC_STRIDE + s]; else if (s < n) u[i] = ((const LAS unsigned*)sc)[qi * SC_STRIDE + (s < SC_STRIDE ? s : 0)]; }
                FOR_NQ(B_LOAD);
                unsigned thr; int need2, mt = 0;
                { *(LAS v4u*)(hist + 8 * lane) = (v4u){0u, 0u, 0u, 0u}; *(LAS v4u*)(hist + 8 * lane + 4) = (v4u){0u, 0u, 0u, 0u};
#define B_H1(i) { __hip_atomic_fetch_add(hist + (u[i] != 0u ? (u[i] >> 23) : 512u + lane), 1u, __ATOMIC_RELAXED, __HIP_MEMORY_SCOPE_WAVEFRONT); }
                  FOR_NQ(B_H1);
#undef B_H1
                  int b1, ab1; hist_find(hist, TOPK, lane, b1, ab1); const unsigned pre1 = (unsigned)b1 << 23;
                  *(LAS v4u*)(hist + 8 * lane) = (v4u){0u, 0u, 0u, 0u}; *(LAS v4u*)(hist + 8 * lane + 4) = (v4u){0u, 0u, 0u, 0u};
#define B_H2(i) { const unsigned t_ = (u[i] - pre1) >> 14; __hip_atomic_fetch_add(hist + (t_ < 512u ? t_ : 512u + lane), 1u, __ATOMIC_RELAXED, __HIP_MEMORY_SCOPE_WAVEFRONT); }
                  FOR_NQ(B_H2);
#undef B_H2
                  int b2, ab2; hist_find(hist, TOPK - ab1, lane, b2, ab2);
                  thr = ((unsigned)b1 << 23) | ((unsigned)b2 << 14); need2 = TOPK - ab1 - ab2; }
#define B_TIE(i) { const u64 eb = __ballot(((u[i] ^ thr) >> 14) == 0u); if (eb != 0ull) { const int pos = mt + __popcll(eb & ((1ull << lane) - 1ull)); \
                    if (((eb >> lane) & 1ull) && pos < 64) tbuf[pos] = u[i] & 0x3fffu; mt += __popcll(eb); } }
                FOR_NQ(B_TIE);
                int cge;
                if (mt <= 64) { asm volatile("s_waitcnt lgkmcnt(0)" ::: "memory"); const unsigned my = lane < mt ? tbuf[lane] : 0u; unsigned lo = 0u; const bool in = lane < mt;
                    for (int bit = 13; bit >= 0; --bit) { const unsigned cand = lo | (1u << bit); if (__popcll(__ballot(in && my >= cand)) >= need2) lo = cand; }
                    thr |= lo; cge = (TOPK - need2) + __popcll(__ballot(in && my >= lo)); }
                else { for (int bit = 13; bit >= 0; --bit) { const unsigned cand = thr | (1u << bit); if (wave_total6(cnt_ge(u, cand, nq)) >= TOPK) thr = cand; }
                    cge = wave_total6(cnt_ge(u, thr, nq)); }
                unsigned wlo = 0u, whi = 0u;
#define B_FAST(i) { const u64 word = __ballot(u[i] >= thr); wlo = wrlane<(i)>((unsigned)word, wlo); whi = wrlane<(i)>((unsigned)(word >> 32), whi); }
#define B_SLOW(i) { const bool eq = u[i] == thr; const u64 eb = __ballot(eq); const int rank = running + __popcll(eb & ltmask); \
                    const u64 word = __ballot(u[i] > thr || (eq && rank < need)); running += __popcll(eb); wlo = wrlane<(i)>((unsigned)word, wlo); whi = wrlane<(i)>((unsigned)(word >> 32), whi); }
                if (cge == TOPK) { FOR_NQ(B_FAST); }
                else { const int cgt = (thr == 0xffffffffu) ? 0 : wave_total6(cnt_ge(u, thr + 1u, nq)); const int need = TOPK - cgt; int running = 0; const u64 ltmask = (1ull << lane) - 1ull;
                    FOR_NQ(B_SLOW); }
                myword = ((u64)whi << 32) | wlo;
#undef B_LOAD
#undef B_TIE
#undef B_FAST
#undef B_SLOW
#undef FOR_NQ
#undef R8_
            }
            if (lane < MASKW) mw[lane] = myword;
        }
        __syncthreads();
        }
    }
}


namespace att {
#ifndef ATT_SDEPTH
#define ATT_SDEPTH 1
#endif
constexpr float SCALE = 0.088388347648318440f, THR = 8.f, NEG = -3.0e38f;
constexpr int SHM_V = 16384, SHM_K = 16384;
#define KSWZ(row, colB) ((row) * 256 + ((colB) ^ (((row) & 15) << 4)))
#define SBAR() __builtin_amdgcn_sched_barrier(0)
__device__ __forceinline__ int v_st(int k, int c) { const int kk = (k & ~0xC) | ((k & 4) << 1) | ((k & 8) >> 1); return ((kk >> 3) * 4 + (c >> 5)) * 512 + ((kk & 7) * 32 + (c & 31)) * 2; }
__device__ __forceinline__ int v_rd_base(int lane) { return ((lane & 3) << 3) | (((lane >> 2) & 3) << 6) | (((lane >> 4) & 1) << 5) | (((lane >> 5) & 1) << 8); }
constexpr int v_rd_off(int d0, int ks, int half) { return d0 * 512 + ks * 4096 + half * 2048; }
template <int OFF> __device__ __forceinline__ s16x4 tr_read_i(int vb) { s16x4 r; asm volatile("ds_read_b64_tr_b16 %0, %1 offset:%2" : "=&v"(r) : "v"(vb), "i"(OFF) : "memory"); return r; }
#define MASK16(P, W) do { const unsigned nw_ = ~(W); _Pragma("unroll") for (int r = 0; r < 16; ++r) { \
    const unsigned sel_ = ((nw_ << (31 - ((r & 3) + 8 * (r >> 2)))) & 0x80000000u) | selc; P[r] = __builtin_amdgcn_fmed3f(P[r], __builtin_bit_cast(float, sel_), NEG); } } while (0)
template <bool TWO> __device__ __forceinline__ void partialSM(f32x16& p0, f32x16& p1, float& m_reg, float& mn, float& alpha) {
    constexpr float Cc = SCALE * 1.4426950408889634f;
    float pmax = p0[0];
#pragma unroll
    for (int r = 1; r < 16; ++r) pmax = fmaxf(pmax, p0[r]);
    if (TWO) {
#pragma unroll
        for (int r = 0; r < 16; ++r) pmax = fmaxf(pmax, p1[r]); }
    { auto rr = __builtin_amdgcn_permlane32_swap(__float_as_uint(pmax), __float_as_uint(pmax), false, false); pmax = fmaxf(__uint_as_float(rr[0]), __uint_as_float(rr[1])); }
    if (__builtin_expect(__all(pmax - m_reg <= THR / SCALE), 1)) { mn = m_reg; alpha = 1.f; }
    else { mn = fmaxf(m_reg, pmax); alpha = __builtin_amdgcn_exp2f((m_reg - mn) * Cc); m_reg = mn; }
    const float mnC = -mn * Cc;
#pragma unroll
    for (int r = 0; r < 16; ++r) p0[r] = fmaf(p0[r], Cc, mnC);
    if (TWO) {
#pragma unroll
        for (int r = 0; r < 16; ++r) p1[r] = fmaf(p1[r], Cc, mnC); }
#pragma unroll
    for (int r = 0; r < 16; ++r) p0[r] = __builtin_amdgcn_exp2f(p0[r]);
}
#define PK4(P, BASE, OUT) do { unsigned a0 = cvtpk(P[BASE + 0], P[BASE + 1]), a1 = cvtpk(P[BASE + 2], P[BASE + 3]);   \
    unsigned b0 = cvtpk(P[BASE + 4], P[BASE + 5]), b1 = cvtpk(P[BASE + 6], P[BASE + 7]);                              \
    auto r0 = __builtin_amdgcn_permlane32_swap(a0, b0, false, false); auto r1 = __builtin_amdgcn_permlane32_swap(a1, b1, false, false); \
    v4u w_ = {r0[0], r1[0], r0[1], r1[1]}; OUT = __builtin_bit_cast(bf16x8, w_); } while (0)
__device__ __forceinline__ void finishSM(f32x16& p0, f32x16& p1, float alpha, float& l_reg, bf16x8& pa0, bf16x8& pa1, bf16x8& pa2, bf16x8& pa3) {
#pragma unroll
    for (int r = 0; r < 16; ++r) p1[r] = __builtin_amdgcn_exp2f(p1[r]);
    float ps = 0;
#pragma unroll
    for (int r = 0; r < 16; ++r) ps += p0[r];
#pragma unroll
    for (int r = 0; r < 16; ++r) ps += p1[r];
    { auto rr = __builtin_amdgcn_permlane32_swap(__float_as_uint(ps), __float_as_uint(ps), false, false); ps = __uint_as_float(rr[0]) + __uint_as_float(rr[1]); }
    l_reg = l_reg * alpha + ps;
    PK4(p0, 0, pa0); PK4(p0, 8, pa1); PK4(p1, 0, pa2); PK4(p1, 8, pa3);
}
__device__ __forceinline__ void qkt(f32x16& p0, f32x16& p1, int Ks, const bf16x8* qr, int r32, int hi) {
    p0 = f32x16{}; p1 = f32x16{};
#pragma unroll
    for (int d0 = 0; d0 < 8; ++d0) { const int cb = (d0 * 16 + hi * 8) * 2;
        const bf16x8 b0 = *(const LAS bf16x8*)(uintptr_t)(Ks + KSWZ(r32, cb)); const bf16x8 b1 = *(const LAS bf16x8*)(uintptr_t)(Ks + KSWZ(32 + r32, cb));
        p0 = __builtin_amdgcn_mfma_f32_32x32x16_bf16(b0, qr[d0], p0, 0, 0, 0); p1 = __builtin_amdgcn_mfma_f32_32x32x16_bf16(b1, qr[d0], p1, 0, 0, 0); }
}
#define PKLH(L, H) (bf16x8){L[0], L[1], L[2], L[3], H[0], H[1], H[2], H[3]}
#define TRB(off_) tr_read_i<(off_)>(vb)
#define WAITL(N_) asm volatile("s_waitcnt lgkmcnt(" #N_ ")" ::: "memory")
#define KRD(d0_, half_) (*(const LAS bf16x8*)(uintptr_t)(Ks + KSWZ(32 * (half_) + r32, ((d0_) * 16 + hi * 8) * 2)))
#define VRD(D0_) l##D0_##0 = TRB(v_rd_off(D0_, 0, 0)); h##D0_##0 = TRB(v_rd_off(D0_, 0, 1)); l##D0_##1 = TRB(v_rd_off(D0_, 1, 0)); h##D0_##1 = TRB(v_rd_off(D0_, 1, 1)); \
                 l##D0_##2 = TRB(v_rd_off(D0_, 2, 0)); h##D0_##2 = TRB(v_rd_off(D0_, 2, 1)); l##D0_##3 = TRB(v_rd_off(D0_, 3, 0)); h##D0_##3 = TRB(v_rd_off(D0_, 3, 1))
#define PVM(D0_) o[D0_] = __builtin_amdgcn_mfma_f32_32x32x16_bf16(pa0, PKLH(l##D0_##0, h##D0_##0), o[D0_], 0, 0, 0); o[D0_] = __builtin_amdgcn_mfma_f32_32x32x16_bf16(pa1, PKLH(l##D0_##1, h##D0_##1), o[D0_], 0, 0, 0); \
                 o[D0_] = __builtin_amdgcn_mfma_f32_32x32x16_bf16(pa2, PKLH(l##D0_##2, h##D0_##2), o[D0_], 0, 0, 0); o[D0_] = __builtin_amdgcn_mfma_f32_32x32x16_bf16(pa3, PKLH(l##D0_##3, h##D0_##3), o[D0_], 0, 0, 0)
#define VDECL(D0_) s16x4 l##D0_##0, h##D0_##0, l##D0_##1, h##D0_##1, l##D0_##2, h##D0_##2, l##D0_##3, h##D0_##3
template <bool QK, bool PV> __device__ __forceinline__ void mblk(f32x16& p0, f32x16& p1, f32x16* o, int Ks, int vb, const bf16x8* qr, bf16x8 pa0, bf16x8 pa1, bf16x8 pa2, bf16x8 pa3, int r32, int hi) {
    VDECL(0); VDECL(1); VDECL(2); VDECL(3);
    if (QK) {
        bf16x8 ka[8], kb[8];
        p0 = f32x16{}; p1 = f32x16{};
        ka[0] = KRD(0, 0); kb[0] = KRD(0, 1); ka[1] = KRD(1, 0); kb[1] = KRD(1, 1); SBAR();
#pragma unroll
        for (int d0 = 0; d0 < 8; ++d0) {
            if (d0 + 2 < 8) { ka[d0 + 2] = KRD(d0 + 2, 0); kb[d0 + 2] = KRD(d0 + 2, 1); }
            if (PV && d0 == 6) { VRD(0); }
            p0 = __builtin_amdgcn_mfma_f32_32x32x16_bf16(ka[d0], qr[d0], p0, 0, 0, 0); p1 = __builtin_amdgcn_mfma_f32_32x32x16_bf16(kb[d0], qr[d0], p1, 0, 0, 0); SBAR(); }
    } else if (PV) { VRD(0); SBAR(); }
    if (PV) {
        VRD(1); WAITL(8); SBAR(); PVM(0); SBAR();
        VRD(2); WAITL(8); SBAR(); PVM(1); SBAR();
        VRD(3); WAITL(8); SBAR(); PVM(2); SBAR();
        WAITL(0); SBAR(); PVM(3); SBAR(); }
}
template <int D0> __device__ __forceinline__ void pv_one(f32x16& od, int vb, bf16x8 pa0, bf16x8 pa1, bf16x8 pa2, bf16x8 pa3) {
    const s16x4 l0 = tr_read_i<v_rd_off(D0, 0, 0)>(vb), h0 = tr_read_i<v_rd_off(D0, 0, 1)>(vb), l1 = tr_read_i<v_rd_off(D0, 1, 0)>(vb), h1 = tr_read_i<v_rd_off(D0, 1, 1)>(vb);
    const s16x4 l2 = tr_read_i<v_rd_off(D0, 2, 0)>(vb), h2 = tr_read_i<v_rd_off(D0, 2, 1)>(vb), l3 = tr_read_i<v_rd_off(D0, 3, 0)>(vb), h3 = tr_read_i<v_rd_off(D0, 3, 1)>(vb);
    asm volatile("s_waitcnt lgkmcnt(0)" ::: "memory"); SBAR();
    od = __builtin_amdgcn_mfma_f32_32x32x16_bf16(pa0, PKLH(l0, h0), od, 0, 0, 0); od = __builtin_amdgcn_mfma_f32_32x32x16_bf16(pa1, PKLH(l1, h1), od, 0, 0, 0);
    od = __builtin_amdgcn_mfma_f32_32x32x16_bf16(pa2, PKLH(l2, h2), od, 0, 0, 0); od = __builtin_amdgcn_mfma_f32_32x32x16_bf16(pa3, PKLH(l3, h3), od, 0, 0, 0);
}
__device__ __forceinline__ void pv_d0(f32x16* o, int vb, bf16x8 pa0, bf16x8 pa1, bf16x8 pa2, bf16x8 pa3) {
    pv_one<0>(o[0], vb, pa0, pa1, pa2, pa3); pv_one<1>(o[1], vb, pa0, pa1, pa2, pa3); pv_one<2>(o[2], vb, pa0, pa1, pa2, pa3); pv_one<3>(o[3], vb, pa0, pa1, pa2, pa3);
}
template <int D0> __device__ __forceinline__ void pv_one32(f32x16& od, int vb, bf16x8 pa0, bf16x8 pa1) {
    const s16x4 l0 = tr_read_i<v_rd_off(D0, 0, 0)>(vb), h0 = tr_read_i<v_rd_off(D0, 0, 1)>(vb), l1 = tr_read_i<v_rd_off(D0, 1, 0)>(vb), h1 = tr_read_i<v_rd_off(D0, 1, 1)>(vb);
    asm volatile("s_waitcnt lgkmcnt(0)" ::: "memory"); SBAR();
    od = __builtin_amdgcn_mfma_f32_32x32x16_bf16(pa0, PKLH(l0, h0), od, 0, 0, 0); od = __builtin_amdgcn_mfma_f32_32x32x16_bf16(pa1, PKLH(l1, h1), od, 0, 0, 0);
}

__device__ __forceinline__ bf16x8 scale8(bf16x8 x, float s) { const v4u w = __builtin_bit_cast(v4u, x); v4u o;
    o.x = cvtpk(bflo(w.x) * s, bfhi(w.x) * s); o.y = cvtpk(bflo(w.y) * s, bfhi(w.y) * s); o.z = cvtpk(bflo(w.z) * s, bfhi(w.z) * s); o.w = cvtpk(bflo(w.w) * s, bfhi(w.w) * s); return __builtin_bit_cast(bf16x8, o); }
constexpr int PR_V = 0, PR_K = 3 * SHM_V, PR_WS = PR_K + 3 * SHM_K, PR_MKL = PR_WS + 2048;
#ifndef PROBE_ATT
#define PROBE_ATT 0
#endif
template <int PM> __device__ __forceinline__ void prompt_unit(Ctx& C, int b, int qblk, int g) {
    int tid = C.tid; asm volatile("" : "+v"(tid));
    const int wid = __builtin_amdgcn_readfirstlane(tid >> 6), lane = tid & 63, r32 = lane & 31, hi = lane >> 5, hh = wid >> 1, qs = wid & 1;
    unsigned selc = 0x7f61b1e6u; asm volatile("" : "+v"(selc));
    const int V_lds = (int)(uintptr_t)C.lds + PR_V, K_lds = (int)(uintptr_t)C.lds + PR_K; LAS float* wsm = (LAS float*)(C.lds + PR_WS) + wid * 64; LAS float* li_l = wsm; LAS float* al_l = wsm + 32;
    const bf16* Q = WSP(bf16, WS_Q); const bf16* Kh = WSP(bf16, WS_KB) + (size_t)b * SEQ * KVW + g * HD; const bf16* Vh = WSP(bf16, WS_VB) + (size_t)b * SEQ * KVW + g * HD;
    const int mq = b * SEQ + 64 * qblk + 32 * qs + r32; const u64* MK = WSP(u64, WS_MASK); const unsigned mo = (unsigned)mq * MASKW;
    float m_reg = -1e30f, l_reg = 0; f32x16 o[4] = {}; bf16x8 qr[8];
    { const unsigned qo = (unsigned)mq * D + (4 * g + hh) * HD + hi * 8;
#pragma unroll
      for (int d0 = 0; d0 < 8; ++d0) qr[d0] = *(const bf16x8*)(Q + (qo + d0 * 16));
      const f32x4 pq = *(const f32x4*)(WSP(float, WS_QSS) + ((size_t)mq * NH + (4 * g + hh)) * 4); const float rq = rsq(((pq.x + pq.y) + (pq.z + pq.w)) * (1.0f / HD) + EPS);
#pragma unroll
      for (int d0 = 0; d0 < 8; ++d0) qr[d0] = scale8(qr[d0], rq); }
    unsigned koff[2], voff[2];
#pragma unroll
    for (int i = 0; i < 2; ++i) { const int s = tid + 512 * i; { const int row = s >> 4, chunk = (s & 15) ^ (row & 15); koff[i] = (unsigned)(row * KVW + chunk * 8); }
        { const int blk = s >> 5, kk = ((blk >> 2) << 3) | ((s & 31) >> 2), k = (kk & ~0xC) | ((kk & 4) << 1) | ((kk & 8) >> 1), c = (blk & 3) * 32 + (s & 3) * 8; voff[i] = (unsigned)(k * KVW + c); } }
    const int vb0 = V_lds + v_rd_base(lane);
#define GLDS(t_) do { if (PM & 32) break; const int sl_ = (t_) % 3; const bf16* Kt_ = Kh + (size_t)(t_) * 64 * KVW; const bf16* Vt_ = Vh + (size_t)(t_) * 64 * KVW; _Pragma("unroll") for (int i_ = 0; i_ < 2; ++i_) { \
    __builtin_amdgcn_global_load_lds((const unsigned*)(Kt_ + koff[i_]), (LAS unsigned*)(uintptr_t)(K_lds + sl_ * SHM_K + wid * 1024 + i_ * 8192), 16, 0, 0); \
    __builtin_amdgcn_global_load_lds((const unsigned*)(Vt_ + voff[i_]), (LAS unsigned*)(uintptr_t)(V_lds + sl_ * SHM_V + wid * 1024 + i_ * 8192), 16, 0, 0); } } while (0)
#define STEP_SYNC() do { asm volatile("s_waitcnt vmcnt(0)" ::: "memory"); __builtin_amdgcn_s_barrier(); asm volatile("" ::: "memory"); } while (0)
#define RESC(a) do { if (__any((a) < 1.f)) { if (hi == 0) al_l[r32] = (a); asm volatile("s_waitcnt lgkmcnt(0)" ::: "memory"); \
    _Pragma("unroll") for (int d = 0; d < 4; ++d) _Pragma("unroll") for (int r = 0; r < 16; ++r) o[d][r] *= al_l[crow(r, hi)]; } } while (0)
#define APPLYMASK(P0, P1, MK_) do { if (PM & 1) break; const unsigned w0_ = (unsigned)(MK_) >> (4 * hi), w1_ = (unsigned)((MK_) >> 32) >> (4 * hi); MASK16(P0, w0_); MASK16(P1, w1_); } while (0)
    const int NT = qblk + 1;
    f32x16 p0 = {}, p1 = {}; float mn, al; bf16x8 pa0 = {}, pa1 = {}, pa2 = {}, pa3 = {};
#define BARX() do { asm volatile("" ::: "memory"); if (!(PM & 64)) __builtin_amdgcn_s_barrier(); asm volatile("" ::: "memory"); } while (0)
#define VM0() asm volatile("s_waitcnt vmcnt(0)" ::: "memory")
#define MBLK_(QK_, PV_, r_) do { int ks_ = K_lds + ((r_) % 3) * SHM_K; asm volatile("" : "+s"(ks_)); int vb_ = vb0 + (((r_) + 2) % 3) * SHM_V; asm volatile("" : "+v"(vb_)); \
    mblk<QK_, PV_>(p0, p1, o, ks_, vb_, qr, pa0, pa1, pa2, pa3, r32, hi); } while (0)
#define SBLK(r_) do { if (PM & 16) { PK4(p0, 0, pa0); PK4(p0, 8, pa1); PK4(p1, 0, pa2); PK4(p1, 8, pa3); break; } const u64 mk_ = mkq[(r_)]; APPLYMASK(p0, p1, mk_); partialSM<true>(p0, p1, m_reg, mn, al); finishSM(p0, p1, al, l_reg, pa0, pa1, pa2, pa3); RESC(al); } while (0)
    LAS u64* mkl = (LAS u64*)(C.lds + PR_MKL);
    { const int q_ = tid >> 3, w4_ = (tid & 7) * 4; const u64* src_ = MK + (size_t)(b * SEQ + 64 * qblk + q_) * MASKW + w4_;
      const v4u m0_ = *(const v4u*)src_, m1_ = *(const v4u*)(src_ + 2); *(LAS v4u*)(mkl + q_ * MASKW + w4_) = m0_; *(LAS v4u*)(mkl + q_ * MASKW + w4_ + 2) = m1_; }
    const LAS u64* mkq = mkl + (32 * qs + r32) * MASKW;
    GLDS(0); if (NT > 1) GLDS(1);
    asm volatile("s_waitcnt lgkmcnt(0)" ::: "memory"); VM0(); BARX();
    if (wid < 4) {
        MBLK_(true, false, 0); BARX(); SBLK(0); VM0(); BARX();
        for (int r = 1; r < NT; ++r) {
            if (r + 1 < NT) { const int t_ = r + 1; GLDS(t_); }
            MBLK_(true, true, r); BARX();
            SBLK(r); VM0(); BARX();
        }
        MBLK_(false, true, NT); BARX();
    } else {
        BARX();
        MBLK_(true, false, 0); VM0(); BARX(); if (2 < NT) GLDS(2); SBLK(0); BARX();
        for (int r = 1; r < NT; ++r) {
            MBLK_(true, true, r); VM0(); BARX();
            if (r + 2 < NT) { const int t_ = r + 2; GLDS(t_); }
            SBLK(r); BARX();
        }
        MBLK_(false, true, NT);
    }
#undef BARX
#undef VM0
#undef MBLK_
#undef SBLK
    if (hi == 0) li_l[r32] = l_reg; asm volatile("s_waitcnt lgkmcnt(0)" ::: "memory");
    __syncthreads();
    { const int ot = (int)(uintptr_t)C.lds + wid * 8704;
#pragma unroll
      for (int r = 0; r < 16; ++r) { const int orow = crow(r, hi); const float rl = __builtin_amdgcn_rcpf(li_l[orow]);
#pragma unroll
          for (int d0 = 0; d0 < 4; ++d0) *(LAS bf16*)(uintptr_t)(ot + orow * 272 + (d0 * 32 + r32) * 2) = (bf16)f2bf(o[d0][r] * rl); }
      asm volatile("s_waitcnt lgkmcnt(0)" ::: "memory");
      const bf16* SZ = WSP(bf16, WS_SZ); bf16* AO = PM ? WSP(bf16, WS_RAW) : WSP(bf16, WS_AO);
#pragma unroll
      for (int e = 0; e < 8; ++e) { const int idx = lane + 64 * e, row = idx >> 4, ch = idx & 15; const unsigned off = (unsigned)(b * SEQ + 64 * qblk + 32 * qs + row) * D + (4 * g + hh) * HD + ch * 8;
          const v4u ov = *(const LAS v4u*)(uintptr_t)(ot + row * 272 + ch * 16), sz = *(const v4u*)(SZ + off); v4u y;
          y.x = cvtpk(bflo(ov.x) * bflo(sz.x), bfhi(ov.x) * bfhi(sz.x)); y.y = cvtpk(bflo(ov.y) * bflo(sz.y), bfhi(ov.y) * bfhi(sz.y));
          y.z = cvtpk(bflo(ov.z) * bflo(sz.z), bfhi(ov.z) * bfhi(sz.z)); y.w = cvtpk(bflo(ov.w) * bflo(sz.w), bfhi(ov.w) * bfhi(sz.w));
          *(v4u*)(AO + off) = y; } }
    __syncthreads();
#undef GLDS
#undef STEP_SYNC
}

constexpr int SU_ROFF = 65536, SU_QB = SU_ROFF + 2112 * 4, SU_CM = SU_QB + 2112, SU_ML = 131072, SU_N = SU_ML + 2048 + 1024, SU_MQ = SU_CM + 8 * 68 * 4, SU_PFX = SU_MQ + 9 * 34 * 8;
__device__ __forceinline__ void sample_unit(Ctx& C, int j, int db, int g) {
    int tid = C.tid; asm volatile("" : "+v"(tid));
    const int wid = __builtin_amdgcn_readfirstlane(tid >> 6), lane = tid & 63, r32 = lane & 31, hi = lane >> 5;
    unsigned selc = 0x7f61b1e6u; asm volatile("" : "+v"(selc));
    LAS unsigned char* lds = C.lds; LAS unsigned* roff = (LAS unsigned*)(lds + SU_ROFF); LAS unsigned char* qb = lds + SU_QB; LAS unsigned* cm = (LAS unsigned*)(lds + SU_CM);
    LAS float* ml = (LAS float*)(lds + SU_ML); LAS int* nUp = (LAS int*)(lds + SU_N);
    const int m0 = TP + db * DSEQ; const u64* mp = WSP(u64, WS_MASK) + (size_t)m0 * MASKW;
    LAS u64* mq = (LAS u64*)(lds + SU_MQ); LAS int* pfx = (LAS int*)(lds + SU_PFX);
    if (lane < 33) mq[wid * 34 + lane] = mp[wid * MASKW + lane];
    __syncthreads();
    if (wid == 0) { u64 uw = 0ull; if (lane < 33) {
#pragma unroll
            for (int t = 0; t < 8; ++t) uw |= mq[t * 34 + lane]; }
        const int cnt = __popcll(uw); int inc = cnt;
#pragma unroll
        for (int o = 1; o < 64; o <<= 1) { const int v = __shfl_up(inc, o); if (lane >= o) inc += v; }
        if (lane < 34) { pfx[lane] = inc - cnt; mq[8 * 34 + lane] = uw; }
        if (lane == 63) nUp[0] = inc; }
    __syncthreads();
    const int nU = nUp[0], nT = (nU + 31) >> 5;
    for (int s = tid; s < 33 * 64; s += 512) { const int i = s >> 6, bt = s & 63; const u64 uw = mq[8 * 34 + i];
        if ((uw >> bt) & 1ull) { const int pos = pfx[i] + __popcll(uw & ((1ull << bt) - 1ull)); unsigned off;
            if (s < SEQ) { const int page = KIN(const int, 5)[db * NPAGES + (s >> 7)]; off = (unsigned)(((page * 2 + j) * PAGE + (s & 127)) * KVW); } else off = 0x80000000u | (unsigned)((s - SEQ) * KVW);
            roff[pos] = off; unsigned qq = 0;
#pragma unroll
            for (int t = 0; t < 8; ++t) qq |= (unsigned)((mq[t * 34 + i] >> bt) & 1ull) << t;
            qb[pos] = (unsigned char)qq; } }
    __syncthreads();
    { const unsigned off0 = roff[0]; for (int c = nU + tid; c < nT * 32; c += 512) { roff[c] = off0; qb[c] = 0; } }
    __syncthreads();
    for (int c0 = wid * 64; c0 < nT * 32; c0 += 512) { const unsigned qq = (c0 + lane < nT * 32) ? qb[c0 + lane] : 0u;
#pragma unroll
        for (int t = 0; t < 8; ++t) { const u64 bw = __ballot((qq >> t) & 1u); if (lane == 0) { cm[t * 68 + (c0 >> 5)] = (unsigned)bw; cm[t * 68 + (c0 >> 5) + 1] = (unsigned)(bw >> 32); } } }
    __syncthreads();
    const float* kc = KIN(const float, 2) + g * HD; const float* vc = KIN(const float, 3) + g * HD;
    const float* kn = C.out + O_KS + (size_t)(db * 2 + j) * DSEQ * KVW + g * HD; const float* vn = C.out + O_VS + (size_t)(db * 2 + j) * DSEQ * KVW + g * HD;
    const int hh = r32 >> 3, t = r32 & 7;
    bf16x8 qr[8]; { const bf16* Qw = WSP(bf16, WS_Q) + (size_t)(m0 + t) * D + (4 * g + hh) * HD + hi * 8;
#pragma unroll
        for (int d0 = 0; d0 < 8; ++d0) qr[d0] = *(const bf16x8*)(Qw + d0 * 16);
        const f32x4 pq = *(const f32x4*)(WSP(float, WS_QSS) + ((size_t)(m0 + t) * NH + (4 * g + hh)) * 4); const float rq = rsq(((pq.x + pq.y) + (pq.z + pq.w)) * (1.0f / HD) + EPS);
#pragma unroll
        for (int d0 = 0; d0 < 8; ++d0) qr[d0] = scale8(qr[d0], rq); }
    const int kt = (int)(uintptr_t)lds + wid * 8192, vt = kt, vbr = vt + v_rd_base(lane); const int cc = lane & 31;
    LAS float* al_l = ml + 512 + wid * 32;
    float m_reg = -1e30f, l_reg = 0.f; f32x16 o[4] = {};
    for (int ti = wid; ti < nT; ti += 8) {
        { f32x4 st[16];
#pragma unroll
          for (int k = 0; k < 16; ++k) { const unsigned ro = roff[ti * 32 + 2 * k + hi]; st[k] = *(const f32x4*)(((ro >> 31) ? kn : kc) + (ro & 0x7fffffffu) + 4 * cc); }
#pragma unroll
          for (int k = 0; k < 16; ++k) { const int i = 2 * k + hi; u32x2v w; w.x = cvtpk(st[k].x, st[k].y); w.y = cvtpk(st[k].z, st[k].w); *(LAS u32x2v*)(uintptr_t)(kt + KSWZ(i, cc * 8)) = w; } }
        f32x4 sv[16];
#pragma unroll
        for (int k = 0; k < 16; ++k) { const unsigned ro = roff[ti * 32 + 2 * k + hi]; sv[k] = *(const f32x4*)(((ro >> 31) ? vn : vc) + (ro & 0x7fffffffu) + 4 * cc); }
        f32x16 p0 = {}, pdummy = {};
#pragma unroll
        for (int d0 = 0; d0 < 8; ++d0) { const bf16x8 kf = *(const LAS bf16x8*)(uintptr_t)(kt + KSWZ(r32, (d0 * 16 + hi * 8) * 2)); p0 = __builtin_amdgcn_mfma_f32_32x32x16_bf16(kf, qr[d0], p0, 0, 0, 0); }
        const unsigned cw = cm[t * 68 + ti] >> (4 * hi); MASK16(p0, cw);
        float mn, alpha; partialSM<false>(p0, pdummy, m_reg, mn, alpha);
        float ps = 0;
#pragma unroll
        for (int r = 0; r < 16; ++r) ps += p0[r];
        { auto rr = __builtin_amdgcn_permlane32_swap(__float_as_uint(ps), __float_as_uint(ps), false, false); ps = __uint_as_float(rr[0]) + __uint_as_float(rr[1]); }
        l_reg = l_reg * alpha + ps;
        bf16x8 pa0, pa1; PK4(p0, 0, pa0); PK4(p0, 8, pa1);
        if (__any(alpha < 1.f)) { if (hi == 0) al_l[r32] = alpha; asm volatile("s_waitcnt lgkmcnt(0)" ::: "memory");
#pragma unroll
            for (int d = 0; d < 4; ++d)
#pragma unroll
                for (int r = 0; r < 16; ++r) o[d][r] *= al_l[crow(r, hi)]; }
        asm volatile("s_waitcnt lgkmcnt(0)" ::: "memory");
#pragma unroll
        for (int k = 0; k < 16; ++k) { const int i = 2 * k + hi; u32x2v w; w.x = cvtpk(sv[k].x, sv[k].y); w.y = cvtpk(sv[k].z, sv[k].w); *(LAS u32x2v*)(uintptr_t)(vt + v_st(i, 4 * cc)) = w; }
        asm volatile("s_waitcnt lgkmcnt(0)" ::: "memory");
        pv_one32<0>(o[0], vbr, pa0, pa1); pv_one32<1>(o[1], vbr, pa0, pa1); pv_one32<2>(o[2], vbr, pa0, pa1); pv_one32<3>(o[3], vbr, pa0, pa1);
    }
    if (hi == 0) { ml[(wid * 32 + r32) * 2] = m_reg; ml[(wid * 32 + r32) * 2 + 1] = l_reg; }
    __syncthreads();
    { constexpr float Cc = SCALE * 1.4426950408889634f;
      float fac[16];
#pragma unroll
      for (int r = 0; r < 16; ++r) { const int row = crow(r, hi); float M = -1e30f;
#pragma unroll
          for (int w = 0; w < 8; ++w) M = fmaxf(M, ml[(w * 32 + row) * 2]);
          float L = 0.f;
#pragma unroll
          for (int w = 0; w < 8; ++w) L += ml[(w * 32 + row) * 2 + 1] * __builtin_amdgcn_exp2f((ml[(w * 32 + row) * 2] - M) * Cc);
          fac[r] = __builtin_amdgcn_exp2f((ml[(wid * 32 + row) * 2] - M) * Cc) * __builtin_amdgcn_rcpf(L); }
      LAS float* part = (LAS float*)lds + wid * 4096;
#pragma unroll
      for (int d0 = 0; d0 < 4; ++d0)
#pragma unroll
          for (int r = 0; r < 16; ++r) part[crow(r, hi) * 128 + d0 * 32 + r32] = o[d0][r] * fac[r]; }
    __syncthreads();
    { const bf16* SZ = WSP(bf16, WS_SZ); bf16* AO = WSP(bf16, WS_AO); const LAS float* part = (const LAS float*)lds;
#pragma unroll
      for (int e = 0; e < 8; ++e) { const int idx = tid + 512 * e, row = idx >> 7, d = idx & 127; float s = 0.f;
#pragma unroll
          for (int w = 0; w < 8; ++w) s += part[w * 4096 + idx];
          const size_t off = (size_t)(m0 + (row & 7)) * D + (4 * g + (row >> 3)) * HD + d; AO[off] = (bf16)f2bf(s * bf2f(SZ[off])); } }
    __syncthreads();
}
#undef RESC
#undef APPLYMASK
}

__device__ __forceinline__ void attn_phase(Ctx& C, int j) {
    const int c = C.bid;
    for (int pass = 0; pass < 2; ++pass) {
        if ((pass == 0) == ((c & 1) == 0)) { for (int u = c; u < DBATCH * NKV; u += C.G) att::sample_unit(C, j, u >> 1, u & 1); }
        else {
            for (int u = c; u < 256; u += C.G) { const int x = u & 7, y = u >> 3, bg = 2 * x + (y >> 4), qp = y & 15;
#pragma clang loop unroll(disable)
                for (int k = 0; k < 2; ++k) att::prompt_unit<0>(C, bg >> 1, k ? 31 - qp : qp, bg & 1); }
#if PROBE_ATT
            for (int u = c; u < 256; u += C.G) { const int x = u & 7, y = u >> 3, bg = 2 * x + (y >> 4), qp = y & 15;
#pragma clang loop unroll(disable)
                for (int k = 0; k < 2; ++k) att::prompt_unit<PROBE_ATT>(C, bg >> 1, k ? 31 - qp : qp, bg & 1); }
#endif
        }
    }
}

template <class F> __device__ __forceinline__ void small_gemm(Ctx& C, const bf16* A, const bf16* Bt, int N, int K, const F& f) {
    int tid = C.tid; asm volatile("" : "+v"(tid));
    const int lane = tid & 63, wave = __builtin_amdgcn_readfirstlane(tid >> 6), fr = lane & 15, fq = lane >> 4;
    LAS float* part = (LAS float*)C.lds;
    const int ntn = N / 64, ntiles = (TS / 64) * ntn, kw = K / 8;
#ifdef NO_SMALL
    if (true) return;
#endif
    for (int tile = C.bid; tile < ntiles; tile += C.G) {
        const int tm = tile / ntn, tn = tile - tm * ntn;
        f32x4 acc[4][4];
#pragma unroll
        for (int m = 0; m < 4; ++m)
#pragma unroll
            for (int n = 0; n < 4; ++n) acc[m][n] = (f32x4){0.f, 0.f, 0.f, 0.f};
        const bf16* ap = A + (size_t)(TP + 64 * tm + fr) * K + wave * kw + 8 * fq; const bf16* bp = Bt + (size_t)(64 * tn + fr) * K + wave * kw + 8 * fq;
        for (int kc = 0; kc < kw; kc += 128) { bf16x8 af[4][4], bfr[4][4];
#pragma unroll
            for (int q = 0; q < 4; ++q) if (kc + 32 * q < kw) {
#pragma unroll
                for (int m = 0; m < 4; ++m) { af[q][m] = *(const bf16x8*)(ap + (size_t)(16 * m) * K + kc + 32 * q); bfr[q][m] = *(const bf16x8*)(bp + (size_t)(16 * m) * K + kc + 32 * q); } }
#pragma unroll
            for (int q = 0; q < 4; ++q) if (kc + 32 * q < kw) {
#pragma unroll
                for (int m = 0; m < 4; ++m)
#pragma unroll
                    for (int n = 0; n < 4; ++n) acc[m][n] = __builtin_amdgcn_mfma_f32_16x16x32_bf16(bfr[q][n], af[q][m], acc[m][n], 0, 0, 0); } }
#pragma unroll
        for (int m = 0; m < 4; ++m)
#pragma unroll
            for (int n = 0; n < 4; ++n)
                *(LAS f32x4*)(part + (wave * 64 + 16 * m + fr) * 68 + 16 * n + 4 * fq) = acc[m][n];
        __syncthreads();
        { const int row = tid >> 3, c8 = (tid & 7) * 8; f32x4 s0 = {0.f, 0.f, 0.f, 0.f}, s1 = s0;
#pragma unroll
          for (int w = 0; w < 8; ++w) { s0 += *(const LAS f32x4*)(part + (w * 64 + row) * 68 + c8); s1 += *(const LAS f32x4*)(part + (w * 64 + row) * 68 + c8 + 4); }
          f(TP + 64 * tm + row, 64 * tn + c8, s0, s1, tid); }
        __syncthreads();
    }
}
__device__ __forceinline__ float sq8(const f32x4& a, const f32x4& b) { return (a.x * a.x + a.y * a.y) + (a.z * a.z + a.w * a.w) + (b.x * b.x + b.y * b.y) + (b.z * b.z + b.w * b.w); }
__device__ __forceinline__ v4u pack8(const f32x4& a, const f32x4& b) { v4u w; w.x = cvtpk(a.x, a.y); w.y = cvtpk(a.z, a.w); w.z = cvtpk(b.x, b.y); w.w = cvtpk(b.z, b.w); return w; }
__device__ __forceinline__ float sum8lanes(float q) { q += __shfl_xor(q, 1); q += __shfl_xor(q, 2); q += __shfl_xor(q, 4); return q; }
struct SEpiBf16 { bf16* O; int ldc;
    __device__ __forceinline__ void operator()(int row, int col, const f32x4& a, const f32x4& b, int) const { *(v4u*)(O + (size_t)row * ldc + col) = pack8(a, b); } };
struct SEpiRes { const float* xf; const bf16* xbin; bf16* x1b; float* ss1;
    __device__ __forceinline__ void operator()(int row, int col, const f32x4& sa, const f32x4& sb, int tid) const { const size_t off = (size_t)row * D + col;
        f32x4 a, b; ld8f(xf, xbin, off, a, b); a += sa; b += sb;
        *(v4u*)(x1b + off) = pack8(a, b);
        const float q = sum8lanes(sq8(a, b)); if ((tid & 7) == 0) ss1[(size_t)row * 16 + (col >> 6)] = q; } };
struct SEpiGate { const float* ss1; const bf16* x1b; const bf16* pe; float* xout; bf16* xb; float* ssx;
    __device__ __forceinline__ void operator()(int row, int col, const f32x4& sa, const f32x4& sb, int tid) const { const size_t off = (size_t)row * D + col; const float r1 = row_r16(ss1, row, 1.0f / D);
        const v4u pw = *(const v4u*)(pe + off); f32x4 xa, xc; ld8f(nullptr, x1b, off, xa, xc); const f32x4 ga = sa * r1, gb = sb * r1; f32x4 a, b;
        a.x = xa.x + sigm(ga.x) * bflo(pw.x); a.y = xa.y + sigm(ga.y) * bfhi(pw.x); a.z = xa.z + sigm(ga.z) * bflo(pw.y); a.w = xa.w + sigm(ga.w) * bfhi(pw.y);
        b.x = xc.x + sigm(gb.x) * bflo(pw.z); b.y = xc.y + sigm(gb.y) * bfhi(pw.z); b.z = xc.z + sigm(gb.z) * bflo(pw.w); b.w = xc.w + sigm(gb.w) * bfhi(pw.w);
        if (xout) { *(f32x4*)(xout + off) = a; *(f32x4*)(xout + off + 4) = b; } *(v4u*)(xb + off) = pack8(a, b);
        const float q = sum8lanes(sq8(a, b)); if ((tid & 7) == 0) ssx[(size_t)row * 16 + (col >> 6)] = q; } };
#ifndef ONLY_PHASE
#define PHASE_ON(k) true
#else
#define PHASE_ON(k) ((k) == ONLY_PHASE)
#endif
#define IN(k) (PHASE_ON(k) && lo <= (k) && (k) < hi)
#ifndef DUP_PHASE
#define DUP_PHASE (-1)
#endif
#define RUN(k, ...) do { if (IN(k)) { __VA_ARGS__; if ((k) == DUP_PHASE) { xcd_barrier(bar); __VA_ARGS__; } } } while (0)
#ifndef SEAM_REPS
#define SEAM_REPS 1
#endif
#define SEAM(k) do { if (lo <= (k) && (k) + 1 < hi) { for (int r_ = 0; r_ < SEAM_REPS; ++r_) xcd_barrier(bar); } } while (0)
template <int jj> __device__ __forceinline__ void layer_pair(Ctx& C, const XcdBarrier& bar, const int lo, const int hi) {
    LAS unsigned char* ring = C.lds;
        const int ia = 2 * jj, ib = 2 * jj + 1, pb = 1 + 9 * jj;
        RUN(pb, { pg8::Gemm g{WSP(bf16, WS_XB0), WSP(bf16, WS_WINA + jj * SZ_WINA), T, NA_IN, D}; pg8::StaticOrder S; S.init(T, NA_IN, C.G, C.bid);
            EpiA1 E{WSP(float, WS_SSX), WSP(bf16, WS_UZ), WSP(bf16, WS_VR), WSP(float, WS_VSS)}; pg8::gemm_phase<EpiA1, pg8::StaticOrder, true, true>(ring, g, S, E);
            if (jj == 0 && C.G == 256 && C.bid >= 96) prologue_part(C, 1, true, (C.bid - 96) * 8 + C.wave, 160 * 8); });
#ifdef PROBE_PLAIN_A1
        if (IN(pb)) { xcd_barrier(bar); pg8::Gemm g{WSP(bf16, WS_XB0), WSP(bf16, WS_WINA + jj * SZ_WINA), T, NA_IN, D}; pg8::StaticOrder S; S.init(T, NA_IN, C.G, C.bid);
#if PROBE_PLAIN_A1 == 2
            EpiNull E{WSP(float, WS_RAW)}; pg8::gemm_phase<EpiNull, pg8::StaticOrder, true, true>(ring, g, S, E); }
#else
            EpiBf16S E{WSP(bf16, WS_RAW), NA_IN}; pg8::gemm_phase<EpiBf16S, pg8::StaticOrder, true, true>(ring, g, S, E); }
#endif
#endif
        SEAM(pb);
        RUN(pb + 1, gate_phase(C, jj));
        SEAM(pb + 1);
        RUN(pb + 2, {
            { pg8::Gemm g{WSP(bf16, WS_Y), WSP(bf16, WS_WOUTA + jj * SZ_WOUTA), TP, D, AW}; pg8::StaticOrder S; S.init(TP, D, C.G, C.bid);
              EpiRes<jj == 0> E{KIN(const float, 0), WSP(bf16, WS_XB0), WSP(bf16, WS_XB1), WSP(float, WS_SS1)};
              pg8::gemm_phase<EpiRes<jj == 0>, pg8::StaticOrder, true, true>(ring, g, S, E); }
            { SEpiRes E{jj == 0 ? KIN(const float, 1) - (size_t)TP * D : nullptr, WSP(bf16, WS_XB0), WSP(bf16, WS_XB1), WSP(float, WS_SS1)};
              small_gemm(C, WSP(bf16, WS_Y), WSP(bf16, WS_WOUTA + jj * SZ_WOUTA), D, AW, E); }
            { pg8::Gemm g{WSP(bf16, WS_PB + ia * SZ_PB), WSP(bf16, WS_WPE + ia * SZ_WPE), TP, D, PD}; pg8::StaticOrder S; S.init(TP, D, C.G, C.bid);
              EpiBf16S E{WSP(bf16, WS_PE), D}; pg8::gemm_phase<EpiBf16S, pg8::StaticOrder, true, true>(ring, g, S, E); }
            { SEpiBf16 E{WSP(bf16, WS_PE), D}; small_gemm(C, WSP(bf16, WS_PB + ia * SZ_PB), WSP(bf16, WS_WPE + ia * SZ_WPE), D, PD, E); } });
        SEAM(pb + 2);
        RUN(pb + 3, { { pg8::Gemm g{WSP(bf16, WS_XB1), WSP(bf16, WS_WGATE + ia * SZ_WSQ), TP, D, D}; pg8::StaticOrder S; S.init(TP, D, C.G, C.bid);
            EpiGate E{WSP(float, WS_SS1), WSP(bf16, WS_XB1), WSP(bf16, WS_PE), nullptr, WSP(bf16, WS_XB0), WSP(float, WS_SSX)}; pg8::gemm_phase<EpiGate, pg8::StaticOrder, true, true>(ring, g, S, E); }
            { SEpiGate E{WSP(float, WS_SS1), WSP(bf16, WS_XB1), WSP(bf16, WS_PE), nullptr, WSP(bf16, WS_XB0), WSP(float, WS_SSX)}; small_gemm(C, WSP(bf16, WS_XB1), WSP(bf16, WS_WGATE + ia * SZ_WSQ), D, D, E); } });
        SEAM(pb + 3);
        RUN(pb + 4, { pg8::Gemm g{WSP(bf16, WS_XB0), WSP(bf16, WS_WINB + jj * SZ_WINB), T, NB_IN, D}; pg8::StaticOrder S; S.init(T, NB_IN, C.G, C.bid);
            EpiB1 E{C.ws, KIN(const float, 15) + jj * HD, KIN(const float, 16) + jj * HD, KIN(const float, 17) + jj * IDXD, C.out, jj, (LAS float*)(C.lds + 131072)};
            pg8::gemm_phase<EpiB1, pg8::StaticOrder, true, true>(ring, g, S, E);
            if (jj == 0 && C.G == 256 && C.bid >= 116) prologue_part(C, 2, true, (C.bid - 116) * 8 + C.wave, 140 * 8); });
#ifdef PROBE_PLAIN_B1
        if (IN(pb + 4)) { xcd_barrier(bar); pg8::Gemm g{WSP(bf16, WS_XB0), WSP(bf16, WS_WINB + jj * SZ_WINB), T, NB_IN, D}; pg8::StaticOrder S; S.init(T, NB_IN, C.G, C.bid);
            EpiBf16S E{WSP(bf16, WS_RAW), NB_IN}; pg8::gemm_phase<EpiBf16S, pg8::StaticOrder, true, true>(ring, g, S, E); }
#endif
        SEAM(pb + 4);
        RUN(pb + 5, idx_phase(C, jj));
        SEAM(pb + 5);
        RUN(pb + 6, attn_phase(C, jj));
        SEAM(pb + 6);
        RUN(pb + 7, {
            { pg8::Gemm g{WSP(bf16, WS_AO), WSP(bf16, WS_WOUTB + jj * SZ_WSQ), TP, D, D}; pg8::StaticOrder S; S.init(TP, D, C.G, C.bid);
              EpiRes<false> E{nullptr, WSP(bf16, WS_XB0), WSP(bf16, WS_XB1), WSP(float, WS_SS1)};
              pg8::gemm_phase<EpiRes<false>, pg8::StaticOrder, true, true>(ring, g, S, E); }
            { SEpiRes E{nullptr, WSP(bf16, WS_XB0), WSP(bf16, WS_XB1), WSP(float, WS_SS1)}; small_gemm(C, WSP(bf16, WS_AO), WSP(bf16, WS_WOUTB + jj * SZ_WSQ), D, D, E); }
            { pg8::Gemm g{WSP(bf16, WS_PB + ib * SZ_PB), WSP(bf16, WS_WPE + ib * SZ_WPE), TP, D, PD}; pg8::StaticOrder S; S.init(TP, D, C.G, C.bid);
              EpiBf16S E{WSP(bf16, WS_PE), D}; pg8::gemm_phase<EpiBf16S, pg8::StaticOrder, true, true>(ring, g, S, E); }
            { SEpiBf16 E{WSP(bf16, WS_PE), D}; small_gemm(C, WSP(bf16, WS_PB + ib * SZ_PB), WSP(bf16, WS_WPE + ib * SZ_WPE), D, PD, E); } });
        SEAM(pb + 7);
        RUN(pb + 8, { { pg8::Gemm g{WSP(bf16, WS_XB1), WSP(bf16, WS_WGATE + ib * SZ_WSQ), TP, D, D}; pg8::StaticOrder S; S.init(TP, D, C.G, C.bid);
            EpiGate E{WSP(float, WS_SS1), WSP(bf16, WS_XB1), WSP(bf16, WS_PE), jj == 1 ? C.out + O_Y : nullptr, WSP(bf16, WS_XB0), WSP(float, WS_SSX)}; pg8::gemm_phase<EpiGate, pg8::StaticOrder, true, true>(ring, g, S, E); }
            { SEpiGate E{WSP(float, WS_SS1), WSP(bf16, WS_XB1), WSP(bf16, WS_PE), jj == 1 ? C.out + O_Y : nullptr, WSP(bf16, WS_XB0), WSP(float, WS_SSX)}; small_gemm(C, WSP(bf16, WS_XB1), WSP(bf16, WS_WGATE + ib * SZ_WSQ), D, D, E); } });
        SEAM(pb + 8);
    }
constexpr int N_PHASES = 19;
__global__ void __launch_bounds__(512, 2) fwd(Args args) {
    extern __shared__ __attribute__((aligned(16))) unsigned char lds_raw[];
    Ctx C; C.lds = (LAS unsigned char*)lds_raw; C.tid = threadIdx.x; C.lane = C.tid & 63; C.wave = __builtin_amdgcn_readfirstlane(C.tid >> 6); C.G = gridDim.x; C.bid = blockIdx.x;
    C.out = args.out; C.ws = args.ws;
    volatile LAS unsigned* MISC = (volatile LAS unsigned*)(C.lds + MISC_OFF);
    if (C.tid < 64) MISC[C.tid] = 0u;
    __syncthreads();
    const int lo = args.ph_lo, hi = args.ph_hi;
    XcdBarrier bar; bar.bar = (unsigned*)(C.ws + WS_CTL) + CW_BAR; bar.x = 0; bar.st = nullptr;
    if (hi - lo > 1) bar = xcd_barrier_post((unsigned*)(C.ws + WS_CTL) + CW_BAR, MISC + 8);
    LAS unsigned char* ring = C.lds;
    RUN(0, prologue_part(C, 0, C.G == 256, C.bid * 8 + C.wave, C.G * 8));
    SEAM(0);
    layer_pair<0>(C, bar, lo, hi);
    layer_pair<1>(C, bar, lo, hi);
#undef IN
#undef SEAM
}

#ifndef MK_FUSED
#define MK_FUSED 1
#endif
extern "C" void kernel_launch(void* const* d_in, const int* in_sizes, int n_in, void* d_out, int out_size, void* d_ws, size_t ws_size, hipStream_t stream) {
    static int grid = 0;
    if (grid == 0) {
        if (n_in != 22 || out_size != (int)O_END || ws_size < WS_END) { fprintf(stderr, "kernel_launch: shape mismatch n_in %d out %d ws %zu (need %zu)\n", n_in, out_size, ws_size, (size_t)WS_END); grid = -1; return; }
        int dev = 0, cus = 0, per_cu = 0;
        if (hipGetDevice(&dev) != hipSuccess || hipDeviceGetAttribute(&cus, hipDeviceAttributeMultiprocessorCount, dev) != hipSuccess) { grid = -1; return; }
        if (hipFuncSetAttribute((const void*)fwd, hipFuncAttributeMaxDynamicSharedMemorySize, LDS_BYTES) != hipSuccess) { fprintf(stderr, "kernel_launch: hipFuncSetAttribute failed\n"); grid = -1; return; }
        if (hipOccupancyMaxActiveBlocksPerMultiprocessor(&per_cu, (const void*)fwd, 512, LDS_BYTES) != hipSuccess || per_cu < 1) fprintf(stderr, "kernel_launch: occupancy query says %d\n", per_cu);
        (void)hipGetLastError();
        grid = cus;
    }
    if (grid < 0) return;
    if (hipMemsetAsync((char*)d_ws + WS_CTL, 0, CTL_BYTES, stream) != hipSuccess) return;
    Args a{};
    for (int i = 0; i < 22; ++i) a.in[i] = d_in[i];
    a.out = (float*)d_out; a.ws = (unsigned char*)d_ws;
#if MK_FUSED
    a.ph_lo = 0; a.ph_hi = N_PHASES;
    hipLaunchKernelGGL(fwd, dim3(grid), dim3(512), LDS_BYTES, stream, a);
#else
    for (int p = 0; p < N_PHASES; ++p) { a.ph_lo = p; a.ph_hi = p + 1; hipLaunchKernelGGL(fwd, dim3(grid), dim3(512), LDS_BYTES, stream, a); }
#endif
    const hipError_t le = hipPeekAtLastError();
    if (le != hipSuccess) fprintf(stderr, "kernel_launch: launch failed: %s\n", hipGetErrorName(le));
}
```
